# Optimizing an MI355X kernel written in HIP

```python
import jax
import jax.numpy as jnp
from jax import lax
import numpy as np

D_MODEL = 1024
BATCH = 8
SEQ = 4096
DEPTH = 2

CTX_LEN = 256
GRID_W = 64
HEAD_DIM = 64
N_HEADS = D_MODEL // 128
N_KV_HEADS = 2
ATTN_WIDTH = N_HEADS * HEAD_DIM
KV_WIDTH = N_KV_HEADS * HEAD_DIM
Q_BLOCK = 128
ROPE_THETA = 10000.0
LRU_WIDTH = D_MODEL // 4
LRU_BLOCKS = 4
LRU_BLOCK = LRU_WIDTH // LRU_BLOCKS
LRU_CONV = 4
LRU_CONV_LEFT = 2
LRU_C = 8.0
SC_WIDTH = D_MODEL // 4
SC_CONV = 3
MIX_WIDTH = ATTN_WIDTH + LRU_WIDTH + SC_WIDTH
IN_SIZES = (ATTN_WIDTH, KV_WIDTH, KV_WIDTH,
            LRU_WIDTH, LRU_WIDTH,
            SC_WIDTH, SC_WIDTH, SC_WIDTH)
IN_SPLITS = tuple(sum(IN_SIZES[:i + 1]) for i in range(len(IN_SIZES) - 1))
IN_WIDTH = sum(IN_SIZES)
D_FF = 2816
FFN_CONV = 3
EPS = 1e-6

kernel_name = "hymba_style_rglru_gqa_shortconv_convffn_prefix_ctx"

F32 = jnp.float32


def _rmsnorm(x, g):
    xf = x.astype(F32)
    y = xf * lax.rsqrt(jnp.mean(xf * xf, axis=-1, keepdims=True) + EPS)
    return (y * g.astype(F32)).astype(x.dtype)


def _heads(t, n):
    return t.reshape(*t.shape[:-1], n, HEAD_DIM)


def _rope_tables(n_tok):
    rows = n_tok // GRID_W
    pos_r = jnp.repeat(jnp.arange(rows, dtype=F32), GRID_W)
    pos_c = jnp.tile(jnp.arange(GRID_W, dtype=F32), rows)
    n_f = HEAD_DIM // 4
    inv = ROPE_THETA ** (-jnp.arange(n_f, dtype=F32) / n_f)
    ang = jnp.concatenate([pos_r[:, None] * inv, pos_c[:, None] * inv], axis=-1)
    return jnp.cos(ang), jnp.sin(ang)


def _rope(x, cos, sin):
    xf = x.astype(F32)
    x1, x2 = jnp.split(xf, 2, axis=-1)
    cs = cos[:, None, :]
    sn = sin[:, None, :]
    return jnp.concatenate([x1 * cs - x2 * sn, x1 * sn + x2 * cs], axis=-1).astype(x.dtype)


def _attend(q, k, v):
    b, t = q.shape[0], q.shape[1]
    grp = N_HEADS // N_KV_HEADS
    nb = t // Q_BLOCK
    qb = q.reshape(b, nb, Q_BLOCK, N_KV_HEADS, grp, HEAD_DIM).swapaxes(0, 1)
    scale = HEAD_DIM ** -0.5

    def one_block(qblk):
        s = jnp.einsum("bqkgd,bskd->bkgqs", qblk, k).astype(F32) * scale
        pr = jax.nn.softmax(s, axis=-1).astype(v.dtype)
        return jnp.einsum("bkgqs,bskd->bqkgd", pr, v)

    o = lax.map(one_block, qb)
    return o.swapaxes(0, 1).reshape(b, t, N_HEADS * HEAD_DIM)


def _dwconv(x, w, left):
    kw = w.shape[0]
    t = x.shape[1]
    xp = jnp.pad(x, ((0, 0), (left, kw - 1 - left), (0, 0)))
    y = xp[:, 0:t] * w[0]
    for j in range(1, kw):
        y = y + xp[:, j:j + t] * w[j]
    return y


def _block_diag(xf, w, b):
    xb = xf.reshape(*xf.shape[:-1], LRU_BLOCKS, LRU_BLOCK)
    y = jnp.einsum("btnd,nde->btne", xb, w.astype(F32)).reshape(xf.shape)
    return y + b.astype(F32)


def _rglru_coeffs(xc, w_a, b_a, w_i, b_i, lam):
    xf = xc.astype(F32)
    r = jax.nn.sigmoid(_block_diag(xf, w_a, b_a))
    i = jax.nn.sigmoid(_block_diag(xf, w_i, b_i))
    log_a = -LRU_C * r * jax.nn.softplus(-lam.astype(F32))
    a = jnp.exp(log_a)
    bb = jnp.sqrt(-jnp.expm1(2.0 * log_a)) * (i * xf)
    return a, bb


def _linear_scan(a, b, h0, reverse):
    if h0 is not None:
        edge = -1 if reverse else 0
        b = b.at[:, edge].add(a[:, edge] * h0)

    def combine(prev, nxt):
        a_p, b_p = prev
        a_n, b_n = nxt
        return a_p * a_n, a_n * b_p + b_n

    return lax.associative_scan(combine, (a, b), axis=1, reverse=reverse)[1]


def _conv_ffn(h, p):
    up = _dwconv(h @ p["w_up"], p["ffn_conv_w"], FFN_CONV // 2)
    u, g = jnp.split(up, 2, axis=-1)
    return (jax.nn.silu(g) * u) @ p["w_down"]


def _layer(x, ctx, c, c_ctx, p, cos, sin, update_ctx):
    dt = x.dtype
    mod_x = (jax.nn.silu(c) @ p["w_mod"] + p["b_mod"])[:, None, :]
    mod_c = jax.nn.silu(c_ctx) @ p["w_mod"] + p["b_mod"]
    sa_x, ca_x, ga_x, sf_x, cf_x, gf_x = jnp.split(mod_x, 6, axis=-1)
    sa_c, ca_c, ga_c, sf_c, cf_c, gf_c = jnp.split(mod_c, 6, axis=-1)

    hx = _rmsnorm(x, p["g_mix"]) * (1 + ca_x) + sa_x
    hc = _rmsnorm(ctx, p["g_mix"]) * (1 + ca_c) + sa_c
    qx, kx, vx, rx, gx, bx, cx, ux = jnp.split(hx @ p["w_in"], IN_SPLITS, axis=-1)
    qc, kc, vc, rc, gc, bc, cc, uc = jnp.split(hc @ p["w_in"], IN_SPLITS, axis=-1)

    kc_h = _rmsnorm(_heads(kc, N_KV_HEADS), p["g_k"])
    vc_h = _heads(vc, N_KV_HEADS)
    qx_h = _rope(_rmsnorm(_heads(qx, N_HEADS), p["g_q"]), cos, sin)
    kx_h = _rope(_rmsnorm(_heads(kx, N_KV_HEADS), p["g_k"]), cos, sin)
    k_all = jnp.concatenate([kx_h, kc_h], axis=1)
    v_all = jnp.concatenate([_heads(vx, N_KV_HEADS), vc_h], axis=1)
    att_x = _attend(qx_h, k_all, v_all)

    rc_conv = _dwconv(rc, p["lru_conv_w"], LRU_CONV_LEFT) + p["lru_conv_b"]
    rx_conv = _dwconv(rx, p["lru_conv_w"], LRU_CONV_LEFT) + p["lru_conv_b"]
    dir_par = [(p["lru_wa"][d], p["lru_ba"][d], p["lru_wi"][d], p["lru_bi"][d], p["lru_lam"][d]) for d in range(2)]
    a_cf, b_cf = _rglru_coeffs(rc_conv, *dir_par[0])
    a_cb, b_cb = _rglru_coeffs(rc_conv, *dir_par[1])
    a_xf, b_xf = _rglru_coeffs(rx_conv, *dir_par[0])
    a_xb, b_xb = _rglru_coeffs(rx_conv, *dir_par[1])
    h_cf = _linear_scan(a_cf, b_cf, None, False)
    h_cb = _linear_scan(a_cb, b_cb, None, True)
    h_xf = _linear_scan(a_xf, b_xf, h_cf[:, -1], False)
    h_xb = _linear_scan(a_xb, b_xb, h_cb[:, 0], True)
    lru_x = jax.nn.gelu(gx) * (h_xf + h_xb).astype(dt)

    sc_x = bx * _dwconv(cx * ux, p["sc_conv_w"], SC_CONV // 2)

    x = x + ga_x * (jnp.concatenate([att_x, lru_x, sc_x], axis=-1) @ p["w_out"])
    x = x + gf_x * _conv_ffn(_rmsnorm(x, p["g_ffn"]) * (1 + cf_x) + sf_x, p)

    if update_ctx:
        qc_h = _rmsnorm(_heads(qc, N_HEADS), p["g_q"])
        att_c = _attend(qc_h, kc_h, vc_h)
        lru_c = jax.nn.gelu(gc) * (h_cf + h_cb).astype(dt)
        sc_c = bc * _dwconv(cc * uc, p["sc_conv_w"], SC_CONV // 2)
        ctx = ctx + ga_c * (jnp.concatenate([att_c, lru_c, sc_c], axis=-1) @ p["w_out"])
        ctx = ctx + gf_c * _conv_ffn(_rmsnorm(ctx, p["g_ffn"]) * (1 + cf_c) + sf_c, p)
    return x, ctx


def setup_inputs(seed: int = 0) -> dict:
    key = jax.random.key(seed)
    ks = iter(jax.random.split(key, 32))
    D = D_MODEL

    def nrm(shape, scale):
        return jax.random.normal(next(ks), shape, F32) * scale

    x = nrm((BATCH, SEQ, D), 1.0)
    c = nrm((BATCH, D), 1.0)
    ctx = nrm((BATCH, CTX_LEN, D), 1.0)
    c_ctx = nrm((D,), 1.0)
    w_mod = nrm((DEPTH, D, 6 * D), 0.5 * D ** -0.5)
    b_mod = nrm((DEPTH, 6 * D), 0.02)
    g_mix = 1.0 + nrm((DEPTH, D), 0.05)
    g_ffn = 1.0 + nrm((DEPTH, D), 0.05)
    w_in = nrm((DEPTH, D, IN_WIDTH), D ** -0.5)
    g_q = 1.0 + nrm((DEPTH, HEAD_DIM), 0.05)
    g_k = 1.0 + nrm((DEPTH, HEAD_DIM), 0.05)
    lru_conv_w = nrm((DEPTH, LRU_CONV, LRU_WIDTH), LRU_CONV ** -0.5)
    lru_conv_b = nrm((DEPTH, LRU_WIDTH), 0.01)
    lru_wa = nrm((DEPTH, 2, LRU_BLOCKS, LRU_BLOCK, LRU_BLOCK), LRU_BLOCK ** -0.5)
    lru_ba = nrm((DEPTH, 2, LRU_WIDTH), 0.01)
    lru_wi = nrm((DEPTH, 2, LRU_BLOCKS, LRU_BLOCK, LRU_BLOCK), LRU_BLOCK ** -0.5)
    lru_bi = nrm((DEPTH, 2, LRU_WIDTH), 0.01)
    u = jax.random.uniform(next(ks), (DEPTH, 2, LRU_WIDTH), F32, 0.9, 0.999)
    a0 = u ** (1.0 / LRU_C)
    lru_lam = jnp.log(a0) - jnp.log1p(-a0)
    sc_conv_w = nrm((DEPTH, SC_CONV, SC_WIDTH), SC_CONV ** -0.5)
    w_out = nrm((DEPTH, MIX_WIDTH, D), MIX_WIDTH ** -0.5)
    w_up = nrm((DEPTH, D, 2 * D_FF), D ** -0.5)
    ffn_conv_w = nrm((DEPTH, FFN_CONV, 2 * D_FF), FFN_CONV ** -0.5)
    w_down = nrm((DEPTH, D_FF, D), D_FF ** -0.5)
    g_final = 1.0 + nrm((D,), 0.05)
    return {"x": x, "c": c, "ctx": ctx, "c_ctx": c_ctx, "w_mod": w_mod, "b_mod": b_mod,
            "g_mix": g_mix, "g_ffn": g_ffn, "w_in": w_in, "g_q": g_q, "g_k": g_k,
            "lru_conv_w": lru_conv_w, "lru_conv_b": lru_conv_b, "lru_wa": lru_wa, "lru_ba": lru_ba,
            "lru_wi": lru_wi, "lru_bi": lru_bi, "lru_lam": lru_lam, "sc_conv_w": sc_conv_w,
            "w_out": w_out, "w_up": w_up, "ffn_conv_w": ffn_conv_w, "w_down": w_down,
            "g_final": g_final}


def reference(x, c, ctx, c_ctx, w_mod, b_mod, g_mix, g_ffn, w_in, g_q, g_k,
              lru_conv_w, lru_conv_b, lru_wa, lru_ba, lru_wi, lru_bi, lru_lam, sc_conv_w,
              w_out, w_up, ffn_conv_w, w_down, g_final):
    cos, sin = _rope_tables(x.shape[1])
    for l in range(DEPTH):
        p = {"w_mod": w_mod[l], "b_mod": b_mod[l], "g_mix": g_mix[l], "g_ffn": g_ffn[l],
             "w_in": w_in[l], "g_q": g_q[l], "g_k": g_k[l],
             "lru_conv_w": lru_conv_w[l], "lru_conv_b": lru_conv_b[l],
             "lru_wa": lru_wa[l], "lru_ba": lru_ba[l], "lru_wi": lru_wi[l], "lru_bi": lru_bi[l],
             "lru_lam": lru_lam[l], "sc_conv_w": sc_conv_w[l], "w_out": w_out[l],
             "w_up": w_up[l], "ffn_conv_w": ffn_conv_w[l], "w_down": w_down[l]}
        x, ctx = _layer(x, ctx, c, c_ctx, p, cos, sin, l < DEPTH - 1)
    return _rmsnorm(x, g_final)
```

```cpp
#include <hip/hip_runtime.h>
#include <cstdio>
#include <cstdint>
#include <cmath>
#include <hip/hip_bf16.h>

#ifndef MK_N_LAUNCHES
#define MK_N_LAUNCHES 1
#endif
#ifndef PROBE_REP_MASK
#define PROBE_REP_MASK 0
#endif
#define REP(kind) for (int rep_ = 0; rep_ < (((PROBE_REP_MASK) >> (kind)) & 1) + 1; ++rep_)

#define LAS __attribute__((address_space(3)))
#define GAS __attribute__((address_space(1)))
typedef unsigned short bf16;
typedef unsigned v4u __attribute__((ext_vector_type(4)));
typedef unsigned v2u __attribute__((ext_vector_type(2)));
typedef float f32x4 __attribute__((ext_vector_type(4)));
typedef float f32x2 __attribute__((ext_vector_type(2)));

constexpr int NB = 8, SEQ = 4096, CTXL = 256, DM = 1024, DEPTH = 2;
constexpr int M_LAT = NB * SEQ, M_CTX = NB * CTXL, M_ALL = M_LAT + M_CTX;
constexpr int NPROJ = 2048, DFF = 2816, NUP = 2 * DFF, KVROWS = SEQ + CTXL, KVP = 128;
constexpr int NCHUNK = 68;
constexpr float EPS = 1e-6f;
constexpr float C2 = 0.125f * 1.4426950408889634f;
constexpr int NWAVES = 8, NTHREADS = 512;

constexpr size_t MiB = 1u << 20;
constexpr size_t WS_CTL = 0, CTL_ZERO_BYTES = 1 * MiB;
constexpr size_t WS_WIN = 1 * MiB, WS_WOUT = 9 * MiB, WS_WUP = 13 * MiB, WS_WDN = 35 * MiB, WS_GW = 46 * MiB;
constexpr size_t SZ_WIN = 4 * MiB, SZ_WOUT = 2 * MiB, SZ_WUP = 11 * MiB, SZ_WDN = 11 * MiB / 2, SZ_GW = MiB / 2;
constexpr size_t WS_MOD = 47 * MiB, WS_BIN = 47 * MiB + 512 * 1024, WS_BUP = 48 * MiB, WS_ROPE = 48 * MiB + 512 * 1024, WS_SPL = WS_ROPE + 16384;
constexpr size_t WS_STA = 49 * MiB, WS_STB = 51 * MiB + 512 * 1024, WS_AGP = 54 * MiB, WS_AGB = 55 * MiB + 512 * 1024;
constexpr size_t WS_XC = 57 * MiB, WS_AP = 65 * MiB, WS_BIG = 133 * MiB;
constexpr size_t WS_PROJ = WS_BIG, WS_MIX = WS_BIG + 136 * MiB, WS_KB = WS_MIX + 68 * MiB, WS_VB = WS_KB + 17 * MiB / 2, WS_RC = WS_VB + 17 * MiB / 2;
constexpr size_t WS_LA = WS_RC + 17 * MiB, WS_XR = WS_LA + 68 * MiB, WS_END1 = WS_XR + 68 * MiB;
constexpr size_t WS_ACT = WS_BIG, WS_EDGE = WS_BIG + 187 * MiB, WS_END2 = WS_EDGE + 8 * MiB;
constexpr size_t WS_END = 512 * MiB;
static_assert(WS_END1 <= WS_END && WS_END2 <= WS_XR, "d_ws map");
static_assert((size_t)M_ALL * NPROJ * 2 == 136 * MiB && (size_t)M_ALL * DM * 2 == 68 * MiB && (size_t)M_ALL * 256 * 2 == 17 * MiB && (size_t)M_ALL * DFF * 2 == 187 * MiB, "sizes");
static_assert((size_t)136 * 4 * NUP * 2 <= 8 * MiB && (size_t)NB * KVROWS * KVP * 2 * 2 == 17 * MiB && (size_t)M_ALL * 256 * 4 * 2 == 68 * MiB, "sizes2");
constexpr int CW_BAR = 4096;

constexpr int RING_BYTES = 131072, LDSCTL_OFF = RING_BYTES, MISC_OFF = LDSCTL_OFF + 320, EXCH_OFF = RING_BYTES + 1024  , LDS_BYTES = 147456;

__device__ __forceinline__ float bflo(unsigned w) { return __uint_as_float(w << 16); }
__device__ __forceinline__ float bfhi(unsigned w) { return __uint_as_float(w & 0xffff0000u); }
__device__ __forceinline__ float bf1(bf16 h) { return __uint_as_float((unsigned)h << 16); }
__device__ __forceinline__ unsigned pk2(float lo, float hi) { unsigned r; asm volatile("v_cvt_pk_bf16_f32 %0, %1, %2" : "=v"(r) : "v"(lo), "v"(hi)); return r; }
__device__ __forceinline__ void unpack8(const v4u w, float (&x)[8]) {
    x[0] = bflo(w.x); x[1] = bfhi(w.x); x[2] = bflo(w.y); x[3] = bfhi(w.y); x[4] = bflo(w.z); x[5] = bfhi(w.z); x[6] = bflo(w.w); x[7] = bfhi(w.w);
}
__device__ __forceinline__ v4u pack8(const float (&x)[8]) { v4u w; w.x = pk2(x[0], x[1]); w.y = pk2(x[2], x[3]); w.z = pk2(x[4], x[5]); w.w = pk2(x[6], x[7]); return w; }
__device__ __forceinline__ float shx(float v, int mask, int lane) { return __int_as_float(__builtin_amdgcn_ds_bpermute((lane ^ mask) << 2, __float_as_int(v))); }
__device__ __forceinline__ float wave_sum(float v, int lane) {
#pragma unroll
    for (int o = 1; o < 64; o <<= 1) v += shx(v, o, lane);
    return v;
}
__device__ __forceinline__ float sigmoidf_(float x) { return __builtin_amdgcn_rcpf(1.0f + __expf(-x)); }
__device__ __forceinline__ float silu_(float x) { return x * __builtin_amdgcn_rcpf(1.0f + __expf(-x)); }
__device__ __forceinline__ float one_minus_exp_(float x) {
    const float s = -x * (1.0f + x * (0.5f + x * (1.0f / 6.0f + x * (1.0f / 24.0f + x * (1.0f / 120.0f + x * (1.0f / 720.0f + x * (1.0f / 5040.0f)))))));
    return x > -0.25f ? s : 1.0f - __expf(x);
}
__device__ __forceinline__ float gelu_tanh_(float x) {
    const float u = 0.7978845608028654f * (x + 0.044715f * x * x * x);
    const float t = 1.0f - 2.0f * __builtin_amdgcn_rcpf(1.0f + __expf(2.0f * u));
    return 0.5f * x * (1.0f + t);
}
__device__ __forceinline__ int row_bi(int m) { return m < M_LAT ? (m >> 12) : 8; }

struct Args { const void* in[24]; float* out; unsigned char* ws; int ph_lo, ph_hi; };
struct Ctx {
    LAS unsigned char* lds; char* lds_gen; int tid, lane, wave, vcu, G, gw, NGW;
    const float *x, *c, *ctx, *c_ctx, *w_mod, *b_mod, *g_mix, *g_ffn, *w_in, *g_q, *g_k, *lru_conv_w, *lru_conv_b, *lru_wa, *lru_ba, *lru_wi, *lru_bi, *lru_lam, *sc_conv_w, *w_out, *w_up, *ffn_conv_w, *w_down, *g_final;
    float* out; unsigned char* ws;
};
#define WSP(T, off) ((T*)(C.ws + (off)))

struct ProjEpi {
    bf16* Cout; int ldc; const float* stats; const float* bias; int ldb; int row_off;
    int tile0; bf16 *MIX, *KB, *VB; const float *ropeT, *gq, *gk;
};
struct ResEpi {
    const float *xi_lat, *xi_ctx; bf16* XR; const float* gate; const float* gn; const float* cn; bf16* AP; float* stats; bool has_ap; int pm_off; bool ap_perm;
    __device__ __forceinline__ const float* xi_row(int grow) const { return grow < M_LAT ? xi_lat + (size_t)grow * DM : xi_ctx + (size_t)(grow - M_LAT) * DM; }
};
struct GatesEpi {
    const bf16* RC; const float *ba, *bi_, *spl; unsigned* LAB; float *AGP, *AGB;
};

__host__ __device__ __forceinline__ int qk_pos(int n) { if (n >= 640) return n; const int d = n & 63; return (n & ~63) + 2 * (d & 31) + (d >> 5); }
__device__ __forceinline__ void transpose_item(const float* W, int K, int N, bf16* WT, LAS float* scr, int item, int lane, bool upperm = false, bool qkperm = false) {
    const int nblk = N / 32, kb = item / nblk, nb = item % nblk, k0 = 64 * kb, n0 = 32 * nb;
    int d0 = n0; if (upperm) { const int half = n0 / DFF, j = n0 - half * DFF; d0 = (j >> 7) * 256 + half * 128 + (j & 127); }
    { f32x4 v[8];
#pragma unroll
      for (int i = 0; i < 8; ++i) v[i] = *(const f32x4*)(W + (size_t)(k0 + 8 * i + (lane >> 3)) * N + n0 + 4 * (lane & 7));
#pragma unroll
      for (int i = 0; i < 8; ++i) { LAS float* d = scr + (8 * i + (lane >> 3)) * 33 + 4 * (lane & 7); d[0] = v[i].x; d[1] = v[i].y; d[2] = v[i].z; d[3] = v[i].w; } }
    asm volatile("s_waitcnt lgkmcnt(0)" ::: "memory");
    const int c = lane & 7;
#pragma unroll
    for (int j = 0; j < 4; ++j) { const int n = (lane >> 3) + 8 * j; const LAS float* s = scr + (8 * c) * 33 + n;
        v4u o; o.x = pk2(s[0 * 33], s[1 * 33]); o.y = pk2(s[2 * 33], s[3 * 33]); o.z = pk2(s[4 * 33], s[5 * 33]); o.w = pk2(s[6 * 33], s[7 * 33]);
        *(v4u*)(WT + (size_t)(qkperm ? qk_pos(n0 + n) : d0 + n) * K + k0 + 8 * c) = o; }
    asm volatile("s_waitcnt lgkmcnt(0)" ::: "memory");
}
__device__ __forceinline__ void gemv9_item(const Ctx& C, LAS float* vec, LAS float* red, const float* W, int ldw, int n0, const float* bias, float* out, int ostride, bool qkperm = false) {
    float acc[9];
#pragma unroll
    for (int b = 0; b < 9; ++b) acc[b] = 0.f;
    const int k0 = C.wave * 128; const float* wp = W + (size_t)k0 * ldw + n0 + C.lane;
#pragma unroll 1
    for (int kk = 0; kk < 128; kk += 16) {
        float w[16];
#pragma unroll
        for (int j = 0; j < 16; ++j) w[j] = wp[(size_t)(kk + j) * ldw];
#pragma unroll
        for (int j = 0; j < 16; j += 4)
#pragma unroll
            for (int b = 0; b < 9; ++b) { const f32x4 v = *(const LAS f32x4*)(vec + b * 1024 + k0 + kk + j); acc[b] += (v.x * w[j] + v.y * w[j + 1]) + (v.z * w[j + 2] + v.w * w[j + 3]); }
    }
#pragma unroll
    for (int b = 0; b < 9; ++b) red[(C.wave * 9 + b) * 64 + C.lane] = acc[b];
    __syncthreads();
    for (int idx = C.tid; idx < 576; idx += NTHREADS) { const int b = idx >> 6, j = idx & 63; float s = 0.f;
#pragma unroll
        for (int w = 0; w < 8; ++w) s += red[(w * 9 + b) * 64 + j];
        if (bias) s += bias[n0 + j];
        out[(size_t)b * ostride + (qkperm ? qk_pos(n0 + j) : n0 + j)] = s; }
    __syncthreads();
}
template <int WHICH> __device__ __forceinline__ void transpose_matrix(const Ctx& C, int l, int widx, int nw) {
    LAS float* scr = (LAS float*)(C.lds + C.wave * 16384);
    if (WHICH == 0) for (int it = widx; it < 16 * 64; it += nw) transpose_item(C.w_in + (size_t)l * DM * NPROJ, DM, NPROJ, WSP(bf16, WS_WIN + l * SZ_WIN), scr, it, C.lane, false, true);
    if (WHICH == 1) for (int it = widx; it < 16 * 32; it += nw) transpose_item(C.w_out + (size_t)l * DM * DM, DM, DM, WSP(bf16, WS_WOUT + l * SZ_WOUT), scr, it, C.lane);
    if (WHICH == 2) for (int it = widx; it < 16 * 176; it += nw) transpose_item(C.w_up + (size_t)l * DM * NUP, DM, NUP, WSP(bf16, WS_WUP + l * SZ_WUP), scr, it, C.lane, true);
    if (WHICH == 3) for (int it = widx; it < 44 * 32; it += nw) transpose_item(C.w_down + (size_t)l * DFF * DM, DFF, DM, WSP(bf16, WS_WDN + l * SZ_WDN), scr, it, C.lane);
}
__device__ __forceinline__ void bias_items(const Ctx& C, int l, bool up, int bidx, int nb) {
    LAS float* vec = (LAS float*)C.lds; LAS float* red = (LAS float*)(C.lds + 40960);
    const float* mod = WSP(float, WS_MOD) + (size_t)l * 9 * 6144 + (up ? 3 * 1024 : 0);
    const int nit = up ? 88 : 32;
    if (bidx < nit) {
        __syncthreads();
        { float t[18];
#pragma unroll
          for (int q = 0; q < 18; ++q) { const int idx = C.tid + q * NTHREADS; t[q] = mod[(size_t)(idx >> 10) * 6144 + (idx & 1023)]; }
#pragma unroll
          for (int q = 0; q < 18; ++q) vec[C.tid + q * NTHREADS] = t[q]; }
        __syncthreads();
        for (int it = bidx; it < nit; it += nb) {
            if (up) gemv9_item(C, vec, red, C.w_up + (size_t)l * DM * NUP, NUP, it * 64, nullptr, WSP(float, WS_BUP) + (size_t)l * 9 * NUP, NUP);
            else    gemv9_item(C, vec, red, C.w_in + (size_t)l * DM * NPROJ, NPROJ, it * 64, nullptr, WSP(float, WS_BIN) + (size_t)l * 9 * NPROJ, NPROJ, true); }
    }
}
__device__ __forceinline__ void phase_p0a(const Ctx& C) {
    transpose_matrix<0>(C, 0, C.gw, C.NGW);
    const int gt = C.gw * 64 + C.lane, NGT = C.NGW * 64;
    for (int idx0 = gt; idx0 < DEPTH * 1024 * 256; idx0 += 4 * NGT) {
        float va[4], vi[4];
#pragma unroll
        for (int q = 0; q < 4; ++q) { const int idx = (idx0 + q * NGT < DEPTH * 1024 * 256) ? idx0 + q * NGT : idx0; const int l = idx >> 18, n = (idx >> 8) & 1023, k = idx & 255;
            const int dir = n >> 9, half = (n >> 8) & 1, cl = n & 127, ch = half * 128 + cl, blk = ch >> 6, e = ch & 63;
            const size_t wi = ((((size_t)l * 2 + dir) * 4 + blk) * 64 + (k & 63)) * 64 + e; va[q] = C.lru_wa[wi]; vi[q] = C.lru_wi[wi]; }
#pragma unroll
        for (int q = 0; q < 4; ++q) { const int idx = idx0 + q * NGT; if (idx < DEPTH * 1024 * 256) { const int l = idx >> 18, n = (idx >> 8) & 1023, k = idx & 255;
            const int half = (n >> 8) & 1, gate = (n >> 7) & 1, cl = n & 127, blk = (half * 128 + cl) >> 6; const float v = ((k >> 6) == blk) ? (gate ? vi[q] : va[q]) : 0.f;
            WSP(bf16, WS_GW + l * SZ_GW)[(size_t)n * 256 + k] = (bf16)(pk2(v, 0.f) & 0xffffu); } }
    }
    if (gt < 1024) { const int pos = gt >> 4, f = gt & 15; const float inv = powf(10000.0f, -(float)f / 16.0f), ang = (float)pos * inv;
        WSP(float, WS_ROPE)[gt] = cosf(ang); WSP(float, WS_ROPE)[1024 + gt] = sinf(ang); }
    if (gt < DEPTH * 2 * 256) { const float lam = C.lru_lam[gt]; WSP(float, WS_SPL)[gt] = log1pf(expf(-lam)); }
    __syncthreads();
    LAS float* vec = (LAS float*)C.lds; LAS float* red = (LAS float*)(C.lds + 40960);
    if (C.vcu < DEPTH * 96) {
        { float t[18];
#pragma unroll
          for (int q = 0; q < 18; ++q) { const int idx = C.tid + q * NTHREADS, b = idx >> 10, k = idx & 1023; const float vc = C.c[(b < 8 ? b : 0) * 1024 + k], vx = C.c_ctx[k]; t[q] = b < 8 ? vc : vx; }
#pragma unroll
          for (int q = 0; q < 18; ++q) vec[C.tid + q * NTHREADS] = silu_(t[q]); }
        __syncthreads();
        for (int it = C.vcu; it < DEPTH * 96; it += C.G) { const int l = it / 96, n0 = (it % 96) * 64;
            gemv9_item(C, vec, red, C.w_mod + (size_t)l * DM * 6144, 6144, n0, C.b_mod + l * 6144, WSP(float, WS_MOD) + (size_t)l * 9 * 6144, 6144); }
    }
}
__device__ __forceinline__ void phase_p0b(const Ctx& C) {
    const int nbw = (C.G > 64) ? 32 : 0;
    bias_items(C, 0, false, C.vcu, C.G);
    if (C.vcu < nbw) return;
    const int gw2 = (C.vcu - nbw) * NWAVES + C.wave, NGW2 = (C.G - nbw) * NWAVES;
    bf16* __restrict__ AP = WSP(bf16, WS_AP); float* __restrict__ STA = WSP(float, WS_STA);
    f32x4 g[4];
#pragma unroll
    for (int j = 0; j < 4; ++j) g[j] = *(const f32x4*)(C.g_mix + (C.lane + 64 * j) * 4);
    for (int m0 = gw2; m0 < M_ALL; m0 += 2 * NGW2) {
        f32x4 v[2][4], cc[2][4]; int mm[2];
#pragma unroll
        for (int q = 0; q < 2; ++q) { const int m = (m0 + q * NGW2 < M_ALL) ? m0 + q * NGW2 : m0; mm[q] = m;
            const float* xr = m < M_LAT ? C.x + (size_t)m * DM : C.ctx + (size_t)(m - M_LAT) * DM; const float* ca = WSP(float, WS_MOD) + (size_t)row_bi(m) * 6144 + 1024;
#pragma unroll
            for (int j = 0; j < 4; ++j) { const int k = (C.lane + 64 * j) * 4; v[q][j] = *(const f32x4*)(xr + k); cc[q][j] = *(const f32x4*)(ca + k); } }
#pragma unroll
        for (int q = 0; q < 2; ++q) { float ss = 0.f;
#pragma unroll
            for (int j = 0; j < 4; ++j) { const int k = (C.lane + 64 * j) * 4; const f32x4 x = v[q][j];
                ss += (x.x * x.x + x.y * x.y) + (x.z * x.z + x.w * x.w); const f32x4 a = x * g[j] * (cc[q][j] + 1.0f);
                v2u w; w.x = pk2(a.x, a.y); w.y = pk2(a.z, a.w); *(v2u*)(AP + (size_t)mm[q] * DM + k) = w; }
            ss = wave_sum(ss, C.lane);
            if (C.lane < 16) STA[(size_t)mm[q] * 16 + C.lane] = C.lane == 0 ? ss : 0.f; }
    }
}
__device__ __forceinline__ void deferred_work(const Ctx& C, int window, int d, int nd) {
    const int widx = d * NWAVES + C.wave, nw = nd * NWAVES;
    if (window == 0) { transpose_matrix<1>(C, 0, widx, nw); transpose_matrix<2>(C, 0, widx, nw); transpose_matrix<0>(C, 1, widx, nw); transpose_matrix<1>(C, 1, widx, nw); bias_items(C, 0, true, d, nd); }
    if (window == 1) { transpose_matrix<3>(C, 0, widx, nw); transpose_matrix<3>(C, 1, widx, nw); }
    if (window == 2) { transpose_matrix<2>(C, 1, widx, nw); bias_items(C, 1, true, d, nd); bias_items(C, 1, false, d >= 88 ? d - 88 : d + nd - 88, nd); }
}

__device__ __forceinline__ void rope_tab(const float* ropeT, int t, int j, f32x4 (&cs)[2], f32x4 (&sn)[2]) {
    const int pos = ((j & 3) < 2) ? (t >> 6) : (t & 63), f0 = 8 * (j & 1); const float* c = ropeT + pos * 16 + f0; const float* s = ropeT + 1024 + pos * 16 + f0;
    cs[0] = *(const f32x4*)c; cs[1] = *(const f32x4*)(c + 4); sn[0] = *(const f32x4*)s; sn[1] = *(const f32x4*)(s + 4);
}
__device__ __forceinline__ void rope8(float (&y)[8], const float (&p)[8], const f32x4 (&cs)[2], const f32x4 (&sn)[2], int j) {
#pragma unroll
    for (int e = 0; e < 8; ++e) { const float c = cs[e >> 2][e & 3], s = sn[e >> 2][e & 3]; y[e] = (j < 4) ? (y[e] * c - p[e] * s) : (y[e] * c + p[e] * s); }
}
__device__ __forceinline__ void head_norm_rope(float (&x)[8], const float (&g)[8], bool rope, const f32x4 (&cs)[2], const f32x4 (&sn)[2], int j, int lane) {
    float ss = 0.f;
#pragma unroll
    for (int e = 0; e < 8; ++e) ss += x[e] * x[e];
    ss += shx(ss, 1, lane); ss += shx(ss, 2, lane); ss += shx(ss, 4, lane);
    const float rinv = rsqrtf(ss * (1.0f / 64.0f) + EPS); float p[8];
#pragma unroll
    for (int e = 0; e < 8; ++e) x[e] = x[e] * rinv * g[e];
#pragma unroll
    for (int e = 0; e < 8; ++e) p[e] = shx(x[e], 4, lane);
    if (rope) rope8(x, p, cs, sn, j);
}
__device__ __forceinline__ void phase_post(const Ctx& C, int l, int m_lo, int m_hi, int tasks, int gw, int NGW) {
    const bf16* __restrict__ PROJ = WSP(bf16, WS_PROJ); bf16* __restrict__ MIX = WSP(bf16, WS_MIX); bf16* __restrict__ KB = WSP(bf16, WS_KB); bf16* __restrict__ VB = WSP(bf16, WS_VB); bf16* __restrict__ RC = WSP(bf16, WS_RC);
    const float* __restrict__ ropeT = WSP(float, WS_ROPE);
    if (tasks & 1) { const int j = C.lane & 7; float gq[8];
#pragma unroll
      for (int e = 0; e < 8; ++e) gq[e] = C.g_q[l * 64 + 8 * j + e];
      for (int m0 = m_lo + gw; m0 < m_hi; m0 += 4 * NGW) {
        v4u xw[4]; f32x4 cs[4][2], sn[4][2]; int mm[4];
#pragma unroll
        for (int q = 0; q < 4; ++q) { const int m = m0 + q * NGW; mm[q] = m < m_hi ? m : m0; xw[q] = *(const v4u*)(PROJ + (size_t)mm[q] * NPROJ + C.lane * 8); rope_tab(ropeT, mm[q] & 4095, j, cs[q], sn[q]); }
#pragma unroll
        for (int q = 0; q < 4; ++q) { float x[8]; unpack8(xw[q], x); head_norm_rope(x, gq, mm[q] < M_LAT, cs[q], sn[q], j, C.lane);
#pragma unroll
            for (int e = 0; e < 8; ++e) x[e] *= C2;
            *(v4u*)(MIX + (size_t)mm[q] * DM + C.lane * 8) = pack8(x); }
      } }
    if (tasks & 2) { const int sub = C.lane & 31, j = sub & 7; const bool iskey = sub < 16; float gk[8];
#pragma unroll
      for (int e = 0; e < 8; ++e) gk[e] = C.g_k[l * 64 + 8 * j + e];
      for (int p0 = m_lo / 2 + gw; p0 < m_hi / 2; p0 += 4 * NGW) {
        v4u xw[4]; f32x4 cs[4][2], sn[4][2]; int mm[4];
#pragma unroll
        for (int q = 0; q < 4; ++q) { const int pi = p0 + q * NGW; mm[q] = 2 * (pi < m_hi / 2 ? pi : p0) + (C.lane >> 5); xw[q] = *(const v4u*)(PROJ + (size_t)mm[q] * NPROJ + 512 + sub * 8); rope_tab(ropeT, mm[q] & 4095, j, cs[q], sn[q]); }
#pragma unroll
        for (int q = 0; q < 4; ++q) { const int m = mm[q]; float x[8], y[8]; unpack8(xw[q], x);
#pragma unroll
            for (int e = 0; e < 8; ++e) y[e] = x[e];
            head_norm_rope(y, gk, m < M_LAT, cs[q], sn[q], j, C.lane);
            int b, pos; if (m < M_LAT) { b = m >> 12; pos = m & 4095; } else { const int mc = m - M_LAT; b = mc >> 8; pos = SEQ + (mc & 255); }
            bf16* dst = (iskey ? KB : VB) + ((size_t)b * KVROWS + pos) * KVP + (sub & 15) * 8;
            *(v4u*)dst = iskey ? pack8(y) : pack8(x); }
      } }
    if (tasks & 4) { const int sub = C.lane & 31, ch0 = sub * 8; float cw[4][8], cb[8];
#pragma unroll
      for (int e = 0; e < 8; ++e) { cb[e] = C.lru_conv_b[l * 256 + ch0 + e];
#pragma unroll
          for (int k = 0; k < 4; ++k) cw[k][e] = C.lru_conv_w[(l * 4 + k) * 256 + ch0 + e]; }
      for (int it = gw; it < (m_hi - m_lo) / 16; it += NGW) {
        const int m0 = m_lo + it * 16 + 8 * (C.lane >> 5); int t0, T; if (m0 < M_LAT) { t0 = m0 & 4095; T = SEQ; } else { t0 = (m0 - M_LAT) & 255; T = CTXL; }
        const bool head = t0 == 0, tail = t0 + 8 == T;
        v4u xw[11];
#pragma unroll
        for (int j = 0; j < 11; ++j) { const bool ok = !((j < 2 && head) || (j == 10 && tail)); xw[j] = *(const v4u*)(PROJ + (size_t)(ok ? m0 + j - 2 : m0) * NPROJ + 768 + ch0); }
        float xa[8], xb[8], xc[8], xd[8];
        unpack8(xw[0], xa); unpack8(xw[1], xb); unpack8(xw[2], xc);
        if (head) {
#pragma unroll
            for (int e = 0; e < 8; ++e) { xa[e] = 0.f; xb[e] = 0.f; } }
#pragma unroll
        for (int i = 0; i < 8; ++i) { unpack8(xw[i + 3], xd);
            if (i == 7 && tail) {
#pragma unroll
                for (int e = 0; e < 8; ++e) xd[e] = 0.f; }
            float acc[8];
#pragma unroll
            for (int e = 0; e < 8; ++e) acc[e] = cb[e] + cw[0][e] * xa[e] + cw[1][e] * xb[e] + cw[2][e] * xc[e] + cw[3][e] * xd[e];
            const int m = m0 + i, rrow = (m & ~63) + 16 * (m & 3) + ((m & 63) >> 2);
            *(v4u*)(RC + (size_t)rrow * 256 + ch0) = pack8(acc);
#pragma unroll
            for (int e = 0; e < 8; ++e) { xa[e] = xb[e]; xb[e] = xc[e]; xc[e] = xd[e]; } }
      } }
    if (tasks & 8) { const int sub = C.lane & 31, ch0 = sub * 8; float cw[3][8];
#pragma unroll
      for (int e = 0; e < 8; ++e)
#pragma unroll
          for (int k = 0; k < 3; ++k) cw[k][e] = C.sc_conv_w[(l * 3 + k) * 256 + ch0 + e];
      for (int it = gw; it < (m_hi - m_lo) / 16; it += NGW) {
        const int m0 = m_lo + it * 16 + 8 * (C.lane >> 5); int t0, T; if (m0 < M_LAT) { t0 = m0 & 4095; T = SEQ; } else { t0 = (m0 - M_LAT) & 255; T = CTXL; }
        const bool head = t0 == 0, tail = t0 + 8 == T;
        v4u bw[8], cw_[10], uw[10];
#pragma unroll
        for (int j = 0; j < 10; ++j) { const bool ok = !((j == 0 && head) || (j == 9 && tail)); const bf16* rp = PROJ + (size_t)(ok ? m0 + j - 1 : m0) * NPROJ + ch0;
            cw_[j] = *(const v4u*)(rp + 1536); uw[j] = *(const v4u*)(rp + 1792); if (j >= 1 && j <= 8) bw[j - 1] = *(const v4u*)(PROJ + (size_t)(m0 + j - 1) * NPROJ + 1280 + ch0); }
        float pa[8], pb[8], pc[8];
        { float cg[8], u[8]; unpack8(cw_[0], cg); unpack8(uw[0], u);
#pragma unroll
          for (int e = 0; e < 8; ++e) pa[e] = head ? 0.f : cg[e] * u[e];
          unpack8(cw_[1], cg); unpack8(uw[1], u);
#pragma unroll
          for (int e = 0; e < 8; ++e) pb[e] = cg[e] * u[e]; }
#pragma unroll
        for (int i = 0; i < 8; ++i) { float cg[8], u[8], bg[8], o[8]; unpack8(cw_[i + 2], cg); unpack8(uw[i + 2], u); unpack8(bw[i], bg);
#pragma unroll
            for (int e = 0; e < 8; ++e) pc[e] = (i == 7 && tail) ? 0.f : cg[e] * u[e];
#pragma unroll
            for (int e = 0; e < 8; ++e) o[e] = bg[e] * (cw[0][e] * pa[e] + cw[1][e] * pb[e] + cw[2][e] * pc[e]);
            *(v4u*)(MIX + (size_t)(m0 + i) * DM + 768 + ch0) = pack8(o);
#pragma unroll
            for (int e = 0; e < 8; ++e) { pa[e] = pb[e]; pb[e] = pc[e]; } }
      } }
}

__device__ __forceinline__ int chunk_row0(int b, int c) { return c < 4 ? M_LAT + b * CTXL + c * 64 : b * SEQ + (c - 4) * 64; }
__device__ __forceinline__ void phase_scan2(const Ctx& C, int l) {
    const unsigned* __restrict__ LAB = WSP(unsigned, WS_LA); const float* __restrict__ AGP = WSP(float, WS_AGP); const float* __restrict__ AGB = WSP(float, WS_AGB);
    const bf16* __restrict__ PROJ = WSP(bf16, WS_PROJ); bf16* __restrict__ MIX = WSP(bf16, WS_MIX);
    const bool lat_only = (l == DEPTH - 1);
    const int nitems = lat_only ? NB * 64 * 4 : NB * NCHUNK * 4;
    for (int it = C.gw; it < nitems; it += C.NGW) {
        const int chq = it & 3, bc = it >> 2, ch = chq * 64 + C.lane; int b, c; if (lat_only) { b = bc >> 6; c = 4 + (bc & 63); } else { c = bc % NCHUNK; b = bc / NCHUNK; }
        const float* gpF = AGP + ((size_t)(0 * NB + b) * NCHUNK) * 256 + ch; const float* gbF = AGB + ((size_t)(0 * NB + b) * NCHUNK) * 256 + ch;
        const float* gpB = AGP + ((size_t)(1 * NB + b) * NCHUNK) * 256 + ch; const float* gbB = AGB + ((size_t)(1 * NB + b) * NCHUNK) * 256 + ch;
        const int nf = c, nb = c >= 4 ? 71 - c : 3 - c, nt = nf + nb;
        float hf = 0.f, hb = 0.f;
        for (int k0 = 0; k0 < nt; k0 += 24) { float p[24], q[24];
#pragma unroll
            for (int j = 0; j < 24; ++j) { const int k = min(k0 + j, nt - 1); const bool fw = k < nf; const int kb = k - nf, cc = fw ? k : (kb < 4 ? 3 - kb : 71 - kb);
                const float* pp = fw ? gpF : gpB; const float* qq = fw ? gbF : gbB; p[j] = pp[cc * 256]; q[j] = qq[cc * 256]; }
#pragma unroll
            for (int j = 0; j < 24; ++j) { const int k = k0 + j; const bool v = k < nt, fw = k < nf;
                const float pj = v ? p[j] : 1.0f, qj = v ? q[j] : 0.0f;
                hf = fw ? pj * hf + qj : hf; hb = fw ? hb : pj * hb + qj; } }
        const int row0 = chunk_row0(b, c);
        LAS unsigned* TF = (LAS unsigned*)(C.lds + C.wave * 8192); LAS bf16* TG = (LAS bf16*)(C.lds + C.wave * 8192 + 4096); LAS bf16* TO = (LAS bf16*)(C.lds + C.wave * 8192 + 6144);
        const int l4t = C.lane >> 4, l4c = (C.lane & 15) * 4, l8t = C.lane >> 3, l8c = (C.lane & 7) * 8;
        const unsigned* pF = LAB + ((size_t)0 * M_ALL + row0) * 256 + chq * 64 + l4c; const unsigned* pB = LAB + ((size_t)1 * M_ALL + row0) * 256 + chq * 64 + l4c;
        const bf16* pg = PROJ + (size_t)row0 * NPROJ + 1024 + chq * 64 + l8c; bf16* po = MIX + (size_t)row0 * DM + 512 + chq * 64 + l8c;
        float hv[64];
        { v4u wf[16];
#pragma unroll
          for (int q = 0; q < 16; ++q) wf[q] = *(const v4u*)(pF + (size_t)(4 * q + l4t) * 256);
#pragma unroll
          for (int st = 0; st < 4; ++st) {
#pragma unroll
              for (int i = 0; i < 4; ++i) *(LAS v4u*)(TF + (4 * i + l4t) * 64 + l4c) = wf[st * 4 + i];
#pragma unroll
              for (int t = 0; t < 16; ++t) { const unsigned w = TF[t * 64 + C.lane]; hf = __builtin_amdgcn_exp2f(bflo(w)) * hf + bfhi(w); hv[st * 16 + t] = hf; } } }
        { v4u wb[16], wg[8];
#pragma unroll
          for (int q = 0; q < 16; ++q) wb[q] = *(const v4u*)(pB + (size_t)(4 * q + l4t) * 256);
#pragma unroll
          for (int q = 0; q < 8; ++q) wg[q] = *(const v4u*)(pg + (size_t)(8 * q + l8t) * NPROJ);
#pragma unroll
          for (int st = 3; st >= 0; --st) {
#pragma unroll
              for (int i = 0; i < 4; ++i) *(LAS v4u*)(TF + (4 * i + l4t) * 64 + l4c) = wb[st * 4 + i];
#pragma unroll
              for (int j = 0; j < 2; ++j) *(LAS v4u*)(TG + (8 * j + l8t) * 64 + l8c) = wg[st * 2 + j];
#pragma unroll
              for (int t = 15; t >= 0; --t) { const unsigned w = TF[t * 64 + C.lane]; const float g = bf1(TG[t * 64 + C.lane]); hb = __builtin_amdgcn_exp2f(bflo(w)) * hb + bfhi(w);
                  TO[t * 64 + C.lane] = (bf16)(pk2(gelu_tanh_(g) * (hv[st * 16 + t] + hb), 0.f) & 0xffffu); }
#pragma unroll
              for (int j = 0; j < 2; ++j) { const v4u o = *(const LAS v4u*)(TO + (8 * j + l8t) * 64 + l8c); *(v4u*)(po + (size_t)(st * 16 + 8 * j + l8t) * DM) = o; } } }
    }
}

namespace attn_body {
using abf16=__hip_bfloat16;
using bf16x8=__attribute__((ext_vector_type(8)))short;
using s16x4=__attribute__((ext_vector_type(4)))short;
using f32x16=__attribute__((ext_vector_type(16)))float;
using u32x4=__attribute__((ext_vector_type(4)))unsigned;
constexpr int D=64,DM=1024,KVPITCH=128;
constexpr int NW=8,QBLK=32,QB=QBLK*NW,KVBLK=64;
__device__ __forceinline__ int crow(int r,int hi){return (r&3)+8*(r>>2)+4*hi;}
#define SBAR() __builtin_amdgcn_sched_barrier(0)
constexpr int NSLOT=3, SLOTB=8192;
constexpr int LDS_K=0, LDS_V=NSLOT*SLOTB, LDS_WS=2*NSLOT*SLOTB, LDS_OST=LDS_WS+NW*64*4, LDS_BYTES=LDS_OST+NW*4096;
constexpr float C2=0.125f*1.4426950408889634f;
__device__ __forceinline__ void glds16(const void*gsrc,unsigned lds_dst){unsigned keep;
  asm volatile("s_mov_b32 %0, m0\n\ts_mov_b32 m0, %2\n\ts_nop 0\n\tglobal_load_lds_dwordx4 %1, off\n\ts_mov_b32 m0, %0":"=&s"(keep):"v"(gsrc),"s"(lds_dst):"memory");}
__device__ __forceinline__ float max3f(float a,float b,float c){float r;asm("v_max3_f32 %0, %1, %2, %3":"=v"(r):"v"(a),"v"(b),"v"(c));return r;}
__device__ __forceinline__ float max2f(float a,float b){float r;asm("v_max_f32_e32 %0, %1, %2":"=v"(r):"v"(a),"v"(b));return r;}
__device__ __forceinline__ float fadd_s(float a,float b){float r;asm("v_add_f32_e32 %0, %1, %2":"=v"(r):"v"(a),"v"(b));return r;}
__device__ __forceinline__ float fsub_s(float a,float b){float r;asm("v_sub_f32_e32 %0, %1, %2":"=v"(r):"v"(a),"v"(b));return r;}
typedef float f32x2_t __attribute__((ext_vector_type(2))); typedef __bf16 bf16x2_t __attribute__((ext_vector_type(2)));
__device__ __forceinline__ unsigned cvtpk_s(float lo,float hi){f32x2_t v={lo,hi};bf16x2_t b=__builtin_convertvector(v,bf16x2_t);return __builtin_bit_cast(unsigned,b);}
#define WAIT_BAR(N) asm volatile("s_waitcnt vmcnt(" #N ") lgkmcnt(0)\n\ts_barrier":::"memory")

__device__ __forceinline__ void qkt(f32x16&p0,f32x16&p1,const char*Kslot,const bf16x8*qr,const f32x16&negm,int r32,int hi){
  const char*kb=Kslot+hi*1024+r32*16;
  #pragma unroll
  for(int d0=0;d0<4;++d0){
    const bf16x8 b0=*reinterpret_cast<const bf16x8*>(kb+d0*2048);
    const bf16x8 b1=*reinterpret_cast<const bf16x8*>(kb+d0*2048+512);
    if(d0==0){p0=__builtin_amdgcn_mfma_f32_32x32x16_bf16(b0,qr[0],negm,0,0,0);p1=__builtin_amdgcn_mfma_f32_32x32x16_bf16(b1,qr[0],negm,0,0,0);}
    else{p0=__builtin_amdgcn_mfma_f32_32x32x16_bf16(b0,qr[d0],p0,0,0,0);p1=__builtin_amdgcn_mfma_f32_32x32x16_bf16(b1,qr[d0],p1,0,0,0);}}
}
typedef __attribute__((address_space(3))) const char* lds_cptr;
typedef short v4i16_t __attribute__((ext_vector_type(4)));
__device__ __forceinline__ void kload8(bf16x8*kf,lds_cptr kp){
  kf[0]=*(const __attribute__((address_space(3))) bf16x8*)(kp);      kf[1]=*(const __attribute__((address_space(3))) bf16x8*)(kp+512);
  kf[2]=*(const __attribute__((address_space(3))) bf16x8*)(kp+2048); kf[3]=*(const __attribute__((address_space(3))) bf16x8*)(kp+2560);
  kf[4]=*(const __attribute__((address_space(3))) bf16x8*)(kp+4096); kf[5]=*(const __attribute__((address_space(3))) bf16x8*)(kp+4608);
  kf[6]=*(const __attribute__((address_space(3))) bf16x8*)(kp+6144); kf[7]=*(const __attribute__((address_space(3))) bf16x8*)(kp+6656);
}
__device__ __forceinline__ void kload2(bf16x8*kf,lds_cptr kp,int j){ kf[2*j]=*(const __attribute__((address_space(3))) bf16x8*)(kp+j*2048); kf[2*j+1]=*(const __attribute__((address_space(3))) bf16x8*)(kp+j*2048+512); }
__device__ __forceinline__ s16x4 vtr(lds_cptr p){ return __builtin_bit_cast(s16x4,__builtin_amdgcn_ds_read_tr16_b64_v4i16((__attribute__((address_space(3))) v4i16_t*)p)); }
__device__ __forceinline__ void pv(f32x16*o,int vb,bf16x8 pa0,bf16x8 pa1,bf16x8 pa2,bf16x8 pa3){
  #pragma unroll
  for(int d0=0;d0<2;++d0){s16x4 lo[4],hi[4];
    #pragma unroll
    for(int ks=0;ks<4;++ks){
      asm volatile("ds_read_b64_tr_b16 %0,%1 offset:%c2":"=&v"(lo[ks]):"v"(vb),"i"(d0*4096+ks*1024):"memory");
      asm volatile("ds_read_b64_tr_b16 %0,%1 offset:%c2":"=&v"(hi[ks]):"v"(vb),"i"(d0*4096+ks*1024+512):"memory");}
    asm volatile("s_waitcnt lgkmcnt(0)":::"memory");SBAR();
    #define PK(k) (bf16x8){lo[k][0],lo[k][1],lo[k][2],lo[k][3],hi[k][0],hi[k][1],hi[k][2],hi[k][3]}
    o[d0]=__builtin_amdgcn_mfma_f32_32x32x16_bf16(pa0,PK(0),o[d0],0,0,0);
    o[d0]=__builtin_amdgcn_mfma_f32_32x32x16_bf16(pa1,PK(1),o[d0],0,0,0);
    o[d0]=__builtin_amdgcn_mfma_f32_32x32x16_bf16(pa2,PK(2),o[d0],0,0,0);
    o[d0]=__builtin_amdgcn_mfma_f32_32x32x16_bf16(pa3,PK(3),o[d0],0,0,0);
    #undef PK
  }
}

#ifndef ATTN_STORE16
#define ATTN_STORE16(p,v) (*(u32x4*)(p)=(v))
#endif
template<int THRL> __device__ __forceinline__ void attn_unit(abf16*Qb,abf16*Ob,const abf16*__restrict__ Kh,const abf16*__restrict__ Vh,const int NT,char*shm,const int tid,const float mref){
  const int lane=tid&63,r32=lane&31,hi=lane>>5; const int wid=__builtin_amdgcn_readfirstlane(tid>>6);
  const abf16*Qw=Qb+(long)(wid*QBLK)*DM;
  const unsigned lds0=(unsigned)(uintptr_t)shm;
  float*wsf=(float*)(shm+LDS_WS)+wid*64;
  const abf16*ksrc=Kh+(long)lane*KVPITCH+wid*8;
  const abf16*vsrc=Vh+(long)(16*(wid&3)+(lane>>2))*KVPITCH+(wid>>2)*32+(lane&3)*8;
  const unsigned kdst=lds0+LDS_K+wid*1024, vdst=lds0+LDS_V+wid*1024;
  #define DMA_K(t,slot) glds16(ksrc+(long)(t)*KVBLK*KVPITCH,(unsigned)__builtin_amdgcn_readfirstlane(kdst+(slot)))
  #define DMA_V(t,slot) glds16(vsrc+(long)(t)*KVBLK*KVPITCH,(unsigned)__builtin_amdgcn_readfirstlane(vdst+(slot)))
  const int vb0=(int)(lds0+LDS_V)+((lane>>4)&1)*32+(lane&3)*8+(4*hi+((lane&15)>>2))*64;
  const char*Kbase=shm+LDS_K; bf16x8 kf[8];
  const lds_cptr shm3=(lds_cptr)shm; const lds_cptr kp0=shm3+LDS_K+hi*1024+r32*16; const lds_cptr vp0=shm3+LDS_V+((lane>>4)&1)*32+(lane&3)*8+(4*hi+((lane&15)>>2))*64;
  if(wid>=4)__builtin_amdgcn_s_setprio(1);
  DMA_K(0,0);DMA_V(0,0);DMA_K(1,SLOTB);
  bf16x8 qr[4];
  #pragma unroll
  for(int d0=0;d0<4;++d0)qr[d0]=*reinterpret_cast<const bf16x8*>(&Qw[(long)r32*DM+d0*16+hi*8]);
  float l_reg=0.f;f32x16 o[2];o[0]=f32x16{};o[1]=f32x16{};f32x16 negm;
  #pragma unroll
  for(int r=0;r<16;++r)negm[r]=-mref;
  asm volatile("":"+v"(negm));
  #define CMASK(P0,P1,t) do{}while(0)
  #define START(P0,P1) do{ _Pragma("unroll") for(int r=0;r<16;++r)P0[r]=__builtin_amdgcn_exp2f(P0[r]); }while(0)
  #define RESC() do{}while(0)
  f32x16 pA0,pA1,pB0,pB1;
  int sl_prev=0,sl_cur=0,sl_next=SLOTB;
  #define ROT() do{sl_prev=sl_cur;sl_cur=sl_next;sl_next=(sl_next==(NSLOT-1)*SLOTB)?0:sl_next+SLOTB;}while(0)
  DMA_K(2,2*SLOTB);
  WAIT_BAR(3);
  qkt(pA0,pA1,Kbase,qr,negm,r32,hi);asm volatile("s_nop 15\n\ts_nop 7":"+v"(pA0),"+v"(pA1));CMASK(pA0,pA1,0);
  START(pA0,pA1);
  _Pragma("unroll") for(int r=0;r<16;++r)pA1[r]=__builtin_amdgcn_exp2f(pA1[r]);
  WAIT_BAR(0);
  DMA_K(3,0);DMA_V(1,SLOTB);
  ROT();
  kload8(kf,kp0+sl_cur);
  WAIT_BAR(2);
  s16x4 vlo[8],vhi[8]; u32x4 pw0,pw1,pw2,pw3;
  #define PKW(P,B) cvtpk_s(P[B],P[B+1])
  #define PAF(k) __builtin_bit_cast(bf16x8,pw##k)
  #define VFR(i) (bf16x8){vlo[i][0],vlo[i][1],vlo[i][2],vlo[i][3],vhi[i][0],vhi[i][1],vhi[i][2],vhi[i][3]}
  #define PIN(x) asm volatile("":"+v"(x))
  #define MX3(a,b,c) __builtin_fmaxf(__builtin_fmaxf((a),(b)),(c))
  #define GAPA(MF,A0,A1,A2,A3,W0,W1,PW) do{ MF; sacc+=A0; sacc+=A1; sacc+=A2; sacc+=A3; PIN(sacc); W0; W1; PIN(PW); SBAR(); }while(0)
  #define EX(v) __builtin_amdgcn_exp2f(v)
  #define GAPB(MF,X,B) do{ MF; X[B]=EX(X[B]); X[B+1]=EX(X[B+1]); X[B+2]=EX(X[B+2]); X[B+3]=EX(X[B+3]); PIN(X); SBAR(); }while(0)
  #define VRD(i) do{ vlo[i]=vtr(vp_+(((i)>>2)*4096+((i)&3)*1024)); vhi[i]=vtr(vp_+(((i)>>2)*4096+((i)&3)*1024+512)); }while(0)
  #define KRD(G,j) do{ if(G){ kload2(kf,kp0+sl_next,j); SBAR(); } }while(0)
  #define STEP(C0,C1,P0,P1,t,GK,GV,GL) do{ SBAR(); \
    const lds_cptr vp_=vp0+sl_prev; \
    VRD(0); SBAR(); float sacc=(P0[0]+P0[1]); \
    GAPA(C0=__builtin_amdgcn_mfma_f32_32x32x16_bf16(kf[0],qr[0],negm,0,0,0), P0[2],P0[3],P0[4],P0[5],     pw0[0]=PKW(P0,0), pw0[1]=PKW(P0,2), pw0); \
    VRD(4); SBAR(); GAPA(C1=__builtin_amdgcn_mfma_f32_32x32x16_bf16(kf[1],qr[0],negm,0,0,0), P0[6],P0[7],P0[8],P0[9],     pw0[2]=PKW(P0,4), pw0[3]=PKW(P0,6), pw0); \
    VRD(1); SBAR(); GAPA(C0=__builtin_amdgcn_mfma_f32_32x32x16_bf16(kf[2],qr[1],C0,0,0,0),   P0[10],P0[11],P0[12],P0[13], pw1[0]=PKW(P0,8), pw1[1]=PKW(P0,10), pw1); \
    VRD(5); SBAR(); GAPA(C1=__builtin_amdgcn_mfma_f32_32x32x16_bf16(kf[3],qr[1],C1,0,0,0),   P0[14],P0[15],P1[0],P1[1],   pw1[2]=PKW(P0,12),pw1[3]=PKW(P0,14), pw1); \
    VRD(2); SBAR(); GAPA(C0=__builtin_amdgcn_mfma_f32_32x32x16_bf16(kf[4],qr[2],C0,0,0,0),   P1[2],P1[3],P1[4],P1[5],     pw2[0]=PKW(P1,0), pw2[1]=PKW(P1,2), pw2); \
    VRD(6); SBAR(); GAPA(C1=__builtin_amdgcn_mfma_f32_32x32x16_bf16(kf[5],qr[2],C1,0,0,0),   P1[6],P1[7],P1[8],P1[9],     pw2[2]=PKW(P1,4), pw2[3]=PKW(P1,6), pw2); \
    VRD(3); SBAR(); GAPA(C0=__builtin_amdgcn_mfma_f32_32x32x16_bf16(kf[6],qr[3],C0,0,0,0),   P1[10],P1[11],P1[12],P1[13], pw3[0]=PKW(P1,8), pw3[1]=PKW(P1,10), pw3); \
    VRD(7); SBAR(); GAPA(C1=__builtin_amdgcn_mfma_f32_32x32x16_bf16(kf[7],qr[3],C1,0,0,0),   P1[14],P1[15],0.f,0.f,       pw3[2]=PKW(P1,12),pw3[3]=PKW(P1,14), pw3); \
    l_reg+=sacc; \
    if(GK){DMA_K((t)+3,sl_cur);} if(GV){DMA_V((t)+1,sl_next);} \
    CMASK(C0,C1,t); \
    SBAR(); \
    GAPB(o[0]=__builtin_amdgcn_mfma_f32_32x32x16_bf16(PAF(0),VFR(0),o[0],0,0,0), C0,0); \
    GAPB(o[1]=__builtin_amdgcn_mfma_f32_32x32x16_bf16(PAF(0),VFR(4),o[1],0,0,0), C0,4); \
    KRD(GL,0); GAPB(o[0]=__builtin_amdgcn_mfma_f32_32x32x16_bf16(PAF(1),VFR(1),o[0],0,0,0), C0,8); \
    KRD(GL,1); GAPB(o[1]=__builtin_amdgcn_mfma_f32_32x32x16_bf16(PAF(1),VFR(5),o[1],0,0,0), C0,12); \
    KRD(GL,2); GAPB(o[0]=__builtin_amdgcn_mfma_f32_32x32x16_bf16(PAF(2),VFR(2),o[0],0,0,0), C1,0); \
    KRD(GL,3); GAPB(o[1]=__builtin_amdgcn_mfma_f32_32x32x16_bf16(PAF(2),VFR(6),o[1],0,0,0), C1,4); \
    GAPB(o[0]=__builtin_amdgcn_mfma_f32_32x32x16_bf16(PAF(3),VFR(3),o[0],0,0,0), C1,8); \
    GAPB(o[1]=__builtin_amdgcn_mfma_f32_32x32x16_bf16(PAF(3),VFR(7),o[1],0,0,0), C1,12); \
    }while(0)
  int t=1;
  #undef CMASK
  #define CMASK(P0,P1,t) do{}while(0)
  for(;t+5<NT;t+=2){
    STEP(pB0,pB1,pA0,pA1,t,true,true,true);     WAIT_BAR(2); RESC(); ROT();
    STEP(pA0,pA1,pB0,pB1,t+1,true,true,true);   WAIT_BAR(2); RESC(); ROT();
  }
  #undef CMASK
  #define CMASK(P0,P1,t) do{}while(0)
  #define ENDW(tt) do{ if((tt)+3<NT){WAIT_BAR(2);} else if((tt)+2<NT){WAIT_BAR(1);} else {WAIT_BAR(0);} }while(0)
  for(;t+1<NT;t+=2){
    STEP(pB0,pB1,pA0,pA1,t,(t+3<NT),(t+1<NT),(t+1<NT));       ENDW(t);   RESC(); ROT();
    STEP(pA0,pA1,pB0,pB1,t+1,(t+4<NT),(t+2<NT),(t+2<NT));     ENDW(t+1); RESC(); ROT();
  }
  STEP(pB0,pB1,pA0,pA1,NT-1,false,false,false); RESC();
  { float sacc=pB0[0]+pB0[1]; _Pragma("unroll") for(int r=2;r<16;++r)sacc+=pB0[r]; _Pragma("unroll") for(int r=0;r<16;++r)sacc+=pB1[r]; l_reg+=sacc;
    pw0=(u32x4){PKW(pB0,0),PKW(pB0,2),PKW(pB0,4),PKW(pB0,6)};pw1=(u32x4){PKW(pB0,8),PKW(pB0,10),PKW(pB0,12),PKW(pB0,14)};pw2=(u32x4){PKW(pB1,0),PKW(pB1,2),PKW(pB1,4),PKW(pB1,6)};pw3=(u32x4){PKW(pB1,8),PKW(pB1,10),PKW(pB1,12),PKW(pB1,14)};
    SBAR(); pv(o,vb0+sl_cur,PAF(0),PAF(1),PAF(2),PAF(3)); }
  #undef PKW
  #undef PAF
  #undef VFR
  #undef PIN
  #undef MX3
  #undef GAPA
  #undef GAPB
  #undef EX
  #undef VRD
  #undef KRD
  #undef STEP
  #undef ENDW
  __builtin_amdgcn_s_setprio(0);
  {auto rr=__builtin_amdgcn_permlane32_swap(__float_as_uint(l_reg),__float_as_uint(l_reg),false,false);l_reg=__uint_as_float(rr[0])+__uint_as_float(rr[1]);}
  if(hi==0)wsf[32+r32]=l_reg;asm volatile("s_waitcnt lgkmcnt(0)":::"memory");
  float rli[16];
  #pragma unroll
  for(int r=0;r<16;++r)rli[r]=__builtin_amdgcn_rcpf(wsf[32+crow(r,hi)]);
  abf16*Ow=Ob+(long)(wid*QBLK)*DM;
  { abf16*stg=(abf16*)(shm+LDS_OST)+wid*2048;
    #pragma unroll
    for(int r=0;r<16;++r){const int orow=crow(r,hi);
      #pragma unroll
      for(int d0=0;d0<2;++d0)stg[orow*64+d0*32+r32]=__float2bfloat16(o[d0][r]*rli[r]);}
    asm volatile("s_waitcnt lgkmcnt(0)":::"memory");
    #pragma unroll
    for(int i=0;i<4;++i){const int row=i*8+(lane>>3),ch=lane&7; const u32x4 v=*(const u32x4*)(stg+row*64+ch*8); ATTN_STORE16(Ow+(long)row*DM+ch*8,v);} }
  asm volatile("s_waitcnt lgkmcnt(0)\n\ts_barrier":::"memory");
  #undef DMA_K
  #undef DMA_V
  #undef CMASK
  #undef START
  #undef RESC
  #undef ROT
}
constexpr int ATTN_LDS_BYTES=LDS_BYTES;
#undef SBAR
#undef WAIT_BAR
}

__device__ __forceinline__ void phase_attn_fast(const Ctx& C, int l, bool dummy_out = false) {
    using attn_body::abf16;
    abf16* MIX = (abf16*)(C.ws + WS_MIX); const abf16* KB = (const abf16*)(C.ws + WS_KB); const abf16* VB = (const abf16*)(C.ws + WS_VB);
    const int nctx = (l == 0) ? 64 : 0;
    float mq = fabsf(C.g_q[l * 64 + C.lane]), mk = fabsf(C.g_k[l * 64 + C.lane]);
#pragma unroll
    for (int o = 1; o < 64; o <<= 1) { mq = fmaxf(mq, shx(mq, o, C.lane)); mk = fmaxf(mk, shx(mk, o, C.lane)); }
    const float mref = fminf(64.0f * C2 * mq * mk * 1.02f + 0.5f, 96.0f);
    for (int i = 0;; ++i) {
        int U;
        if (C.G == 256) {
            if (i < 4) U = (C.vcu >> 5) * 128 + i * 32 + (C.vcu & 31);
            else if (i == 4 && nctx && (C.vcu & 3) == 0) U = 1024 + (C.vcu >> 2);
            else break;
        } else { U = i * C.G + C.vcu; if (U >= 1024 + nctx) break; }
        int b, h, qrow, key0, NT;
        if (U < 1024) { const int g = U >> 6, r = U & 63; b = g >> 1; h = (g & 1) * 4 + (r >> 4); qrow = b * SEQ + (r & 15) * 256; key0 = 0; NT = KVROWS / 64; }
        else { const int id = U - 1024; b = id >> 3; h = id & 7; qrow = M_LAT + b * CTXL; key0 = SEQ; NT = CTXL / 64; }
        const size_t kvoff = ((size_t)b * KVROWS + key0) * KVP + (h >> 2) * 64;
        abf16* Obase = dummy_out ? (abf16*)(C.ws + WS_AP) : MIX;
        attn_body::attn_unit<8>(MIX + (size_t)qrow * DM + h * 64, Obase + (size_t)qrow * DM + h * 64, KB + kvoff, VB + kvoff, NT, C.lds_gen, C.tid, mref);
    }
}

__device__ __forceinline__ void ffn_fix_panel(const Ctx& C, int l, int pm) {
    const bf16* EDGE = WSP(bf16, WS_EDGE); bf16* ACT = WSP(bf16, WS_ACT);
    for (int idx = C.tid; idx < 2 * 352; idx += NTHREADS) {
        const int side = idx >= 352 ? 1 : 0, j0 = (idx - side * 352) * 8, R = pm * 256;
        bool first, last; if (pm < 128) { first = (R & 4095) == 0; last = ((R + 255) & 4095) == 4095; } else { first = true; last = true; }
        const bf16 *pu, *px, *pd; bool hu, hd; int row;
        if (side == 0) { row = R; hu = !first; hd = true; pu = EDGE + (size_t)((pm - 1) * 4 + 3) * NUP; px = EDGE + (size_t)(pm * 4 + 0) * NUP; pd = EDGE + (size_t)(pm * 4 + 1) * NUP; }
        else { row = R + 255; hu = true; hd = !last; pu = EDGE + (size_t)(pm * 4 + 2) * NUP; px = EDGE + (size_t)(pm * 4 + 3) * NUP; pd = EDGE + (size_t)((pm + 1) * 4 + 0) * NUP; }
        float au[8], ag[8];
#pragma unroll
        for (int e = 0; e < 8; ++e) { au[e] = 0.f; ag[e] = 0.f; }
#pragma unroll
        for (int k = 0; k < 3; ++k) { const bool has = (k == 0) ? hu : (k == 2) ? hd : true; const bf16* rp = ((k == 0) ? pu : (k == 2) ? pd : px) + j0;
            if (has) { float u[8], g[8]; unpack8(*(const v4u*)rp, u); unpack8(*(const v4u*)(rp + DFF), g);
                const float* wu = C.ffn_conv_w + (size_t)(l * 3 + k) * NUP + j0; const f32x4 wu0 = *(const f32x4*)wu, wu1 = *(const f32x4*)(wu + 4), wg0 = *(const f32x4*)(wu + DFF), wg1 = *(const f32x4*)(wu + DFF + 4);
#pragma unroll
                for (int e = 0; e < 4; ++e) { au[e] += wu0[e] * u[e]; au[4 + e] += wu1[e] * u[4 + e]; ag[e] += wg0[e] * g[e]; ag[4 + e] += wg1[e] * g[4 + e]; } } }
        float o[8];
#pragma unroll
        for (int e = 0; e < 8; ++e) o[e] = silu_(ag[e]) * au[e];
        *(v4u*)(ACT + (size_t)row * DFF + j0) = pack8(o);
    }
}
__device__ __forceinline__ void phase_final(const Ctx& C) {
    const float* __restrict__ STA = WSP(float, WS_STA); const bf16* __restrict__ XR = WSP(bf16, WS_XR);
    f32x4 g[2][2];
#pragma unroll
    for (int j = 0; j < 2; ++j) { g[j][0] = *(const f32x4*)(C.g_final + C.lane * 8 + 512 * j); g[j][1] = *(const f32x4*)(C.g_final + C.lane * 8 + 512 * j + 4); }
    for (int m = C.gw; m < M_LAT; m += C.NGW) {
        float s = STA[(size_t)m * 16 + (C.lane & 15)];
        v4u w[2];
#pragma unroll
        for (int j = 0; j < 2; ++j) w[j] = *(const v4u*)(XR + (size_t)m * DM + C.lane * 8 + 512 * j);
        s += shx(s, 1, C.lane); s += shx(s, 2, C.lane); s += shx(s, 4, C.lane); s += shx(s, 8, C.lane);
        const float r = rsqrtf(s * (1.0f / DM) + EPS);
#pragma unroll
        for (int j = 0; j < 2; ++j) { float x[8]; unpack8(w[j], x); float* o = C.out + (size_t)m * DM + C.lane * 8 + 512 * j;
            *(f32x4*)o = (f32x4){x[0], x[1], x[2], x[3]} * r * g[j][0]; *(f32x4*)(o + 4) = (f32x4){x[4], x[5], x[6], x[7]} * r * g[j][1]; }
    }
}

namespace pg8 {
#define PG8_LAS __attribute__((address_space(3)))
typedef unsigned short bf16_t;
typedef short bf16x8 __attribute__((ext_vector_type(8)));
typedef float f32x4 __attribute__((ext_vector_type(4)));
typedef unsigned u32x4 __attribute__((ext_vector_type(4)));
constexpr int BM = 256, BK = 64, HALF = 128, HTB = HALF * BK * 2  , STAGE_BYTES = 8 * HTB, NXCD = 8, WGM = 8;

__host__ __device__ __forceinline__ int lds_byte(int r, int c) { const int st = (r >> 4) * 2 + (c >> 5), rr = r & 15, cc = c & 31, ob = rr * 64 + cc * 2; return st * 1024 + (ob ^ (((ob >> 9) & 1) << 5)); }
__host__ __device__ __forceinline__ void stage_rc(int b, int& R, int& C) { const int st = b / 1024, sb = b % 1024, swz = sb ^ (((sb >> 9) & 1) << 5); R = (st >> 1) * 16 + swz / 64; C = (st & 1) * 32 + (swz % 64) / 2; }
__host__ __device__ __forceinline__ int perm32(int rho) { const int n = rho >> 4, i = rho & 15; return 8 * (i >> 2) + 4 * n + (i & 3); }

struct Unit { int pm, pn; };
struct Gemm { const bf16_t* A; const bf16_t* Bt; int M, N, K; int ksub = 0; };

struct StaticOrder {
    int nM, nN, nwg, G, c;
    __host__ __device__ void init(int M, int N, int G_, int c_) { nM = M / BM; nN = N / BM; nwg = nM * nN; G = G_; c = c_; }
    __host__ __device__ bool next(int i, Unit& u) const {
        const long L = (long)i * G + c; if (L >= nwg) return false;
        int wgid = (int)L; { const int q = nwg / NXCD, r = nwg % NXCD, xcd = wgid % NXCD, off = wgid / NXCD; wgid = (xcd < r ? xcd * (q + 1) : r * (q + 1) + (xcd - r) * q) + off; }
        const int nig = WGM * nN, gid = wgid / nig, fm = gid * WGM, gsz = (nM - fm) < WGM ? (nM - fm) : WGM;
        u.pm = fm + ((wgid % nig) % gsz); u.pn = (wgid % nig) / gsz; return true;
    }
    __device__ __forceinline__ void a_ready(const Unit&) const {}
    __device__ __forceinline__ void done(const Unit&) const {}
};


template <class Epi, class Sched, bool ALIGN_EPI = false, bool SP2 = false>
__device__ __forceinline__ void gemm_phase(PG8_LAS unsigned char* lds, const Gemm g, const Sched& S, const Epi& E, const int tid) {
    const int wid = __builtin_amdgcn_readfirstlane(tid >> 6), lane = tid & 63, wr = wid >> 2, wc = wid & 3, fr = lane & 15, fq = lane >> 4;
    const int K = g.K, nt = (g.ksub ? g.ksub : K) / BK;
#define PG8_KOF(u) (g.ksub ? (size_t)((u).pn & 1) * (size_t)g.ksub * 2 : (size_t)0)
    unsigned voffA[2], voffB[2];
#pragma unroll
    for (int i = 0; i < 2; ++i) { int R, C; stage_rc(tid * 16 + i * 8192, R, C); const int Rb = Epi::PERM ? ((R & ~31) + perm32(R & 31)) : R;
        voffA[i] = (unsigned)(R * K + C) * 2u; voffB[i] = (unsigned)(Rb * K + C) * 2u; }
    const size_t kstep = (size_t)(BK * 2);
    const size_t hstep = (size_t)HALF * K * 2;
    const size_t tstep = 2 * hstep;
    const unsigned ldsw = (unsigned)wid * 1024u;
    const int aoff = lds_byte(wr * 64 + fr, fq * 8), boff = lds_byte(wc * 32 + fr, fq * 8);
#define PG8_SA(b, h) (((b) * 2 + (h)) * HTB)
#define PG8_SB(b, h) ((4 + (b) * 2 + (h)) * HTB)
#define PG8_STAGE(bufoff, gbase, voff) do { _Pragma("unroll") for (int _i = 0; _i < 2; ++_i) \
        __builtin_amdgcn_global_load_lds((const unsigned*)((const char*)(gbase) + (voff)[_i]), (PG8_LAS unsigned*)(lds + (bufoff) + ldsw + _i * 8192), 16, 0, 0); } while (0)
#define PG8_LDA(dst, b, h) do { _Pragma("unroll") for (int m = 0; m < 4; ++m) _Pragma("unroll") for (int k = 0; k < 2; ++k) dst[m][k] = *(const PG8_LAS bf16x8*)(lds + PG8_SA(b, h) + aoff + m * 2048 + k * 1024); } while (0)
#define PG8_LDB(dst, b, h) do { _Pragma("unroll") for (int n = 0; n < 2; ++n) _Pragma("unroll") for (int k = 0; k < 2; ++k) dst[n][k] = *(const PG8_LAS bf16x8*)(lds + PG8_SB(b, h) + boff + n * 2048 + k * 1024); } while (0)
#define PG8_MMA(ai, bj, At, Bt) do { __builtin_amdgcn_s_setprio(1); _Pragma("unroll") for (int m = 0; m < 4; ++m) _Pragma("unroll") for (int n = 0; n < 2; ++n) _Pragma("unroll") for (int k = 0; k < 2; ++k) \
        acc[ai][bj][m][n] = __builtin_amdgcn_mfma_f32_16x16x32_bf16(Bt[n][k], At[m][k], acc[ai][bj][m][n], 0, 0, 0); __builtin_amdgcn_s_setprio(0); } while (0)
#define PG8_WAIT_V(n) asm volatile("s_waitcnt vmcnt(" #n ")" ::: "memory")
#define PG8_WAIT_L(n) asm volatile("s_waitcnt lgkmcnt(" #n ")" ::: "memory")
#define PG8_BAR __builtin_amdgcn_s_barrier()
#define PG8_SCHED __builtin_amdgcn_sched_barrier(0)
    Unit cur, nxt; int ui = 0;
    if (!S.next(0, cur)) return;
    f32x4 acc[2][2][4][2];
#pragma unroll
    for (int a = 0; a < 2; ++a)
#pragma unroll
        for (int b = 0; b < 2; ++b)
#pragma unroll
            for (int m = 0; m < 4; ++m)
#pragma unroll
                for (int n = 0; n < 2; ++n) acc[a][b][m][n] = (f32x4){0.f, 0.f, 0.f, 0.f};
    bf16x8 At[4][2], B0[2][2], B1[2][2];
    const char* cA = (const char*)g.A + (size_t)cur.pm * tstep + PG8_KOF(cur); const char* cB = (const char*)g.Bt + (size_t)cur.pn * tstep + PG8_KOF(cur);
    S.a_ready(cur);
    if constexpr (SP2) {
        PG8_STAGE(PG8_SB(0, 0), cB, voffB); PG8_STAGE(PG8_SB(0, 1), cB + hstep, voffB); PG8_STAGE(PG8_SA(0, 0), cA, voffA); PG8_STAGE(PG8_SA(0, 1), cA + hstep, voffA);
        if (wr == 1) PG8_BAR;
        PG8_WAIT_V(2); PG8_BAR;
        PG8_STAGE(PG8_SB(1, 0), cB + kstep, voffB); PG8_STAGE(PG8_SA(1, 0), cA + kstep, voffA); PG8_STAGE(PG8_SB(1, 1), cB + hstep + kstep, voffB);
        PG8_WAIT_V(6); PG8_BAR;
    } else {
        PG8_STAGE(PG8_SB(0, 0), cB, voffB); PG8_STAGE(PG8_SA(0, 0), cA, voffA); PG8_STAGE(PG8_SB(0, 1), cB + hstep, voffB); PG8_STAGE(PG8_SA(0, 1), cA + hstep, voffA);
        if (wr == 1) PG8_BAR;
        PG8_WAIT_V(4); PG8_BAR;
        PG8_STAGE(PG8_SB(1, 0), cB + kstep, voffB); PG8_STAGE(PG8_SA(1, 0), cA + kstep, voffA); PG8_STAGE(PG8_SB(1, 1), cB + hstep + kstep, voffB);
        PG8_WAIT_V(6); PG8_BAR;
    }
    for (;;) {
        const bool has_next = S.next(ui + 1, nxt);
        const char* nA = has_next ? (const char*)g.A + (size_t)nxt.pm * tstep + PG8_KOF(nxt) : cA; const char* nB = has_next ? (const char*)g.Bt + (size_t)nxt.pn * tstep + PG8_KOF(nxt) : cB;
        for (int t = 0; t < nt; t += 2) {
            const bool last = (t == nt - 2);
            const char* a1 = cA + (size_t)(t + 1) * kstep;
            const char* a2 = last ? nA : cA + (size_t)(t + 2) * kstep; const char* b2 = last ? nB : cB + (size_t)(t + 2) * kstep;
            const char* a3 = a2 + kstep; const char* b3 = b2 + kstep;
            if (last && has_next) S.a_ready(nxt);
            if constexpr (SP2) {
            PG8_LDB(B0, 0, 0); PG8_LDB(B1, 0, 1); PG8_SCHED; PG8_LDA(At, 0, 0); PG8_STAGE(PG8_SA(1, 1), a1 + hstep, voffA);
            PG8_WAIT_V(8); PG8_WAIT_L(0); PG8_BAR; PG8_MMA(0, 0, At, B0); PG8_MMA(0, 1, At, B1); PG8_BAR; PG8_SCHED;
            PG8_LDA(At, 0, 1); PG8_STAGE(PG8_SB(0, 0), b2, voffB); PG8_STAGE(PG8_SB(0, 1), b2 + hstep, voffB); PG8_STAGE(PG8_SA(0, 0), a2, voffA);
            PG8_WAIT_V(8); PG8_WAIT_L(0); PG8_BAR; PG8_MMA(1, 0, At, B0); PG8_MMA(1, 1, At, B1); PG8_BAR; PG8_SCHED;
            PG8_LDB(B0, 1, 0); PG8_LDB(B1, 1, 1); PG8_SCHED; PG8_LDA(At, 1, 0); PG8_STAGE(PG8_SA(0, 1), a2 + hstep, voffA);
            PG8_WAIT_V(8); PG8_WAIT_L(0); PG8_BAR; PG8_MMA(0, 0, At, B0); PG8_MMA(0, 1, At, B1); PG8_BAR; PG8_SCHED;
            PG8_LDA(At, 1, 1); PG8_STAGE(PG8_SB(1, 0), b3, voffB); PG8_STAGE(PG8_SB(1, 1), b3 + hstep, voffB); PG8_STAGE(PG8_SA(1, 0), a3, voffA);
            PG8_WAIT_V(8); PG8_WAIT_L(0); PG8_BAR; PG8_MMA(1, 0, At, B0); PG8_MMA(1, 1, At, B1); PG8_BAR; PG8_SCHED;
            } else {
            PG8_LDB(B0, 0, 0); PG8_SCHED; PG8_LDA(At, 0, 0); PG8_STAGE(PG8_SA(1, 1), a1 + hstep, voffA);
            PG8_WAIT_L(8); PG8_BAR; PG8_WAIT_L(0); PG8_MMA(0, 0, At, B0); PG8_BAR; PG8_SCHED;
            PG8_LDB(B1, 0, 1); PG8_STAGE(PG8_SB(0, 0), b2, voffB);
            PG8_BAR; PG8_WAIT_L(0); PG8_MMA(0, 1, At, B1); PG8_BAR;
            PG8_LDA(At, 0, 1); PG8_STAGE(PG8_SA(0, 0), a2, voffA);
            PG8_BAR; PG8_WAIT_L(0); PG8_MMA(1, 0, At, B0); PG8_BAR; PG8_SCHED;
            PG8_STAGE(PG8_SB(0, 1), b2 + hstep, voffB);
            PG8_WAIT_V(6); PG8_BAR; PG8_MMA(1, 1, At, B1); PG8_BAR;
            PG8_LDB(B0, 1, 0); PG8_SCHED; PG8_LDA(At, 1, 0); PG8_STAGE(PG8_SA(0, 1), a2 + hstep, voffA);
            PG8_WAIT_L(8); PG8_BAR; PG8_WAIT_L(0); PG8_MMA(0, 0, At, B0); PG8_BAR; PG8_SCHED;
            PG8_LDB(B1, 1, 1); PG8_STAGE(PG8_SB(1, 0), b3, voffB);
            PG8_BAR; PG8_WAIT_L(0); PG8_MMA(0, 1, At, B1); PG8_BAR;
            PG8_LDA(At, 1, 1); PG8_STAGE(PG8_SA(1, 0), a3, voffA);
            PG8_BAR; PG8_WAIT_L(0); PG8_MMA(1, 0, At, B0); PG8_BAR; PG8_SCHED;
            PG8_STAGE(PG8_SB(1, 1), b3 + hstep, voffB);
            PG8_WAIT_V(6); PG8_BAR; PG8_MMA(1, 1, At, B1); PG8_BAR;
            }
        }
        if constexpr (ALIGN_EPI) { if (wr == 0) PG8_BAR; }
        if constexpr (!Epi::AFTER_DRAIN) { E(acc, cur, wr, wc, fr, fq); S.done(cur); }
        if (!has_next) break;
#pragma unroll
        for (int a = 0; a < 2; ++a)
#pragma unroll
            for (int b = 0; b < 2; ++b)
#pragma unroll
                for (int m = 0; m < 4; ++m)
#pragma unroll
                    for (int n = 0; n < 2; ++n) acc[a][b][m][n] = (f32x4){0.f, 0.f, 0.f, 0.f};
        cur = nxt; cA = nA; cB = nB; ++ui;
        if constexpr (ALIGN_EPI) { if (wr == 1) PG8_BAR; }
    }
    PG8_WAIT_V(0);
    if constexpr (!ALIGN_EPI) { if (wr == 0) PG8_BAR; }
    PG8_BAR;
    if constexpr (Epi::AFTER_DRAIN) { E.fused(acc, cur, wr, wc, fr, fq, lds, wid, lane); S.done(cur); }
#undef PG8_KOF
#undef PG8_SA
#undef PG8_SB
#undef PG8_STAGE
#undef PG8_LDA
#undef PG8_LDB
#undef PG8_MMA
#undef PG8_WAIT_V
#undef PG8_WAIT_L
#undef PG8_BAR
#undef PG8_SCHED
}
}


struct FastProj {
    static constexpr bool PERM = true, AFTER_DRAIN = false; ProjEpi e; LAS unsigned char* xl;
    __device__ __forceinline__ void operator()(const f32x4 (&acc)[2][2][4][2], const pg8::Unit& u, int wr, int wc, int fr, int fq) const {
        asm volatile("" : "+v"(fr), "+v"(fq));
        LAS float* HS = (LAS float*)xl;
        LAS float* GL = (LAS float*)(xl + 8192);
        const int lrow0 = u.pm * 256 + wr * 64 + fr, grow0 = e.row_off + lrow0, bi = row_bi(e.row_off + u.pm * 256), col0 = u.pn * 256 + wc * 32 + 8 * fq, lane = fq * 16 + fr;
        const int gtile = e.tile0 + u.pn, hsub = wc >> 1, half = wc & 1, tid = (wr * 4 + wc) * 64 + lane;
        const bool qkv = gtile < 3, isq = gtile < 2;
        float rsv[2][4];
        { f32x4 sv[2][4];
#pragma unroll
          for (int ai = 0; ai < 2; ++ai)
#pragma unroll
              for (int m = 0; m < 4; ++m) sv[ai][m] = *(const f32x4*)(e.stats + (size_t)(grow0 + ai * 128 + m * 16) * 16 + fq * 4);
          if (tid < 128) GL[tid] = tid < 64 ? e.gq[tid] : e.gk[tid - 64];
#pragma unroll
          for (int ai = 0; ai < 2; ++ai)
#pragma unroll
              for (int m = 0; m < 4; ++m) { float s = (sv[ai][m].x + sv[ai][m].y) + (sv[ai][m].z + sv[ai][m].w); s += shx(s, 16, lane); s += shx(s, 32, lane); rsv[ai][m] = rsqrtf(s * (1.0f / DM) + EPS); } }
        f32x4 bv[2][2];
#pragma unroll
        for (int bj = 0; bj < 2; ++bj)
#pragma unroll
            for (int n = 0; n < 2; ++n) bv[bj][n] = *(const f32x4*)(e.bias + (size_t)bi * e.ldb + col0 + bj * 128 + 4 * n);
        if (qkv) {
#pragma unroll
            for (int ai = 0; ai < 2; ++ai)
#pragma unroll
                for (int m = 0; m < 4; ++m)
#pragma unroll
                    for (int bj = 0; bj < 2; ++bj) { const f32x4 v0 = acc[ai][bj][m][0] * rsv[ai][m] + bv[bj][0], v1 = acc[ai][bj][m][1] * rsv[ai][m] + bv[bj][1];
                        float q = ((v0.x * v0.x + v0.y * v0.y) + (v0.z * v0.z + v0.w * v0.w)) + ((v1.x * v1.x + v1.y * v1.y) + (v1.z * v1.z + v1.w * v1.w));
                        q += shx(q, 16, lane); q += shx(q, 32, lane);
                        if (fq == 0) HS[((ai * 128 + wr * 64 + m * 16 + fr) * 4 + 2 * bj + hsub) * 2 + half] = q; }
        }
        asm volatile("s_waitcnt lgkmcnt(0)" ::: "memory"); __builtin_amdgcn_s_barrier(); asm volatile("" ::: "memory");
        const int ib = 16 * half + 4 * fq;
#pragma unroll
        for (int ai = 0; ai < 2; ++ai)
#pragma unroll
            for (int m = 0; m < 4; ++m) { int grow = grow0 + ai * 128 + m * 16, hrow = ai * 128 + wr * 64 + m * 16 + fr, lrow = lrow0 + ai * 128 + m * 16;
                asm volatile("" : "+v"(grow), "+v"(hrow), "+v"(lrow));
                const float rs = rsv[ai][m];
                if (!qkv) {
                    bf16* rowp = e.Cout + (size_t)lrow * e.ldc + col0;
#pragma unroll
                    for (int bj = 0; bj < 2; ++bj) { const f32x4 v0 = acc[ai][bj][m][0] * rs + bv[bj][0], v1 = acc[ai][bj][m][1] * rs + bv[bj][1];
                        v4u w; w.x = pk2(v0.x, v0.y); w.y = pk2(v0.z, v0.w); w.z = pk2(v1.x, v1.y); w.w = pk2(v1.z, v1.w); *(v4u*)(rowp + bj * 128) = w; }
                } else {
                    const bool lat = grow < M_LAT; const int t = grow & 4095, pos = half ? (t & 63) : (t >> 6);
                    const f32x4 cs = *(const f32x4*)(e.ropeT + pos * 16 + 4 * fq), sn = *(const f32x4*)(e.ropeT + 1024 + pos * 16 + 4 * fq);
                    int b, kpos; if (lat) { b = grow >> 12; kpos = t; } else { const int mc = grow - M_LAT; b = mc >> 8; kpos = SEQ + (mc & 255); }
#pragma unroll
                    for (int bj = 0; bj < 2; ++bj) { const bool isv = (!isq) && (bj == 1);
                        const f32x2 hp = *(const LAS f32x2*)(HS + (hrow * 4 + 2 * bj + hsub) * 2); const float rinv = rsqrtf((hp.x + hp.y) * (1.0f / 64.0f) + EPS);
                        const int gsel = (isq ? 0 : 64);
                        const f32x4 ga = *(const LAS f32x4*)(GL + gsel + ib), gb = *(const LAS f32x4*)(GL + gsel + 32 + ib);
                        float o[8];
#pragma unroll
                        for (int n = 0; n < 2; ++n) { const f32x4 v = acc[ai][bj][m][n] * rs + bv[bj][n];
                            float a1 = v.x * rinv * ga[2 * n], a2 = v.y * rinv * gb[2 * n], b1 = v.z * rinv * ga[2 * n + 1], b2 = v.w * rinv * gb[2 * n + 1];
                            if (lat) { const float c0 = cs[2 * n], s0 = sn[2 * n], c1 = cs[2 * n + 1], s1 = sn[2 * n + 1];
                                const float ta = a1 * c0 - a2 * s0, tb = a1 * s0 + a2 * c0, tc = b1 * c1 - b2 * s1, td = b1 * s1 + b2 * c1; a1 = ta; a2 = tb; b1 = tc; b2 = td; }
                            const float sc = isq ? C2 : 1.0f;
                            o[4 * n] = isv ? v.x : a1 * sc; o[4 * n + 1] = isv ? v.y : a2 * sc; o[4 * n + 2] = isv ? v.z : b1 * sc; o[4 * n + 3] = isv ? v.w : b2 * sc; }
                        v4u w; w.x = pk2(o[0], o[1]); w.y = pk2(o[2], o[3]); w.z = pk2(o[4], o[5]); w.w = pk2(o[6], o[7]);
                        bf16* dq = e.MIX + (size_t)grow * DM + (gtile * 4 + 2 * bj + hsub) * 64 + 32 * half + 8 * fq;
                        bf16* dkv = (isv ? e.VB : e.KB) + ((size_t)b * KVROWS + kpos) * KVP + hsub * 64 + 32 * half + 8 * fq;
                        *(v4u*)(isq ? dq : dkv) = w; }
                }
                asm volatile("" ::: "memory"); __builtin_amdgcn_sched_barrier(0);
            }
    }
};
template <bool XIN_F32> struct FastRes {
    static constexpr bool PERM = true, AFTER_DRAIN = false; ResEpi e;
    __device__ __forceinline__ void operator()(const f32x4 (&acc)[2][2][4][2], const pg8::Unit& u, int wr, int wc, int fr, int fq) const {
        asm volatile("" : "+v"(fr), "+v"(fq));
        const int pmg = e.pm_off + u.pm, grow0 = pmg * 256 + wr * 64 + fr, bi = row_bi(pmg * 256), col8 = u.pn * 256 + wc * 32 + 8 * fq, lane = fq * 16 + fr;
        f32x4 gt[2][2], gg[2][2], gc[2][2], xf[2][2][2]; v4u xb[2][2];
#pragma unroll
        for (int bj = 0; bj < 2; ++bj) {
#pragma unroll
            for (int n = 0; n < 2; ++n) { const int c = col8 + bj * 128 + 4 * n; gt[bj][n] = *(const f32x4*)(e.gate + (size_t)bi * 6144 + c);
                gg[bj][n] = *(const f32x4*)(e.gn + c); gc[bj][n] = *(const f32x4*)(e.cn + (size_t)bi * 6144 + c);
                if (XIN_F32) xf[0][bj][n] = *(const f32x4*)(e.xi_row(grow0) + c); }
            if (!XIN_F32) xb[0][bj] = *(const v4u*)(e.XR + (size_t)grow0 * DM + col8 + bj * 128); }
#pragma unroll
        for (int bj = 0; bj < 2; ++bj)
#pragma unroll
            for (int n = 0; n < 2; ++n) gg[bj][n] = gg[bj][n] * (gc[bj][n] + 1.0f);
#pragma unroll
        for (int g = 0; g < 8; ++g) { const int ai = g >> 2, m = g & 3, grow = grow0 + ai * 128 + m * 16; float ss = 0.f;
            const int aprow = e.ap_perm ? (grow & ~63) + 16 * (grow & 3) + ((grow & 63) >> 2) : grow;
            if (g < 7) { const int grow1 = grow0 + ((g + 1) >> 2) * 128 + ((g + 1) & 3) * 16;
#pragma unroll
                for (int bj = 0; bj < 2; ++bj) {
                    if (XIN_F32) {
#pragma unroll
                        for (int n = 0; n < 2; ++n) xf[(g + 1) & 1][bj][n] = *(const f32x4*)(e.xi_row(grow1) + col8 + bj * 128 + 4 * n); }
                    else xb[(g + 1) & 1][bj] = *(const v4u*)(e.XR + (size_t)grow1 * DM + col8 + bj * 128); } }
#pragma unroll
            for (int bj = 0; bj < 2; ++bj) { f32x4 x0, x1;
                if (XIN_F32) { x0 = xf[g & 1][bj][0]; x1 = xf[g & 1][bj][1]; }
                else { const v4u w = xb[g & 1][bj]; x0 = (f32x4){bflo(w.x), bfhi(w.x), bflo(w.y), bfhi(w.y)}; x1 = (f32x4){bflo(w.z), bfhi(w.z), bflo(w.w), bfhi(w.w)}; }
                const f32x4 v0 = x0 + gt[bj][0] * acc[ai][bj][m][0], v1 = x1 + gt[bj][1] * acc[ai][bj][m][1];
                ss += ((v0.x * v0.x + v0.y * v0.y) + (v0.z * v0.z + v0.w * v0.w)) + ((v1.x * v1.x + v1.y * v1.y) + (v1.z * v1.z + v1.w * v1.w));
                v4u xo; xo.x = pk2(v0.x, v0.y); xo.y = pk2(v0.z, v0.w); xo.z = pk2(v1.x, v1.y); xo.w = pk2(v1.z, v1.w);
                *(v4u*)(e.XR + (size_t)grow * DM + col8 + bj * 128) = xo;
                if (e.has_ap) { const f32x4 a0 = v0 * gg[bj][0], a1 = v1 * gg[bj][1]; v4u w; w.x = pk2(a0.x, a0.y); w.y = pk2(a0.z, a0.w); w.z = pk2(a1.x, a1.y); w.w = pk2(a1.z, a1.w);
                    *(v4u*)(e.AP + (size_t)aprow * DM + col8 + bj * 128) = w; } }
            ss += shx(ss, 16, lane); ss += shx(ss, 32, lane);
            if (fq == 0) e.stats[(size_t)grow * 16 + u.pn * 4 + wc] = ss;
            asm volatile("" ::: "memory");
        }
    }
};

constexpr int CW_FIN = 8192;
struct FastResFinal {
    static constexpr bool PERM = true, AFTER_DRAIN = false; ResEpi e; const float* gfin; float* outp; float* XB; unsigned* ctl; LAS unsigned char* xl;
    __device__ __forceinline__ void operator()(f32x4 (&acc)[2][2][4][2], const pg8::Unit& u, int wr, int wc, int fr, int fq) const {
        asm volatile("" : "+v"(fr), "+v"(fq));
        LAS float* PL = (LAS float*)xl; LAS float* RS = (LAS float*)(xl + 4096);
        const int grow0 = u.pm * 256 + wr * 64 + fr, bi = row_bi(u.pm * 256), col8 = u.pn * 256 + wc * 32 + 8 * fq, tid = (wr * 4 + wc) * 64 + fq * 16 + fr, lane = fq * 16 + fr;
        f32x4 gt[2][2]; v4u xb[2][2];
#pragma unroll
        for (int bj = 0; bj < 2; ++bj) {
#pragma unroll
            for (int n = 0; n < 2; ++n) gt[bj][n] = *(const f32x4*)(e.gate + (size_t)bi * 6144 + col8 + bj * 128 + 4 * n);
            xb[0][bj] = *(const v4u*)(e.XR + (size_t)grow0 * DM + col8 + bj * 128); }
#pragma unroll
        for (int g = 0; g < 8; ++g) { const int ai = g >> 2, m = g & 3; float ss = 0.f;
            if (g < 7) { const int grow1 = grow0 + ((g + 1) >> 2) * 128 + ((g + 1) & 3) * 16;
#pragma unroll
                for (int bj = 0; bj < 2; ++bj) xb[(g + 1) & 1][bj] = *(const v4u*)(e.XR + (size_t)grow1 * DM + col8 + bj * 128); }
#pragma unroll
            for (int bj = 0; bj < 2; ++bj) { const v4u w = xb[g & 1][bj];
                const f32x4 x0 = (f32x4){bflo(w.x), bfhi(w.x), bflo(w.y), bfhi(w.y)}, x1 = (f32x4){bflo(w.z), bfhi(w.z), bflo(w.w), bfhi(w.w)};
                const f32x4 v0 = x0 + gt[bj][0] * acc[ai][bj][m][0], v1 = x1 + gt[bj][1] * acc[ai][bj][m][1]; acc[ai][bj][m][0] = v0; acc[ai][bj][m][1] = v1;
                ss += ((v0.x * v0.x + v0.y * v0.y) + (v0.z * v0.z + v0.w * v0.w)) + ((v1.x * v1.x + v1.y * v1.y) + (v1.z * v1.z + v1.w * v1.w)); }
            ss += shx(ss, 16, lane); ss += shx(ss, 32, lane);
            if (fq == 0) PL[(ai * 128 + wr * 64 + m * 16 + fr) * 4 + wc] = ss;
            asm volatile("" ::: "memory"); }
        asm volatile("s_waitcnt lgkmcnt(0)" ::: "memory"); __builtin_amdgcn_s_barrier(); asm volatile("" ::: "memory");
        if (tid < 256) { const f32x4 p = *(const LAS f32x4*)(PL + tid * 4); const float s = (p.x + p.y) + (p.z + p.w);
            __hip_atomic_store(XB + (size_t)(u.pm * 256 + tid) * 4 + u.pn, s, __ATOMIC_RELAXED, __HIP_MEMORY_SCOPE_AGENT); }
        asm volatile("s_waitcnt vmcnt(0)" ::: "memory"); __builtin_amdgcn_s_barrier(); asm volatile("" ::: "memory");
        if (tid == 0) __hip_atomic_fetch_add(ctl + CW_FIN + 64 * u.pm, 1u, __ATOMIC_RELAXED, __HIP_MEMORY_SCOPE_AGENT);
        if (tid < 64) { unsigned sp = 0;
            while ((unsigned)__builtin_amdgcn_readfirstlane((int)__hip_atomic_load(ctl + CW_FIN + 64 * u.pm, __ATOMIC_RELAXED, __HIP_MEMORY_SCOPE_AGENT)) < 4u) { __builtin_amdgcn_s_sleep(2); if (++sp > (1u << 22)) break; }
            __builtin_amdgcn_fence(__ATOMIC_ACQUIRE, "agent"); asm volatile("s_waitcnt vmcnt(0)" ::: "memory"); }
        asm volatile("" ::: "memory"); __builtin_amdgcn_s_barrier(); asm volatile("" ::: "memory");
        if (tid < 256) { const float* xbp = XB + (size_t)(u.pm * 256 + tid) * 4; float t = 0.f;
#pragma unroll
            for (int p = 0; p < 4; ++p) t += __hip_atomic_load(xbp + p, __ATOMIC_RELAXED, __HIP_MEMORY_SCOPE_AGENT);
            RS[tid] = rsqrtf(t * (1.0f / DM) + EPS); }
        asm volatile("s_waitcnt lgkmcnt(0)" ::: "memory"); __builtin_amdgcn_s_barrier(); asm volatile("" ::: "memory");
        f32x4 gf[2][2];
#pragma unroll
        for (int bj = 0; bj < 2; ++bj)
#pragma unroll
            for (int n = 0; n < 2; ++n) gf[bj][n] = *(const f32x4*)(gfin + col8 + bj * 128 + 4 * n);
#pragma unroll
        for (int g = 0; g < 8; ++g) { const int ai = g >> 2, m = g & 3, grow = grow0 + ai * 128 + m * 16; const float rs = RS[ai * 128 + wr * 64 + m * 16 + fr]; float* xn = outp + (size_t)grow * DM + col8;
#pragma unroll
            for (int bj = 0; bj < 2; ++bj)
#pragma unroll
                for (int n = 0; n < 2; ++n) *(f32x4*)(xn + bj * 128 + 4 * n) = acc[ai][bj][m][n] * rs * gf[bj][n]; }
    }
};

__device__ __forceinline__ unsigned dpp_ror1(unsigned v) { return (unsigned)__builtin_amdgcn_update_dpp(0, (int)v, 0x121, 0xf, 0xf, false); }
__device__ __forceinline__ unsigned dpp_ror15(unsigned v) { return (unsigned)__builtin_amdgcn_update_dpp(0, (int)v, 0x12F, 0xf, 0xf, false); }
struct FastUpConv {
    static constexpr bool PERM = true, AFTER_DRAIN = false;
    bf16* ACT; bf16* EDGE; const float* stats; const float* bias; const float* cw; LAS unsigned char* xl;
    static __device__ __forceinline__ float ror1f(float v) { return __int_as_float(__builtin_amdgcn_mov_dpp(__float_as_int(v), 0x121, 0xf, 0xf, false)); }
    static __device__ __forceinline__ float shr1_old(float old, float v) { return __int_as_float(__builtin_amdgcn_update_dpp(__float_as_int(old), __float_as_int(v), 0x111, 0xf, 0xf, false)); }
    static __device__ __forceinline__ float shl1_old(float old, float v) { return __int_as_float(__builtin_amdgcn_update_dpp(__float_as_int(old), __float_as_int(v), 0x101, 0xf, 0xf, false)); }
    static __device__ __forceinline__ float sg_(float g2, float u2) { return g2 * u2 * __builtin_amdgcn_rcpf(1.0f + __builtin_amdgcn_exp2f(g2)); }
    static __device__ __forceinline__ float ror15f(float v) { return __int_as_float(__builtin_amdgcn_mov_dpp(__float_as_int(v), 0x12F, 0xf, 0xf, false)); }
    __device__ __forceinline__ void operator()(f32x4 (&acc)[2][2][4][2], const pg8::Unit& u, int wr, int wc, int fr, int fq) const {
        asm volatile("" : "+v"(fr), "+v"(fq));
        LAS float* EX = (LAS float*)xl; LAS float* RS = (LAS float*)(xl + 8192); LAS float* CT = (LAS float*)(xl + 9216);
        const int trow0 = wr * 64 + 4 * fr;
        const int bi = row_bi(u.pm * 256), j0 = u.pn * 128 + wc * 32 + 8 * fq, tid = (wr * 4 + wc) * 64 + fq * 16 + fr;
        const int ct0 = wc * 32 + 8 * fq;
        { const int which = (wr * 4 + wc) >> 1  , c = (tid * 2) & 255, col = (c >> 7) * DFF + u.pn * 128 + (c & 127);
          const f32x2 vb = *(const f32x2*)(bias + (size_t)bi * NUP + col), vw = *(const f32x2*)(cw + (size_t)(which > 0 ? which - 1 : 0) * NUP + col);
          const float csc = (c >> 7) ? -1.4426950408889634f : -0.6931471805599453f;
          const f32x2 v = which == 0 ? vb : vw * csc;
          if (tid < 256) { const f32x4* sp = (const f32x4*)(stats + (size_t)(u.pm * 256 + tid) * 16); const f32x4 a = sp[0], b = sp[1], c4 = sp[2], d = sp[3];
              const float s = ((a.x + a.y) + (a.z + a.w)) + ((b.x + b.y) + (b.z + b.w)) + ((c4.x + c4.y) + (c4.z + c4.w)) + ((d.x + d.y) + (d.z + d.w));
              RS[tid] = rsqrtf(s * (1.0f / DM) + EPS); }
          *(LAS f32x2*)(CT + which * 256 + c) = v; }
        asm volatile("s_waitcnt lgkmcnt(0)" ::: "memory"); __builtin_amdgcn_s_barrier(); asm volatile("" ::: "memory");
        { f32x4 bv[2][2];
#pragma unroll
          for (int bj = 0; bj < 2; ++bj)
#pragma unroll
              for (int n = 0; n < 2; ++n) bv[bj][n] = *(const LAS f32x4*)(CT + bj * 128 + ct0 + 4 * n);
#pragma unroll
          for (int ai = 0; ai < 2; ++ai) { const f32x4 rs4 = *(const LAS f32x4*)(RS + ai * 128 + trow0);
#pragma unroll
              for (int m = 0; m < 4; ++m)
#pragma unroll
                  for (int bj = 0; bj < 2; ++bj)
#pragma unroll
                      for (int n = 0; n < 2; ++n) acc[ai][bj][m][n] = acc[ai][bj][m][n] * rs4[m] + bv[bj][n]; } }
#pragma unroll
        for (int ai = 0; ai < 2; ++ai) { const int s = 2 * ai + wr;
#pragma unroll
            for (int bj = 0; bj < 2; ++bj)
#pragma unroll
                for (int n = 0; n < 2; ++n) {
                    if (fr == 0) *(LAS f32x4*)(EX + ((s * 2 + 0) * 4 + wc) * 64 + (bj * 2 + n) * 16 + fq * 4) = acc[ai][bj][0][n];
                    if (fr == 15) *(LAS f32x4*)(EX + ((s * 2 + 1) * 4 + wc) * 64 + (bj * 2 + n) * 16 + fq * 4) = acc[ai][bj][3][n]; } }
        if (wr == 0 && fr == 0) {
#pragma unroll
            for (int m = 0; m < 2; ++m)
#pragma unroll
                for (int bj = 0; bj < 2; ++bj)
#pragma unroll
                    for (int n = 0; n < 2; ++n) { const f32x4 v = acc[0][bj][m][n]; v2u w; w.x = pk2(v.x, v.y); w.y = pk2(v.z, v.w); *(v2u*)(EDGE + (size_t)(u.pm * 4 + m) * NUP + bj * DFF + j0 + 4 * n) = w; } }
        if (wr == 1 && fr == 15) {
#pragma unroll
            for (int m = 2; m < 4; ++m)
#pragma unroll
                for (int bj = 0; bj < 2; ++bj)
#pragma unroll
                    for (int n = 0; n < 2; ++n) { const f32x4 v = acc[1][bj][m][n]; v2u w; w.x = pk2(v.x, v.y); w.y = pk2(v.z, v.w); *(v2u*)(EDGE + (size_t)(u.pm * 4 + m) * NUP + bj * DFF + j0 + 4 * n) = w; } }
        asm volatile("s_waitcnt lgkmcnt(0)" ::: "memory"); __builtin_amdgcn_s_barrier(); asm volatile("" ::: "memory");
#pragma unroll
        for (int ai = 0; ai < 2; ++ai) { const int s = 2 * ai + wr; v2u keep[4];
#pragma unroll
            for (int n = 0; n < 2; ++n) { f32x4 cv[2][4];
#pragma unroll
                for (int bj = 0; bj < 2; ++bj) {
                    const f32x4 top = *(const LAS f32x4*)(EX + (((ai == 0 ? 0 : s - 1) * 2 + 1) * 4 + wc) * 64 + (bj * 2 + n) * 16 + fq * 4);
                    const f32x4 bot = *(const LAS f32x4*)(EX + (((ai == 1 ? 3 : s + 1) * 2 + 0) * 4 + wc) * 64 + (bj * 2 + n) * 16 + fq * 4);
                    const f32x4 w0 = *(const LAS f32x4*)(CT + 1 * 256 + bj * 128 + ct0 + 4 * n), w1 = *(const LAS f32x4*)(CT + 2 * 256 + bj * 128 + ct0 + 4 * n), w2 = *(const LAS f32x4*)(CT + 3 * 256 + bj * 128 + ct0 + 4 * n);
                    f32x4 up0, dn3;
#pragma unroll
                    for (int k = 0; k < 4; ++k) { up0[k] = shr1_old(top[k], acc[ai][bj][3][n][k]); dn3[k] = shl1_old(bot[k], acc[ai][bj][0][n][k]); }
#pragma unroll
                    for (int m = 0; m < 4; ++m) { const f32x4 up = (m > 0) ? acc[ai][bj][m - 1][n] : up0, dn = (m < 3) ? acc[ai][bj][m + 1][n] : dn3;
                        cv[bj][m] = w0 * up + w1 * acc[ai][bj][m][n] + w2 * dn; } }
#pragma unroll
                for (int m = 0; m < 4; ++m) { v2u o; o.x = pk2(sg_(cv[1][m].x, cv[0][m].x), sg_(cv[1][m].y, cv[0][m].y)); o.y = pk2(sg_(cv[1][m].z, cv[0][m].z), sg_(cv[1][m].w, cv[0][m].w));
                    if (n == 0) keep[m] = o;
                    else { v4u w4; w4.x = keep[m].x; w4.y = keep[m].y; w4.z = o.x; w4.w = o.y; *(v4u*)(ACT + (size_t)(u.pm * 256 + ai * 128 + trow0 + m) * DFF + j0) = w4; } }
            } }
    }
};

template <int DSH> __device__ __forceinline__ float dpp_up(float v) { return __int_as_float(__builtin_amdgcn_mov_dpp(__float_as_int(v), 0x120 + (16 - DSH), 0xf, 0xf, false)); }
template <int DIR> __device__ __forceinline__ void aff_step(float& P, float& B, const float Ps, const float Bs) {
    if (DIR == 0) { B = Ps * B + Bs; P = P * Ps; } else { B = P * Bs + B; P = P * Ps; }
}
struct FastGates {
    static constexpr bool PERM = false, AFTER_DRAIN = false; GatesEpi e; LAS unsigned char* xl;
    __device__ __forceinline__ void operator()(const f32x4 (&acc)[2][2][4][2], const pg8::Unit& u, int wr, int wc, int fr, int fq) const {
        asm volatile("" : "+v"(fr), "+v"(fq));
        LAS float* PR = (LAS float*)xl;
        const int srow0 = u.pm * 256 + wr * 64 + fr;
        const int trow0 = u.pm * 256 + wr * 64 + 4 * fr;
        const int dir = u.pn >> 1, chb = (u.pn & 1) * 128, cl0 = wc * 32 + 4 * fq, ch0 = chb + cl0, tid = (wr * 4 + wc) * 64 + fq * 16 + fr;
        { const int which = (wr * 4 + wc) >> 1  , c = tid & 127;
          if (which < 3) { const int i = dir * 256 + chb + c; const float v0 = e.ba[i], v1 = e.bi_[i], v2 = e.spl[i] * (-8.0f * 1.4426950408889634f);
              PR[which * 128 + c] = which == 0 ? v0 * -1.4426950408889634f : which == 1 ? v1 * -1.4426950408889634f : v2; } }
        asm volatile("s_waitcnt lgkmcnt(0)" ::: "memory"); __builtin_amdgcn_s_barrier(); asm volatile("" ::: "memory");
#pragma unroll
        for (int ai = 0; ai < 2; ++ai) {
            v2u xr[4][2];
#pragma unroll
            for (int m = 0; m < 4; ++m)
#pragma unroll
                for (int n = 0; n < 2; ++n) xr[m][n] = *(const v2u*)(e.RC + (size_t)(srow0 + ai * 128 + m * 16) * 256 + ch0 + 16 * n);
#pragma unroll
            for (int n = 0; n < 2; ++n) {
                const f32x4 vba = *(const LAS f32x4*)(PR + cl0 + 16 * n), vbi = *(const LAS f32x4*)(PR + 128 + cl0 + 16 * n), vsp = *(const LAS f32x4*)(PR + 256 + cl0 + 16 * n);
                float Pa[4], Ba[4];
#pragma unroll
                for (int m = 0; m < 4; ++m) {
                    const v2u xw = xr[m][n]; const float xf[4] = {bflo(xw.x), bfhi(xw.x), bflo(xw.y), bfhi(xw.y)};
                    const f32x4 ya = acc[ai][0][m][n], yi = acc[ai][1][m][n];
                    v4u pw;
#pragma unroll
                    for (int k = 0; k < 4; ++k) { const float rg = __builtin_amdgcn_rcpf(1.0f + __builtin_amdgcn_exp2f(__builtin_fmaf(ya[k], -1.4426950408889634f, vba[k]))), ig = __builtin_amdgcn_rcpf(1.0f + __builtin_amdgcn_exp2f(__builtin_fmaf(yi[k], -1.4426950408889634f, vbi[k])));
                        const float la2 = bflo(pk2(rg * vsp[k], 0.f));
                        const float P = __builtin_amdgcn_exp2f(la2);
                        const float bb = __builtin_amdgcn_sqrtf(__builtin_fminf(__builtin_fmaxf(1.0f - P * P, 0.f), 1.0f)) * (ig * xf[k]);
                        const unsigned w = pk2(la2, bb); pw[k] = w; const float B = bfhi(w);
                        if (m == 0) { Pa[k] = P; Ba[k] = B; } else if (dir == 0) aff_step<0>(Pa[k], Ba[k], P, B); else aff_step<1>(Pa[k], Ba[k], P, B); }
                    *(v4u*)(e.LAB + ((size_t)dir * M_ALL + trow0 + ai * 128 + m) * 256 + ch0 + 16 * n) = pw;
                }
                if (dir == 0) {
#pragma unroll
                    for (int k = 0; k < 4; ++k) { aff_step<0>(Pa[k], Ba[k], dpp_up<1>(Pa[k]), dpp_up<1>(Ba[k])); aff_step<0>(Pa[k], Ba[k], dpp_up<2>(Pa[k]), dpp_up<2>(Ba[k]));
                        aff_step<0>(Pa[k], Ba[k], dpp_up<4>(Pa[k]), dpp_up<4>(Ba[k])); aff_step<0>(Pa[k], Ba[k], dpp_up<8>(Pa[k]), dpp_up<8>(Ba[k])); }
                } else {
#pragma unroll
                    for (int k = 0; k < 4; ++k) { aff_step<1>(Pa[k], Ba[k], dpp_up<1>(Pa[k]), dpp_up<1>(Ba[k])); aff_step<1>(Pa[k], Ba[k], dpp_up<2>(Pa[k]), dpp_up<2>(Ba[k]));
                        aff_step<1>(Pa[k], Ba[k], dpp_up<4>(Pa[k]), dpp_up<4>(Ba[k])); aff_step<1>(Pa[k], Ba[k], dpp_up<8>(Pa[k]), dpp_up<8>(Ba[k])); }
                }
                if (fr == 0) { const int s = 2 * ai + wr; int b, c; if (u.pm < 128) { b = u.pm >> 4; c = 4 + (u.pm & 15) * 4 + s; } else { b = u.pm - 128; c = s; }
                    const size_t o = ((size_t)(dir * NB + b) * NCHUNK + c) * 256 + ch0 + 16 * n;
                    *(f32x4*)(e.AGP + o) = (f32x4){Pa[0], Pa[1], Pa[2], Pa[3]}; *(f32x4*)(e.AGB + o) = (f32x4){Ba[0], Ba[1], Ba[2], Ba[3]}; }
                asm volatile("" ::: "memory"); __builtin_amdgcn_sched_barrier(0);
            }
        }
    }
};

struct GenOrder {
    pg8::StaticOrder map; int b1, s1, n1, b2, s2, n2;
    __device__ __forceinline__ void strided(int M, int N, int first, int stride) { map.init(M, N, 1, 0); b1 = first; s1 = stride; n1 = 1 << 20; b2 = 0; s2 = 0; n2 = 0; }
    __device__ __forceinline__ bool next(int i, pg8::Unit& u) const { int L; if (i < n1) L = b1 + i * s1; else if (i < n1 + n2) L = b2 + (i - n1) * s2; else return false; return map.next(L, u); }
    __device__ __forceinline__ void a_ready(const pg8::Unit&) const {}
    __device__ __forceinline__ void done(const pg8::Unit&) const {}
};
__device__ __forceinline__ void gemm_proj(const Ctx& C, const bf16* A, const bf16* Bt, int Mrows, int N, int K, const GenOrder& S, const ProjEpi& E) {
    pg8::Gemm g{A, Bt, Mrows, N, K}; FastProj F{E, C.lds + EXCH_OFF};
    pg8::gemm_phase<FastProj, GenOrder, true, true>(C.lds, g, S, F, C.tid);
}
template <bool XIN_F32> __device__ __forceinline__ void gemm_res(const Ctx& C, const bf16* A, const bf16* Bt, int Mrows, int K, const GenOrder& S, const ResEpi& E) {
    pg8::Gemm g{A, Bt, Mrows, DM, K}; FastRes<XIN_F32> F{E};
    pg8::gemm_phase<FastRes<XIN_F32>, GenOrder, true, true>(C.lds, g, S, F, C.tid);
}
__device__ __forceinline__ void gemm_res_final(const Ctx& C, const bf16* A, const bf16* Bt, int Mrows, int K, const GenOrder& S, const ResEpi& E) {
    pg8::Gemm g{A, Bt, Mrows, DM, K}; FastResFinal F{E, C.g_final, C.out, (float*)(C.ws + WS_AGP), (unsigned*)(C.ws + WS_CTL), C.lds + EXCH_OFF};
    pg8::gemm_phase<FastResFinal, GenOrder, true, true>(C.lds, g, S, F, C.tid);
}
__device__ __forceinline__ void gemm_gates(const Ctx& C, const bf16* A, const bf16* Bt, const GatesEpi& E) {
    pg8::Gemm g{A, Bt, M_ALL, 1024, 256, 128}; GenOrder S; S.strided(M_ALL, 1024, (int)blockIdx.x, C.G); FastGates F{E, C.lds + EXCH_OFF};
    pg8::gemm_phase<FastGates, GenOrder, true, true>(C.lds, g, S, F, C.tid);
}
__device__ __forceinline__ void gemm_upconv(const Ctx& C, int l, int Mrows) {
    pg8::Gemm g{(const bf16*)(C.ws + WS_AP), (const bf16*)(C.ws + WS_WUP + l * SZ_WUP), Mrows, NUP, DM}; GenOrder S; S.strided(Mrows, NUP, (int)blockIdx.x, C.G);
    FastUpConv F{(bf16*)(C.ws + WS_ACT), (bf16*)(C.ws + WS_EDGE), (const float*)(C.ws + WS_STB), (const float*)(C.ws + WS_BUP) + (size_t)l * 9 * NUP, C.ffn_conv_w + (size_t)l * 3 * NUP, C.lds + EXCH_OFF};
    pg8::gemm_phase<FastUpConv, GenOrder, true, true>(C.lds, g, S, F, C.tid);
}


typedef GAS unsigned gu32;
#define RLX_AGENT __ATOMIC_RELAXED, __HIP_MEMORY_SCOPE_AGENT
#define XB_TMO      128
#define XB_XCNT(j)  (256  + 64 * (j))
#define XB_XSUB(j)  (1280 + 64 * (j))
#define XB_XGEN(j)  (2304 + 64 * (j))
#define XB_TOP      3328
#define XB_TOPGEN   3392
#define XCD_BAR_WORDS 3456
#define XB_SPIN_CAP (1u << 18)

__device__ __forceinline__ unsigned xb_ld(unsigned* p)              { return __hip_atomic_load(p, __ATOMIC_RELAXED, __HIP_MEMORY_SCOPE_AGENT); }
__device__ __forceinline__ unsigned xb_add(unsigned* p, unsigned v) { return __hip_atomic_fetch_add(p, v, __ATOMIC_RELAXED, __HIP_MEMORY_SCOPE_AGENT); }
__device__ __forceinline__ unsigned xb_xcc_id() { return (unsigned)__builtin_amdgcn_s_getreg((3 << 11) | 20) & 0xFu; }
#define XB_SPIN(cond, bar) do { unsigned _sp = 0; while (cond) { __builtin_amdgcn_s_sleep(1); \
    if ((++_sp & 255u) == 0u) { if (xb_ld(&(bar)[XB_TMO])) break; if (_sp > XB_SPIN_CAP) { atomicAdd(&(bar)[XB_TMO], 1u); break; } } } } while (0)

struct XcdBarrier {
    int wave;
    unsigned* bar; unsigned x;
    volatile LAS unsigned* st;
};

__device__ __forceinline__ bool xb_leader(int wave) { return wave == 0 && __builtin_amdgcn_mbcnt_hi(~0u, __builtin_amdgcn_mbcnt_lo(~0u, 0u)) == 0u; }
__device__ __forceinline__ XcdBarrier xcd_barrier_post(unsigned* bar, volatile LAS unsigned* st, int wave) {
    XcdBarrier b; b.wave = wave; b.bar = bar; b.x = xb_xcc_id(); b.st = st;
    if (xb_leader(wave)) (void)xb_add(&bar[XB_XCNT(b.x)], 1u);
    return b;
}
__device__ __forceinline__ void xcd_barrier_complete(unsigned* bar, unsigned x, unsigned& nloc, unsigned& nx) {
    const unsigned G = gridDim.x * gridDim.y * gridDim.z;
    unsigned sum, cnt, mine, sp = 0u;
    for (;;) {
        sum = 0u; cnt = 0u; mine = 0u;
#pragma unroll
        for (unsigned j = 0; j < 16; ++j) { const unsigned c = xb_ld(&bar[XB_XCNT(j)]); sum += c; cnt += (c > 0u) ? 1u : 0u; mine = (j == x) ? c : mine; }
        if (sum == G) break;
        __builtin_amdgcn_s_sleep(1);
        if ((++sp & 255u) == 0u) { if (xb_ld(&bar[XB_TMO])) break; if (sp > XB_SPIN_CAP) { atomicAdd(&bar[XB_TMO], 1u); break; } }
    }
    nloc = mine > 0u ? mine : 1u; nx = cnt > 0u ? cnt : 1u;
}

__device__ __forceinline__ void xcd_barrier(const XcdBarrier& b) {
    asm volatile("s_waitcnt vmcnt(0)" ::: "memory");
    __syncthreads();
    if (xb_leader(b.wave)) {
        unsigned* bar = b.bar;
        __builtin_amdgcn_s_waitcnt(0);
        unsigned nloc = b.st[0], nx = b.st[1];
        if (nloc == 0u) { xcd_barrier_complete(bar, b.x, nloc, nx); b.st[0] = nloc; b.st[1] = nx; }
        const unsigned old = xb_add(&bar[XB_XSUB(b.x)], 1u);
        const unsigned gen = old / nloc;
        if (old + 1u == (gen + 1u) * nloc) {
            __builtin_amdgcn_fence(__ATOMIC_RELEASE, "agent");
            asm volatile("s_waitcnt vmcnt(0)" ::: "memory");
            const unsigned og = xb_add(&bar[XB_TOP], 1u);
            const unsigned tg = og / nx;
            if (og + 1u == (tg + 1u) * nx) xb_add(&bar[XB_TOPGEN], 1u);
            else XB_SPIN(xb_ld(&bar[XB_TOPGEN]) == tg, bar);
            __builtin_amdgcn_fence(__ATOMIC_ACQUIRE, "agent");
            xb_add(&bar[XB_XGEN(b.x)], 1u);
            asm volatile("s_waitcnt vmcnt(0)" ::: "memory");
        } else {
            XB_SPIN(xb_ld(&bar[XB_XGEN(b.x)]) == gen, bar);
            __builtin_amdgcn_fence(__ATOMIC_ACQUIRE, "agent");
            asm volatile("s_waitcnt vmcnt(0)" ::: "memory");
        }
    }
    __syncthreads();
}

constexpr int CW_GSYNC = 3840;
__device__ __forceinline__ void grid_arrive(unsigned* word, int wave) {
    asm volatile("s_waitcnt vmcnt(0)" ::: "memory"); __syncthreads();
    if (xb_leader(wave)) { __builtin_amdgcn_fence(__ATOMIC_RELEASE, "agent"); asm volatile("s_waitcnt vmcnt(0)" ::: "memory"); (void)xb_add(word, 1u); }
}
__device__ __forceinline__ void grid_wait(unsigned* word, unsigned target, int wave) {
    if (xb_leader(wave)) { unsigned sp = 0; while (xb_ld(word) < target) { __builtin_amdgcn_s_sleep(2); if (++sp > (1u << 22)) break; }
        __builtin_amdgcn_fence(__ATOMIC_ACQUIRE, "agent"); asm volatile("s_waitcnt vmcnt(0)" ::: "memory"); }
    __syncthreads();
}

constexpr int PH_PER_LAYER = 7, PH_FINAL = 2 + DEPTH * PH_PER_LAYER, N_PHASES = PH_FINAL + 1;
__global__ void __launch_bounds__(NTHREADS, 2) fwd_kernel(Args args) {
    extern __shared__ __attribute__((aligned(16))) unsigned char lds_raw[];
    Ctx C;
    C.lds = (LAS unsigned char*)lds_raw; C.lds_gen = (char*)lds_raw; C.wave = __builtin_amdgcn_readfirstlane((int)threadIdx.x >> 6); C.lane = (int)__builtin_amdgcn_mbcnt_hi(~0u, __builtin_amdgcn_mbcnt_lo(~0u, 0u)); C.tid = C.wave * 64 + C.lane;
    C.G = gridDim.x; { const int bx = blockIdx.x; C.vcu = (C.G % 8 == 0) ? (bx % 8) * (C.G / 8) + bx / 8 : bx; }
    C.gw = C.vcu * NWAVES + C.wave; C.NGW = C.G * NWAVES;
    const int lo = args.ph_lo, hi = args.ph_hi;
    for (int u = C.tid; u < (LDS_BYTES - LDSCTL_OFF) / 4; u += NTHREADS) ((LAS unsigned*)(C.lds + LDSCTL_OFF))[u] = 0u;
    __syncthreads();
    XcdBarrier bar; bar.wave = C.wave; bar.bar = (unsigned*)(args.ws + WS_CTL) + CW_BAR; bar.x = 0; bar.st = nullptr;
    if (hi - lo > 1) bar = xcd_barrier_post((unsigned*)(args.ws + WS_CTL) + CW_BAR, (volatile LAS unsigned*)(C.lds + MISC_OFF) + 8, C.wave);
#define IN(k) (lo <= (k) && (k) < hi)
#define PCTX Ctx L = C; asm volatile("v_mbcnt_lo_u32_b32 %0, -1, 0\n\tv_mbcnt_hi_u32_b32 %0, -1, %0" : "=v"(L.lane)); L.tid = L.wave * 64 + L.lane; asm volatile("" : "+s"(L.vcu), "+s"(L.gw)); { const __attribute__((address_space(4))) Args* ka_ = (const __attribute__((address_space(4))) Args*)__builtin_amdgcn_kernarg_segment_ptr(); asm volatile("" : "+s"(ka_)); L.x = (const float*)ka_->in[0]; L.c = (const float*)ka_->in[1]; L.ctx = (const float*)ka_->in[2]; L.c_ctx = (const float*)ka_->in[3]; L.w_mod = (const float*)ka_->in[4]; L.b_mod = (const float*)ka_->in[5]; L.g_mix = (const float*)ka_->in[6]; L.g_ffn = (const float*)ka_->in[7]; L.w_in = (const float*)ka_->in[8]; L.g_q = (const float*)ka_->in[9]; L.g_k = (const float*)ka_->in[10]; L.lru_conv_w = (const float*)ka_->in[11]; L.lru_conv_b = (const float*)ka_->in[12]; L.lru_wa = (const float*)ka_->in[13]; L.lru_ba = (const float*)ka_->in[14]; L.lru_wi = (const float*)ka_->in[15]; L.lru_bi = (const float*)ka_->in[16]; L.lru_lam = (const float*)ka_->in[17]; L.sc_conv_w = (const float*)ka_->in[18]; L.w_out = (const float*)ka_->in[19]; L.w_up = (const float*)ka_->in[20]; L.ffn_conv_w = (const float*)ka_->in[21]; L.w_down = (const float*)ka_->in[22]; L.g_final = (const float*)ka_->in[23]; L.out = ka_->out; { GAS unsigned char* wsg_ = (GAS unsigned char*)ka_->ws; asm volatile("" : "+s"(wsg_)); L.ws = (unsigned char*)wsg_; } }
#define SEAM(k) do { if (IN(k) && IN((k) + 1)) { xcd_barrier(bar); } } while (0)
    if (IN(0)) REP(0) { PCTX; phase_p0a(L); } SEAM(0);
    if (IN(1)) REP(1) { PCTX; phase_p0b(L); } SEAM(1);
    for (int l = 0; l < DEPTH; ++l) {
        const int P = 2 + l * PH_PER_LAYER;
        const int Mff = (l == 0) ? M_ALL : M_LAT;
        if (IN(P + 0)) REP(2) {
            PCTX; int bx = (int)blockIdx.x; asm volatile("" : "+s"(bx));
            if (l == 0) {
                ProjEpi E{(bf16*)(L.ws + WS_PROJ), NPROJ, (const float*)(L.ws + WS_STA), (const float*)(L.ws + WS_BIN), NPROJ, 0, 0, (bf16*)(L.ws + WS_MIX), (bf16*)(L.ws + WS_KB), (bf16*)(L.ws + WS_VB), (const float*)(L.ws + WS_ROPE), L.g_q + (0) * 64, L.g_k + (0) * 64};
                GenOrder S; S.strided(M_ALL, NPROJ, bx, L.G);
                gemm_proj(L, (const bf16*)(L.ws + WS_AP), (const bf16*)(L.ws + WS_WIN), M_ALL, NPROJ, DM, S, E);
                { const int rem = (L.G == 256) ? ((M_ALL / 256) * (NPROJ / 256)) & 255 : 0; if (bx >= rem) { __syncthreads(); deferred_work(L, 0, bx - rem, L.G - rem); } }
            } else {
                { const float* mod = (const float*)(L.ws + WS_MOD) + (size_t)(l - 1) * 9 * 6144;
                  ResEpi E{L.x, L.ctx, (bf16*)(L.ws + WS_XR), mod + 5 * 1024, L.g_mix + l * DM, mod + 9 * 6144 + 1 * 1024, (bf16*)(L.ws + WS_AP), (float*)(L.ws + WS_STA), true, M_LAT / 256, false};
                  GenOrder S; S.strided(M_CTX, DM, bx, L.G);
                  { pg8::Unit fu; int prev = -1; for (int i = 0; S.next(i, fu); ++i) { if (fu.pm != prev) ffn_fix_panel(L, l - 1, M_LAT / 256 + fu.pm); prev = fu.pm; } asm volatile("s_waitcnt vmcnt(0)" ::: "memory"); __syncthreads(); }
                  gemm_res<false>(L, (const bf16*)(L.ws + WS_ACT) + (size_t)M_LAT * DFF, (const bf16*)(L.ws + WS_WDN + (l - 1) * SZ_WDN), M_CTX, DFF, S, E); }
                { ProjEpi E{(bf16*)(L.ws + WS_PROJ), NPROJ, (const float*)(L.ws + WS_STA), (const float*)(L.ws + WS_BIN) + (size_t)l * 9 * NPROJ, NPROJ, 0, 0, (bf16*)(L.ws + WS_MIX), (bf16*)(L.ws + WS_KB), (bf16*)(L.ws + WS_VB), (const float*)(L.ws + WS_ROPE), L.g_q + (l) * 64, L.g_k + (l) * 64};
                  GenOrder S; S.strided(M_LAT, NPROJ, bx, L.G);
                  if (L.G == 256) {
                      if (bx < 32) { S.b1 = 896 + bx; S.s1 = 32; S.n1 = 2; }
                      else { const int j = bx - 32; S.b1 = j; S.s1 = 224; S.n1 = 4; S.b2 = 960 + j; S.s2 = 0; S.n2 = j < 64 ? 1 : 0; } }
                  gemm_proj(L, (const bf16*)(L.ws + WS_AP), (const bf16*)(L.ws + WS_WIN + l * SZ_WIN), M_LAT, NPROJ, DM, S, E); }
            }
        } SEAM(P + 0);
        if (IN(P + 1)) {
            if ((PROBE_REP_MASK >> 3) & 1) { PCTX; if (l == 0) phase_post(L, l, 0, M_ALL, 12, L.gw, L.NGW); }
            PCTX;
            if (l == 0) phase_post(L, l, 0, M_ALL, 12, L.gw, L.NGW);
            else {
                const int gs = L.G >> 3; const bool split = gs >= 2; int q = 0, below = 0, role = 0;
#pragma unroll
                for (int p = 0; p < 8; ++p) { if (L.vcu == p * gs) { role = 1; q = p; } if (split && L.vcu == p * gs + 1) { role = 2; q = p; } if (p * gs < L.vcu) ++below; if (split && p * gs + 1 < L.vcu) ++below; }
                if (role != 0) {
                    const int r0 = M_LAT + 256 * q, c0 = (role == 2 || !split) ? 512 : 768, ncol = split ? 256 : 512;
                    ProjEpi E{(bf16*)(L.ws + WS_PROJ) + (size_t)r0 * NPROJ + c0, NPROJ, (const float*)(L.ws + WS_STA), (const float*)(L.ws + WS_BIN) + (size_t)l * 9 * NPROJ + c0, NPROJ, r0, c0 >> 8, (bf16*)(L.ws + WS_MIX), (bf16*)(L.ws + WS_KB), (bf16*)(L.ws + WS_VB), (const float*)(L.ws + WS_ROPE), L.g_q + l * 64, L.g_k + l * 64};
                    GenOrder S; S.strided(256, ncol, 0, 1);
                    gemm_proj(L, (const bf16*)(L.ws + WS_AP) + (size_t)r0 * DM, (const bf16*)(L.ws + WS_WIN + l * SZ_WIN) + (size_t)c0 * DM, 256, ncol, DM, S, E);
                    if (role == 1) { asm volatile("s_waitcnt vmcnt(0)" ::: "memory"); __syncthreads(); phase_post(L, l, r0, r0 + 256, 4, L.wave, NWAVES); }
                } else {
                    const int j = L.vcu - below, nl = L.G - (split ? 16 : 8);
                    phase_post(L, l, 0, M_LAT, 12, j * NWAVES + L.wave, nl * NWAVES);
                }
            }
        } SEAM(P + 1);
        const bool fuse23 = IN(P + 2) && IN(P + 3);
        if (IN(P + 2)) REP(4) {
            PCTX;
            GatesEpi E{(const bf16*)(L.ws + WS_RC), L.lru_ba + l * 512, L.lru_bi + l * 512, (const float*)(L.ws + WS_SPL) + l * 512, (unsigned*)(L.ws + WS_LA), (float*)(L.ws + WS_AGP), (float*)(L.ws + WS_AGB)};
            gemm_gates(L, (const bf16*)(L.ws + WS_RC), (const bf16*)(L.ws + WS_GW + l * SZ_GW), E);
            if (l == 0) { const int bx = (int)blockIdx.x, rem = (L.G == 256) ? ((M_ALL / 256) * 4) & 255 : 0; if (bx >= rem) { __syncthreads(); deferred_work(L, 1, bx - rem, L.G - rem); } }
            if (fuse23) grid_arrive((unsigned*)(L.ws + WS_CTL) + CW_GSYNC + 64 * l, L.wave);
        } if (!fuse23) SEAM(P + 2);
        if (IN(P + 3)) { { PCTX;
            REP(6) phase_attn_fast(L, l, rep_ == 0 && ((PROBE_REP_MASK >> 6) & 1));
            } REP(7) { PCTX; if (fuse23) grid_wait((unsigned*)(L.ws + WS_CTL) + CW_GSYNC + 64 * l, (unsigned)L.G, L.wave); phase_scan2(L, l); } } SEAM(P + 3);
        if (IN(P + 4)) for (int rep_ = 0; rep_ < ((((PROBE_REP_MASK) >> 8) & 1) && l == 0 ? 2 : 1); ++rep_) {
            PCTX; const float* mod = (const float*)(L.ws + WS_MOD) + (size_t)l * 9 * 6144;
            ResEpi E{L.x, L.ctx, (bf16*)(L.ws + WS_XR), mod + 2 * 1024, L.g_ffn + l * DM, mod + 4 * 1024, (bf16*)(L.ws + WS_AP), (float*)(L.ws + WS_STB), true, 0, true};
            GenOrder S; S.strided(Mff, DM, (int)blockIdx.x, L.G);
            if (l == 0) gemm_res<true>(L, (const bf16*)(L.ws + WS_MIX), (const bf16*)(L.ws + WS_WOUT + l * SZ_WOUT), Mff, DM, S, E);
            else gemm_res<false>(L, (const bf16*)(L.ws + WS_MIX), (const bf16*)(L.ws + WS_WOUT + l * SZ_WOUT), Mff, DM, S, E);
            if (l == 0) { const int bx = (int)blockIdx.x, rem = (L.G == 256) ? ((M_ALL / 256) * 4) & 255 : 0; if (bx >= rem) { __syncthreads(); deferred_work(L, 2, bx - rem, L.G - rem); } }
        } SEAM(P + 4);
        if (IN(P + 5)) REP(9) { PCTX; gemm_upconv(L, l, Mff); } SEAM(P + 5);
        if (IN(P + 6)) {
            PCTX; const float* mod = (const float*)(L.ws + WS_MOD) + (size_t)l * 9 * 6144;
            const bool last = (l == DEPTH - 1);
            ResEpi E{L.x, L.ctx, (bf16*)(L.ws + WS_XR), mod + 5 * 1024, last ? L.g_final : L.g_mix + (l + 1) * DM, last ? mod : mod + 9 * 6144 + 1 * 1024, (bf16*)(L.ws + WS_AP), (float*)(L.ws + WS_STA), !last, 0, false};
            GenOrder S; S.strided(M_LAT, DM, (int)blockIdx.x, L.G);
            { pg8::Unit fu; int prev = -1; for (int i = 0; S.next(i, fu); ++i) { if (fu.pm != prev) ffn_fix_panel(L, l, fu.pm); prev = fu.pm; } asm volatile("s_waitcnt vmcnt(0)" ::: "memory"); __syncthreads(); }
            if (last && L.G == 256) gemm_res_final(L, (const bf16*)(L.ws + WS_ACT), (const bf16*)(L.ws + WS_WDN + l * SZ_WDN), M_LAT, DFF, S, E);
            else gemm_res<false>(L, (const bf16*)(L.ws + WS_ACT), (const bf16*)(L.ws + WS_WDN + l * SZ_WDN), M_LAT, DFF, S, E);
        } if (!(l == DEPTH - 1 && C.G == 256)) SEAM(P + 6);
    }
    if (IN(PH_FINAL) && C.G != 256) { PCTX; phase_final(L); }
#undef IN
#undef SEAM
}

extern "C" void kernel_launch(void* const* d_in, const int* in_sizes, int n_in, void* d_out, int out_size, void* d_ws, size_t ws_size, hipStream_t stream) {
    static int grid = 0;
    if (grid == 0) {
        if (n_in != 24 || out_size != M_LAT * DM || ws_size < WS_END) { fprintf(stderr, "kernel_launch: unexpected problem (n_in %d, out %d, ws %zu)\n", n_in, out_size, ws_size); grid = -1; return; }
        int dev = 0, cus = 0, per_cu = 0;
        if (hipGetDevice(&dev) != hipSuccess || hipDeviceGetAttribute(&cus, hipDeviceAttributeMultiprocessorCount, dev) != hipSuccess) { grid = -1; return; }
        if (hipFuncSetAttribute((const void*)fwd_kernel, hipFuncAttributeMaxDynamicSharedMemorySize, LDS_BYTES) != hipSuccess) { fprintf(stderr, "kernel_launch: hipFuncSetAttribute failed\n"); grid = -1; return; }
        if (hipOccupancyMaxActiveBlocksPerMultiprocessor(&per_cu, (const void*)fwd_kernel, NTHREADS, LDS_BYTES) != hipSuccess || per_cu < 1) { fprintf(stderr, "kernel_launch: occupancy query says %d blocks per CU\n", per_cu); }
        (void)hipGetLastError();
        grid = cus;
    }
    if (grid < 0) return;
    (void)hipMemsetAsync((char*)d_ws + WS_CTL, 0, CTL_ZERO_BYTES, stream);
    Args a{};
    for (int i = 0; i < 24; ++i) a.in[i] = d_in[i];
    a.out = (float*)d_out; a.ws = (unsigned char*)d_ws;
#if MK_N_LAUNCHES == 1
    a.ph_lo = 0; a.ph_hi = N_PHASES;
    void* kargs[] = {&a};
    hipError_t e = hipLaunchCooperativeKernel((const void*)fwd_kernel, dim3(grid), dim3(NTHREADS), kargs, LDS_BYTES, stream);
    if (e != hipSuccess) fprintf(stderr, "kernel_launch: cooperative launch failed: %s (grid %d)\n", hipGetErrorString(e), grid);
#else
    for (int p = 0; p < N_PHASES; ++p) {
        a.ph_lo = p; a.ph_hi = p + 1;
        hipLaunchKernelGGL(fwd_kernel, dim3(grid), dim3(NTHREADS), LDS_BYTES, stream, a);
    }
#endif
}
```

```cpp
#include <hip/hip_runtime.h>
#include <cstdio>
#include <cstdint>
#include <cmath>
#include <hip/hip_bf16.h>

#ifndef MK_N_LAUNCHES
#define MK_N_LAUNCHES 1
#endif
#ifndef PROBE_REP_MASK
#define PROBE_REP_MASK 0
#endif
#define REP(kind) for (int rep_ = 0; rep_ < (((PROBE_REP_MASK) >> (kind)) & 1) + 1; ++rep_)

#define LAS __attribute__((address_space(3)))
#define GAS __attribute__((address_space(1)))
typedef unsigned short bf16;
typedef unsigned v4u __attribute__((ext_vector_type(4)));
typedef unsigned v2u __attribute__((ext_vector_type(2)));
typedef float f32x4 __attribute__((ext_vector_type(4)));
typedef float f32x2 __attribute__((ext_vector_type(2)));

constexpr int NB = 8, SEQ = 4096, CTXL = 256, DM = 1024, DEPTH = 2;
constexpr int M_LAT = NB * SEQ, M_CTX = NB * CTXL, M_ALL = M_LAT + M_CTX;
constexpr int NPROJ = 2048, DFF = 2816, NUP = 2 * DFF, KVROWS = SEQ + CTXL, KVP = 128;
constexpr int NCHUNK = 68;
constexpr float EPS = 1e-6f;
constexpr float C2 = 0.125f * 1.4426950408889634f;
constexpr int NWAVES = 8, NTHREADS = 512;

constexpr size_t MiB = 1u << 20;
constexpr size_t WS_CTL = 0, CTL_ZERO_BYTES = 1 * MiB;
constexpr size_t WS_WIN = 1 * MiB, WS_WOUT = 9 * MiB, WS_WUP = 13 * MiB, WS_WDN = 35 * MiB, WS_GW = 46 * MiB;
constexpr size_t SZ_WIN = 4 * MiB, SZ_WOUT = 2 * MiB, SZ_WUP = 11 * MiB, SZ_WDN = 11 * MiB / 2, SZ_GW = MiB / 2;
constexpr size_t WS_MOD = 47 * MiB, WS_BIN = 47 * MiB + 512 * 1024, WS_BUP = 48 * MiB, WS_ROPE = 48 * MiB + 512 * 1024, WS_SPL = WS_ROPE + 16384;
constexpr size_t WS_STA = 49 * MiB, WS_STB = 51 * MiB + 512 * 1024, WS_AGP = 54 * MiB, WS_AGB = 55 * MiB + 512 * 1024;
constexpr size_t WS_XC = 57 * MiB, WS_AP = 65 * MiB, WS_BIG = 133 * MiB;
constexpr size_t WS_PROJ = WS_BIG, WS_MIX = WS_BIG + 136 * MiB, WS_KB = WS_MIX + 68 * MiB, WS_VB = WS_KB + 17 * MiB / 2, WS_RC = WS_VB + 17 * MiB / 2;
constexpr size_t WS_LA = WS_RC + 17 * MiB, WS_XR = WS_LA + 68 * MiB, WS_END1 = WS_XR + 68 * MiB;
constexpr size_t WS_ACT = WS_BIG, WS_EDGE = WS_BIG + 187 * MiB, WS_END2 = WS_EDGE + 8 * MiB;
constexpr size_t WS_END = 512 * MiB;
static_assert(WS_END1 <= WS_END && WS_END2 <= WS_XR, "d_ws map");
static_assert((size_t)M_ALL * NPROJ * 2 == 136 * MiB && (size_t)M_ALL * DM * 2 == 68 * MiB && (size_t)M_ALL * 256 * 2 == 17 * MiB && (size_t)M_ALL * DFF * 2 == 187 * MiB, "sizes");
static_assert((size_t)136 * 4 * NUP * 2 <= 8 * MiB && (size_t)NB * KVROWS * KVP * 2 * 2 == 17 * MiB && (size_t)M_ALL * 256 * 4 * 2 == 68 * MiB, "sizes2");
constexpr int CW_BAR = 4096;

constexpr int RING_BYTES = 131072, LDSCTL_OFF = RING_BYTES, MISC_OFF = LDSCTL_OFF + 320, EXCH_OFF = RING_BYTES + 1024  , LDS_BYTES = 147456;

__device__ __forceinline__ float bflo(unsigned w) { return __uint_as_float(w << 16); }
__device__ __forceinline__ float bfhi(unsigned w) { return __uint_as_float(w & 0xffff0000u); }
__device__ __forceinline__ float bf1(bf16 h) { return __uint_as_float((unsigned)h << 16); }
__device__ __forceinline__ unsigned pk2(float lo, float hi) { unsigned r; asm volatile("v_cvt_pk_bf16_f32 %0, %1, %2" : "=v"(r) : "v"(lo), "v"(hi)); return r; }
__device__ __forceinline__ void unpack8(const v4u w, float (&x)[8]) {
    x[0] = bflo(w.x); x[1] = bfhi(w.x); x[2] = bflo(w.y); x[3] = bfhi(w.y); x[4] = bflo(w.z); x[5] = bfhi(w.z); x[6] = bflo(w.w); x[7] = bfhi(w.w);
}
__device__ __forceinline__ v4u pack8(const float (&x)[8]) { v4u w; w.x = pk2(x[0], x[1]); w.y = pk2(x[2], x[3]); w.z = pk2(x[4], x[5]); w.w = pk2(x[6], x[7]); return w; }
__device__ __forceinline__ float shx(float v, int mask, int lane) { return __int_as_float(__builtin_amdgcn_ds_bpermute((lane ^ mask) << 2, __float_as_int(v))); }
__device__ __forceinline__ float wave_sum(float v, int lane) {
#pragma unroll
    for (int o = 1; o < 64; o <<= 1) v += shx(v, o, lane);
    return v;
}
__device__ __forceinline__ float sigmoidf_(float x) { return __builtin_amdgcn_rcpf(1.0f + __expf(-x)); }
__device__ __forceinline__ float silu_(float x) { return x * __builtin_amdgcn_rcpf(1.0f + __expf(-x)); }
__device__ __forceinline__ float one_minus_exp_(float x) {
    const float s = -x * (1.0f + x * (0.5f + x * (1.0f / 6.0f + x * (1.0f / 24.0f + x * (1.0f / 120.0f + x * (1.0f / 720.0f + x * (1.0f / 5040.0f)))))));
    return x > -0.25f ? s : 1.0f - __expf(x);
}
__device__ __forceinline__ float gelu_tanh_(float x) {
    const float u = 0.7978845608028654f * (x + 0.044715f * x * x * x);
    const float t = 1.0f - 2.0f * __builtin_amdgcn_rcpf(1.0f + __expf(2.0f * u));
    return 0.5f * x * (1.0f + t);
}
__device__ __forceinline__ int row_bi(int m) { return m < M_LAT ? (m >> 12) : 8; }

struct Args { const void* in[24]; float* out; unsigned char* ws; int ph_lo, ph_hi; };
struct Ctx {
    LAS unsigned char* lds; char* lds_gen; int tid, lane, wave, vcu, G, gw, NGW;
    const float *x, *c, *ctx, *c_ctx, *w_mod, *b_mod, *g_mix, *g_ffn, *w_in, *g_q, *g_k, *lru_conv_w, *lru_conv_b, *lru_wa, *lru_ba, *lru_wi, *lru_bi, *lru_lam, *sc_conv_w, *w_out, *w_up, *ffn_conv_w, *w_down, *g_final;
    float* out; unsigned char* ws;
};
#define WSP(T, off) ((T*)(C.ws + (off)))

struct ProjEpi {
    bf16* Cout; int ldc; const float* stats; const float* bias; int ldb; int row_off;
    int tile0; bf16 *MIX, *KB, *VB; const float *ropeT, *gq, *gk;
};
struct ResEpi {
    const float *xi_lat, *xi_ctx; bf16* XR; const float* gate; const float* gn; const float* cn; bf16* AP; float* stats; bool has_ap; int pm_off; bool ap_perm;
    __device__ __forceinline__ const float* xi_row(int grow) const { return grow < M_LAT ? xi_lat + (size_t)grow * DM : xi_ctx + (size_t)(grow - M_LAT) * DM; }
};
struct GatesEpi {
    const bf16* RC; const float *ba, *bi_, *spl; unsigned* LAB; float *AGP, *AGB;
};

__host__ __device__ __forceinline__ int qk_pos(int n) { if (n >= 640) return n; const int d = n & 63; return (n & ~63) + 2 * (d & 31) + (d >> 5); }
__device__ __forceinline__ void transpose_item(const float* W, int K, int N, bf16* WT, LAS float* scr, int item, int lane, bool upperm = false, bool qkperm = false) {
    const int nblk = N / 32, kb = item / nblk, nb = item % nblk, k0 = 64 * kb, n0 = 32 * nb;
    int d0 = n0; if (upperm) { const int half = n0 / DFF, j = n0 - half * DFF; d0 = (j >> 7) * 256 + half * 128 + (j & 127); }
    { f32x4 v[8];
#pragma unroll
      for (int i = 0; i < 8; ++i) v[i] = *(const f32x4*)(W + (size_t)(k0 + 8 * i + (lane >> 3)) * N + n0 + 4 * (lane & 7));
#pragma unroll
      for (int i = 0; i < 8; ++i) { LAS float* d = scr + (8 * i + (lane >> 3)) * 33 + 4 * (lane & 7); d[0] = v[i].x; d[1] = v[i].y; d[2] = v[i].z; d[3] = v[i].w; } }
    asm volatile("s_waitcnt lgkmcnt(0)" ::: "memory");
    const int c = lane & 7;
#pragma unroll
    for (int j = 0; j < 4; ++j) { const int n = (lane >> 3) + 8 * j; const LAS float* s = scr + (8 * c) * 33 + n;
        v4u o; o.x = pk2(s[0 * 33], s[1 * 33]); o.y = pk2(s[2 * 33], s[3 * 33]); o.z = pk2(s[4 * 33], s[5 * 33]); o.w = pk2(s[6 * 33], s[7 * 33]);
        *(v4u*)(WT + (size_t)(qkperm ? qk_pos(n0 + n) : d0 + n) * K + k0 + 8 * c) = o; }
    asm volatile("s_waitcnt lgkmcnt(0)" ::: "memory");
}
__device__ __forceinline__ void gemv9_item(const Ctx& C, LAS float* vec, LAS float* red, const float* W, int ldw, int n0, const float* bias, float* out, int ostride, bool qkperm = false) {
    float acc[9];
#pragma unroll
    for (int b = 0; b < 9; ++b) acc[b] = 0.f;
    const int k0 = C.wave * 128; const float* wp = W + (size_t)k0 * ldw + n0 + C.lane;
#pragma unroll 1
    for (int kk = 0; kk < 128; kk += 16) {
        float w[16];
#pragma unroll
        for (int j = 0; j < 16; ++j) w[j] = wp[(size_t)(kk + j) * ldw];
#pragma unroll
        for (int j = 0; j < 16; j += 4)
#pragma unroll
            for (int b = 0; b < 9; ++b) { const f32x4 v = *(const LAS f32x4*)(vec + b * 1024 + k0 + kk + j); acc[b] += (v.x * w[j] + v.y * w[j + 1]) + (v.z * w[j + 2] + v.w * w[j + 3]); }
    }
#pragma unroll
    for (int b = 0; b < 9; ++b) red[(C.wave * 9 + b) * 64 + C.lane] = acc[b];
    __syncthreads();
    for (int idx = C.tid; idx < 576; idx += NTHREADS) { const int b = idx >> 6, j = idx & 63; float s = 0.f;
#pragma unroll
        for (int w = 0; w < 8; ++w) s += red[(w * 9 + b) * 64 + j];
        if (bias) s += bias[n0 + j];
        out[(size_t)b * ostride + (qkperm ? qk_pos(n0 + j) : n0 + j)] = s; }
    __syncthreads();
}
template <int WHICH> __device__ __forceinline__ void transpose_matrix(const Ctx& C, int l, int widx, int nw) {
    LAS float* scr = (LAS float*)(C.lds + C.wave * 16384);
    if (WHICH == 0) for (int it = widx; it < 16 * 64; it += nw) transpose_item(C.w_in + (size_t)l * DM * NPROJ, DM, NPROJ, WSP(bf16, WS_WIN + l * SZ_WIN), scr, it, C.lane, false, true);
    if (WHICH == 1) for (int it = widx; it < 16 * 32; it += nw) transpose_item(C.w_out + (size_t)l * DM * DM, DM, DM, WSP(bf16, WS_WOUT + l * SZ_WOUT), scr, it, C.lane);
    if (WHICH == 2) for (int it = widx; it < 16 * 176; it += nw) transpose_item(C.w_up + (size_t)l * DM * NUP, DM, NUP, WSP(bf16, WS_WUP + l * SZ_WUP), scr, it, C.lane, true);
    if (WHICH == 3) for (int it = widx; it < 44 * 32; it += nw) transpose_item(C.w_down + (size_t)l * DFF * DM, DFF, DM, WSP(bf16, WS_WDN + l * SZ_WDN), scr, it, C.lane);
}
__device__ __forceinline__ void bias_items(const Ctx& C, int l, bool up, int bidx, int nb) {
    LAS float* vec = (LAS float*)C.lds; LAS float* red = (LAS float*)(C.lds + 40960);
    const float* mod = WSP(float, WS_MOD) + (size_t)l * 9 * 6144 + (up ? 3 * 1024 : 0);
    const int nit = up ? 88 : 32;
    if (bidx < nit) {
        __syncthreads();
        { float t[18];
#pragma unroll
          for (int q = 0; q < 18; ++q) { const int idx = C.tid + q * NTHREADS; t[q] = mod[(size_t)(idx >> 10) * 6144 + (idx & 1023)]; }
#pragma unroll
          for (int q = 0; q < 18; ++q) vec[C.tid + q * NTHREADS] = t[q]; }
        __syncthreads();
        for (int it = bidx; it < nit; it += nb) {
            if (up) gemv9_item(C, vec, red, C.w_up + (size_t)l * DM * NUP, NUP, it * 64, nullptr, WSP(float, WS_BUP) + (size_t)l * 9 * NUP, NUP);
            else    gemv9_item(C, vec, red, C.w_in + (size_t)l * DM * NPROJ, NPROJ, it * 64, nullptr, WSP(float, WS_BIN) + (size_t)l * 9 * NPROJ, NPROJ, true); }
    }
}
__device__ __forceinline__ void phase_p0a(const Ctx& C) {
    transpose_matrix<0>(C, 0, C.gw, C.NGW);
    const int gt = C.gw * 64 + C.lane, NGT = C.NGW * 64;
    for (int idx0 = gt; idx0 < DEPTH * 1024 * 256; idx0 += 4 * NGT) {
        float va[4], vi[4];
#pragma unroll
        for (int q = 0; q < 4; ++q) { const int idx = (idx0 + q * NGT < DEPTH * 1024 * 256) ? idx0 + q * NGT : idx0; const int l = idx >> 18, n = (idx >> 8) & 1023, k = idx & 255;
            const int dir = n >> 9, half = (n >> 8) & 1, cl = n & 127, ch = half * 128 + cl, blk = ch >> 6, e = ch & 63;
            const size_t wi = ((((size_t)l * 2 + dir) * 4 + blk) * 64 + (k & 63)) * 64 + e; va[q] = C.lru_wa[wi]; vi[q] = C.lru_wi[wi]; }
#pragma unroll
        for (int q = 0; q < 4; ++q) { const int idx = idx0 + q * NGT; if (idx < DEPTH * 1024 * 256) { const int l = idx >> 18, n = (idx >> 8) & 1023, k = idx & 255;
            const int half = (n >> 8) & 1, gate = (n >> 7) & 1, cl = n & 127, blk = (half * 128 + cl) >> 6; const float v = ((k >> 6) == blk) ? (gate ? vi[q] : va[q]) : 0.f;
            WSP(bf16, WS_GW + l * SZ_GW)[(size_t)n * 256 + k] = (bf16)(pk2(v, 0.f) & 0xffffu); } }
    }
    if (gt < 1024) { const int pos = gt >> 4, f = gt & 15; const float inv = powf(10000.0f, -(float)f / 16.0f), ang = (float)pos * inv;
        WSP(float, WS_ROPE)[gt] = cosf(ang); WSP(float, WS_ROPE)[1024 + gt] = sinf(ang); }
    if (gt < DEPTH * 2 * 256) { const float lam = C.lru_lam[gt]; WSP(float, WS_SPL)[gt] = log1pf(expf(-lam)); }
    __syncthreads();
    LAS float* vec = (LAS float*)C.lds; LAS float* red = (LAS float*)(C.lds + 40960);
    if (C.vcu < DEPTH * 96) {
        { float t[18];
#pragma unroll
          for (int q = 0; q < 18; ++q) { const int idx = C.tid + q * NTHREADS, b = idx >> 10, k = idx & 1023; const float vc = C.c[(b < 8 ? b : 0) * 1024 + k], vx = C.c_ctx[k]; t[q] = b < 8 ? vc : vx; }
#pragma unroll
          for (int q = 0; q < 18; ++q) vec[C.tid + q * NTHREADS] = silu_(t[q]); }
        __syncthreads();
        for (int it = C.vcu; it < DEPTH * 96; it += C.G) { const int l = it / 96, n0 = (it % 96) * 64;
            gemv9_item(C, vec, red, C.w_mod + (size_t)l * DM * 6144, 6144, n0, C.b_mod + l * 6144, WSP(float, WS_MOD) + (size_t)l * 9 * 6144, 6144); }
    }
}
__device__ __forceinline__ void phase_p0b(const Ctx& C) {
    const int nbw = (C.G > 64) ? 32 : 0;
    bias_items(C, 0, false, C.vcu, C.G);
    if (C.vcu < nbw) return;
    const int gw2 = (C.vcu - nbw) * NWAVES + C.wave, NGW2 = (C.G - nbw) * NWAVES;
    bf16* __restrict__ AP = WSP(bf16, WS_AP); float* __restrict__ STA = WSP(float, WS_STA);
    f32x4 g[4];
#pragma unroll
    for (int j = 0; j < 4; ++j) g[j] = *(const f32x4*)(C.g_mix + (C.lane + 64 * j) * 4);
    for (int m0 = gw2; m0 < M_ALL; m0 += 2 * NGW2) {
        f32x4 v[2][4], cc[2][4]; int mm[2];
#pragma unroll
        for (int q = 0; q < 2; ++q) { const int m = (m0 + q * NGW2 < M_ALL) ? m0 + q * NGW2 : m0; mm[q] = m;
            const float* xr = m < M_LAT ? C.x + (size_t)m * DM : C.ctx + (size_t)(m - M_LAT) * DM; const float* ca = WSP(float, WS_MOD) + (size_t)row_bi(m) * 6144 + 1024;
#pragma unroll
            for (int j = 0; j < 4; ++j) { const int k = (C.lane + 64 * j) * 4; v[q][j] = *(const f32x4*)(xr + k); cc[q][j] = *(const f32x4*)(ca + k); } }
#pragma unroll
        for (int q = 0; q < 2; ++q) { float ss = 0.f;
#pragma unroll
            for (int j = 0; j < 4; ++j) { const int k = (C.lane + 64 * j) * 4; const f32x4 x = v[q][j];
                ss += (x.x * x.x + x.y * x.y) + (x.z * x.z + x.w * x.w); const f32x4 a = x * g[j] * (cc[q][j] + 1.0f);
                v2u w; w.x = pk2(a.x, a.y); w.y = pk2(a.z, a.w); *(v2u*)(AP + (size_t)mm[q] * DM + k) = w; }
            ss = wave_sum(ss, C.lane);
            if (C.lane < 16) STA[(size_t)mm[q] * 16 + C.lane] = C.lane == 0 ? ss : 0.f; }
    }
}
__device__ __forceinline__ void deferred_work(const Ctx& C, int window, int d, int nd) {
    const int widx = d * NWAVES + C.wave, nw = nd * NWAVES;
    if (window == 0) { transpose_matrix<1>(C, 0, widx, nw); transpose_matrix<2>(C, 0, widx, nw); transpose_matrix<0>(C, 1, widx, nw); transpose_matrix<1>(C, 1, widx, nw); bias_items(C, 0, true, d, nd); }
    if (window == 1) { transpose_matrix<3>(C, 0, widx, nw); transpose_matrix<3>(C, 1, widx, nw); }
    if (window == 2) { transpose_matrix<2>(C, 1, widx, nw); bias_items(C, 1, true, d, nd); bias_items(C, 1, false, d >= 88 ? d - 88 : d + nd - 88, nd); }
}

__device__ __forceinline__ void rope_tab(const float* ropeT, int t, int j, f32x4 (&cs)[2], f32x4 (&sn)[2]) {
    const int pos = ((j & 3) < 2) ? (t >> 6) : (t & 63), f0 = 8 * (j & 1); const float* c = ropeT + pos * 16 + f0; const float* s = ropeT + 1024 + pos * 16 + f0;
    cs[0] = *(const f32x4*)c; cs[1] = *(const f32x4*)(c + 4); sn[0] = *(const f32x4*)s; sn[1] = *(const f32x4*)(s + 4);
}
__device__ __forceinline__ void rope8(float (&y)[8], const float (&p)[8], const f32x4 (&cs)[2], const f32x4 (&sn)[2], int j) {
#pragma unroll
    for (int e = 0; e < 8; ++e) { const float c = cs[e >> 2][e & 3], s = sn[e >> 2][e & 3]; y[e] = (j < 4) ? (y[e] * c - p[e] * s) : (y[e] * c + p[e] * s); }
}
__device__ __forceinline__ void head_norm_rope(float (&x)[8], const float (&g)[8], bool rope, const f32x4 (&cs)[2], const f32x4 (&sn)[2], int j, int lane) {
    float ss = 0.f;
#pragma unroll
    for (int e = 0; e < 8; ++e) ss += x[e] * x[e];
    ss += shx(ss, 1, lane); ss += shx(ss, 2, lane); ss += shx(ss, 4, lane);
    const float rinv = rsqrtf(ss * (1.0f / 64.0f) + EPS); float p[8];
#pragma unroll
    for (int e = 0; e < 8; ++e) x[e] = x[e] * rinv * g[e];
#pragma unroll
    for (int e = 0; e < 8; ++e) p[e] = shx(x[e], 4, lane);
    if (rope) rope8(x, p, cs, sn, j);
}
__device__ __forceinline__ void phase_post(const Ctx& C, int l, int m_lo, int m_hi, int tasks, int gw, int NGW) {
    const bf16* __restrict__ PROJ = WSP(bf16, WS_PROJ); bf16* __restrict__ MIX = WSP(bf16, WS_MIX); bf16* __restrict__ KB = WSP(bf16, WS_KB); bf16* __restrict__ VB = WSP(bf16, WS_VB); bf16* __restrict__ RC = WSP(bf16, WS_RC);
    const float* __restrict__ ropeT = WSP(float, WS_ROPE);
    if (tasks & 1) { const int j = C.lane & 7; float gq[8];
#pragma unroll
      for (int e = 0; e < 8; ++e) gq[e] = C.g_q[l * 64 + 8 * j + e];
      for (int m0 = m_lo + gw; m0 < m_hi; m0 += 4 * NGW) {
        v4u xw[4]; f32x4 cs[4][2], sn[4][2]; int mm[4];
#pragma unroll
        for (int q = 0; q < 4; ++q) { const int m = m0 + q * NGW; mm[q] = m < m_hi ? m : m0; xw[q] = *(const v4u*)(PROJ + (size_t)mm[q] * NPROJ + C.lane * 8); rope_tab(ropeT, mm[q] & 4095, j, cs[q], sn[q]); }
#pragma unroll
        for (int q = 0; q < 4; ++q) { float x[8]; unpack8(xw[q], x); head_norm_rope(x, gq, mm[q] < M_LAT, cs[q], sn[q], j, C.lane);
#pragma unroll
            for (int e = 0; e < 8; ++e) x[e] *= C2;
            *(v4u*)(MIX + (size_t)mm[q] * DM + C.lane * 8) = pack8(x); }
      } }
    if (tasks & 2) { const int sub = C.lane & 31, j = sub & 7; const bool iskey = sub < 16; float gk[8];
#pragma unroll
      for (int e = 0; e < 8; ++e) gk[e] = C.g_k[l * 64 + 8 * j + e];
      for (int p0 = m_lo / 2 + gw; p0 < m_hi / 2; p0 += 4 * NGW) {
        v4u xw[4]; f32x4 cs[4][2], sn[4][2]; int mm[4];
#pragma unroll
        for (int q = 0; q < 4; ++q) { const int pi = p0 + q * NGW; mm[q] = 2 * (pi < m_hi / 2 ? pi : p0) + (C.lane >> 5); xw[q] = *(const v4u*)(PROJ + (size_t)mm[q] * NPROJ + 512 + sub * 8); rope_tab(ropeT, mm[q] & 4095, j, cs[q], sn[q]); }
#pragma unroll
        for (int q = 0; q < 4; ++q) { const int m = mm[q]; float x[8], y[8]; unpack8(xw[q], x);
#pragma unroll
            for (int e = 0; e < 8; ++e) y[e] = x[e];
            head_norm_rope(y, gk, m < M_LAT, cs[q], sn[q], j, C.lane);
            int b, pos; if (m < M_LAT) { b = m >> 12; pos = m & 4095; } else { const int mc = m - M_LAT; b = mc >> 8; pos = SEQ + (mc & 255); }
            bf16* dst = (iskey ? KB : VB) + ((size_t)b * KVROWS + pos) * KVP + (sub & 15) * 8;
            *(v4u*)dst = iskey ? pack8(y) : pack8(x); }
      } }
    if (tasks & 4) { const int sub = C.lane & 31, ch0 = sub * 8; float cw[4][8], cb[8];
#pragma unroll
      for (int e = 0; e < 8; ++e) { cb[e] = C.lru_conv_b[l * 256 + ch0 + e];
#pragma unroll
          for (int k = 0; k < 4; ++k) cw[k][e] = C.lru_conv_w[(l * 4 + k) * 256 + ch0 + e]; }
      for (int it = gw; it < (m_hi - m_lo) / 16; it += NGW) {
        const int m0 = m_lo + it * 16 + 8 * (C.lane >> 5); int t0, T; if (m0 < M_LAT) { t0 = m0 & 4095; T = SEQ; } else { t0 = (m0 - M_LAT) & 255; T = CTXL; }
        const bool head = t0 == 0, tail = t0 + 8 == T;
        v4u xw[11];
#pragma unroll
        for (int j = 0; j < 11; ++j) { const bool ok = !((j < 2 && head) || (j == 10 && tail)); xw[j] = *(const v4u*)(PROJ + (size_t)(ok ? m0 + j - 2 : m0) * 256 + ch0); }
        float xa[8], xb[8], xc[8], xd[8];
        unpack8(xw[0], xa); unpack8(xw[1], xb); unpack8(xw[2], xc);
        if (head) {
#pragma unroll
            for (int e = 0; e < 8; ++e) { xa[e] = 0.f; xb[e] = 0.f; } }
#pragma unroll
        for (int i = 0; i < 8; ++i) { unpack8(xw[i + 3], xd);
            if (i == 7 && tail) {
#pragma unroll
                for (int e = 0; e < 8; ++e) xd[e] = 0.f; }
            float acc[8];
#pragma unroll
            for (int e = 0; e < 8; ++e) acc[e] = cb[e] + cw[0][e] * xa[e] + cw[1][e] * xb[e] + cw[2][e] * xc[e] + cw[3][e] * xd[e];
            const int m = m0 + i, rrow = (m & ~63) + 16 * (m & 3) + ((m & 63) >> 2);
            *(v4u*)(RC + (size_t)rrow * 256 + ch0) = pack8(acc);
#pragma unroll
            for (int e = 0; e < 8; ++e) { xa[e] = xb[e]; xb[e] = xc[e]; xc[e] = xd[e]; } }
      } }
    if (tasks & 8) { const int sub = C.lane & 31, ch0 = sub * 8; float cw[3][8];
#pragma unroll
      for (int e = 0; e < 8; ++e)
#pragma unroll
          for (int k = 0; k < 3; ++k) cw[k][e] = C.sc_conv_w[(l * 3 + k) * 256 + ch0 + e];
      for (int it = gw; it < (m_hi - m_lo) / 16; it += NGW) {
        const int m0 = m_lo + it * 16 + 8 * (C.lane >> 5); int t0, T; if (m0 < M_LAT) { t0 = m0 & 4095; T = SEQ; } else { t0 = (m0 - M_LAT) & 255; T = CTXL; }
        const bool head = t0 == 0, tail = t0 + 8 == T;
        v4u bw[8], cw_[10], uw[10];
#pragma unroll
        for (int j = 0; j < 10; ++j) { const bool ok = !((j == 0 && head) || (j == 9 && tail)); const bf16* rp = PROJ + (size_t)(ok ? m0 + j - 1 : m0) * 256 + ch0;
            cw_[j] = *(const v4u*)(rp + (size_t)3 * M_ALL * 256); uw[j] = *(const v4u*)(rp + (size_t)4 * M_ALL * 256); if (j >= 1 && j <= 8) bw[j - 1] = *(const v4u*)(PROJ + (size_t)2 * M_ALL * 256 + (size_t)(m0 + j - 1) * 256 + ch0); }
        float pa[8], pb[8], pc[8];
        { float cg[8], u[8]; unpack8(cw_[0], cg); unpack8(uw[0], u);
#pragma unroll
          for (int e = 0; e < 8; ++e) pa[e] = head ? 0.f : cg[e] * u[e];
          unpack8(cw_[1], cg); unpack8(uw[1], u);
#pragma unroll
          for (int e = 0; e < 8; ++e) pb[e] = cg[e] * u[e]; }
#pragma unroll
        for (int i = 0; i < 8; ++i) { float cg[8], u[8], bg[8], o[8]; unpack8(cw_[i + 2], cg); unpack8(uw[i + 2], u); unpack8(bw[i], bg);
#pragma unroll
            for (int e = 0; e < 8; ++e) pc[e] = (i == 7 && tail) ? 0.f : cg[e] * u[e];
#pragma unroll
            for (int e = 0; e < 8; ++e) o[e] = bg[e] * (cw[0][e] * pa[e] + cw[1][e] * pb[e] + cw[2][e] * pc[e]);
            *(v4u*)(MIX + (size_t)(m0 + i) * DM + 768 + ch0) = pack8(o);
#pragma unroll
            for (int e = 0; e < 8; ++e) { pa[e] = pb[e]; pb[e] = pc[e]; } }
      } }
}

__device__ __forceinline__ int chunk_row0(int b, int c) { return c < 4 ? M_LAT + b * CTXL + c * 64 : b * SEQ + (c - 4) * 64; }
__device__ __forceinline__ void phase_scan2(const Ctx& C, int l) {
    const unsigned* __restrict__ LAB = WSP(unsigned, WS_LA); const float* __restrict__ AGP = WSP(float, WS_AGP); const float* __restrict__ AGB = WSP(float, WS_AGB);
    const bf16* __restrict__ PROJ = WSP(bf16, WS_PROJ); bf16* __restrict__ MIX = WSP(bf16, WS_MIX);
    const bool lat_only = (l == DEPTH - 1);
    const int nitems = lat_only ? NB * 64 * 4 : NB * NCHUNK * 4;
    for (int it = C.gw; it < nitems; it += C.NGW) {
        const int chq = it & 3, bc = it >> 2, ch = chq * 64 + C.lane; int b, c; if (lat_only) { b = bc >> 6; c = 4 + (bc & 63); } else { c = bc % NCHUNK; b = bc / NCHUNK; }
        const float* gpF = AGP + ((size_t)(0 * NB + b) * NCHUNK) * 256 + ch; const float* gbF = AGB + ((size_t)(0 * NB + b) * NCHUNK) * 256 + ch;
        const float* gpB = AGP + ((size_t)(1 * NB + b) * NCHUNK) * 256 + ch; const float* gbB = AGB + ((size_t)(1 * NB + b) * NCHUNK) * 256 + ch;
        const int nf = c, nb = c >= 4 ? 71 - c : 3 - c, nt = nf + nb;
        float hf = 0.f, hb = 0.f;
        for (int k0 = 0; k0 < nt; k0 += 24) { float p[24], q[24];
#pragma unroll
            for (int j = 0; j < 24; ++j) { const int k = min(k0 + j, nt - 1); const bool fw = k < nf; const int kb = k - nf, cc = fw ? k : (kb < 4 ? 3 - kb : 71 - kb);
                const float* pp = fw ? gpF : gpB; const float* qq = fw ? gbF : gbB; p[j] = pp[cc * 256]; q[j] = qq[cc * 256]; }
#pragma unroll
            for (int j = 0; j < 24; ++j) { const int k = k0 + j; const bool v = k < nt, fw = k < nf;
                const float pj = v ? p[j] : 1.0f, qj = v ? q[j] : 0.0f;
                hf = fw ? pj * hf + qj : hf; hb = fw ? hb : pj * hb + qj; } }
        const int row0 = chunk_row0(b, c);
        LAS unsigned* TF = (LAS unsigned*)(C.lds + C.wave * 8192); LAS bf16* TG = (LAS bf16*)(C.lds + C.wave * 8192 + 4096); LAS bf16* TO = (LAS bf16*)(C.lds + C.wave * 8192 + 6144);
        const int l4t = C.lane >> 4, l4c = (C.lane & 15) * 4, l8t = C.lane >> 3, l8c = (C.lane & 7) * 8;
        const unsigned* pF = LAB + ((size_t)0 * M_ALL + row0) * 256 + chq * 64 + l4c; const unsigned* pB = LAB + ((size_t)1 * M_ALL + row0) * 256 + chq * 64 + l4c;
        const bf16* pg = PROJ + (size_t)1 * M_ALL * 256 + (size_t)row0 * 256 + chq * 64 + l8c;        bf16* po = MIX + (size_t)row0 * DM + 512 + chq * 64 + l8c;
        float hv[64];
        { v4u wf[16];
#pragma unroll
          for (int q = 0; q < 16; ++q) wf[q] = *(const v4u*)(pF + (size_t)(4 * q + l4t) * 256);
#pragma unroll
          for (int st = 0; st < 4; ++st) {
#pragma unroll
              for (int i = 0; i < 4; ++i) *(LAS v4u*)(TF + (4 * i + l4t) * 64 + l4c) = wf[st * 4 + i];
#pragma unroll
              for (int t = 0; t < 16; ++t) { const unsigned w = TF[t * 64 + C.lane]; hf = __builtin_amdgcn_exp2f(bflo(w)) * hf + bfhi(w); hv[st * 16 + t] = hf; } } }
        { v4u wb[16], wg[8];
#pragma unroll
          for (int q = 0; q < 16; ++q) wb[q] = *(const v4u*)(pB + (size_t)(4 * q + l4t) * 256);
#pragma unroll
          for (int q = 0; q < 8; ++q) wg[q] = *(const v4u*)(pg + (size_t)(8 * q + l8t) * 256);
#pragma unroll
          for (int st = 3; st >= 0; --st) {
#pragma unroll
              for (int i = 0; i < 4; ++i) *(LAS v4u*)(TF + (4 * i + l4t) * 64 + l4c) = wb[st * 4 + i];
#pragma unroll
              for (int j = 0; j < 2; ++j) *(LAS v4u*)(TG + (8 * j + l8t) * 64 + l8c) = wg[st * 2 + j];
#pragma unroll
              for (int t = 15; t >= 0; --t) { const unsigned w = TF[t * 64 + C.lane]; const float g = bf1(TG[t * 64 + C.lane]); hb = __builtin_amdgcn_exp2f(bflo(w)) * hb + bfhi(w);
                  TO[t * 64 + C.lane] = (bf16)(pk2(gelu_tanh_(g) * (hv[st * 16 + t] + hb), 0.f) & 0xffffu); }
#pragma unroll
              for (int j = 0; j < 2; ++j) { const v4u o = *(const LAS v4u*)(TO + (8 * j + l8t) * 64 + l8c); *(v4u*)(po + (size_t)(st * 16 + 8 * j + l8t) * DM) = o; } } }
    }
}

namespace attn_body {
using abf16=__hip_bfloat16;
using bf16x8=__attribute__((ext_vector_type(8)))short;
using s16x4=__attribute__((ext_vector_type(4)))short;
using f32x16=__attribute__((ext_vector_type(16)))float;
using u32x4=__attribute__((ext_vector_type(4)))unsigned;
constexpr int D=64,DM=1024,KVPITCH=128;
constexpr int NW=8,QBLK=32,QB=QBLK*NW,KVBLK=64;
__device__ __forceinline__ int crow(int r,int hi){return (r&3)+8*(r>>2)+4*hi;}
#define SBAR() __builtin_amdgcn_sched_barrier(0)
constexpr int NSLOT=3, SLOTB=8192;
constexpr int LDS_K=0, LDS_V=NSLOT*SLOTB, LDS_WS=2*NSLOT*SLOTB, LDS_OST=LDS_WS+NW*64*4, LDS_BYTES=LDS_OST+NW*4096;
constexpr float C2=0.125f*1.4426950408889634f;
__device__ __forceinline__ void glds16(const void*gsrc,unsigned lds_dst){unsigned keep;
  asm volatile("s_mov_b32 %0, m0\n\ts_mov_b32 m0, %2\n\ts_nop 0\n\tglobal_load_lds_dwordx4 %1, off\n\ts_mov_b32 m0, %0":"=&s"(keep):"v"(gsrc),"s"(lds_dst):"memory");}
__device__ __forceinline__ float max3f(float a,float b,float c){float r;asm("v_max3_f32 %0, %1, %2, %3":"=v"(r):"v"(a),"v"(b),"v"(c));return r;}
__device__ __forceinline__ float max2f(float a,float b){float r;asm("v_max_f32_e32 %0, %1, %2":"=v"(r):"v"(a),"v"(b));return r;}
__device__ __forceinline__ float fadd_s(float a,float b){float r;asm("v_add_f32_e32 %0, %1, %2":"=v"(r):"v"(a),"v"(b));return r;}
__device__ __forceinline__ float fsub_s(float a,float b){float r;asm("v_sub_f32_e32 %0, %1, %2":"=v"(r):"v"(a),"v"(b));return r;}
typedef float f32x2_t __attribute__((ext_vector_type(2))); typedef __bf16 bf16x2_t __attribute__((ext_vector_type(2)));
__device__ __forceinline__ unsigned cvtpk_s(float lo,float hi){f32x2_t v={lo,hi};bf16x2_t b=__builtin_convertvector(v,bf16x2_t);return __builtin_bit_cast(unsigned,b);}
#define WAIT_BAR(N) asm volatile("s_waitcnt vmcnt(" #N ") lgkmcnt(0)\n\ts_barrier":::"memory")

__device__ __forceinline__ void qkt(f32x16&p0,f32x16&p1,const char*Kslot,const bf16x8*qr,const f32x16&negm,int r32,int hi){
  const char*kb=Kslot+hi*1024+r32*16;
  #pragma unroll
  for(int d0=0;d0<4;++d0){
    const bf16x8 b0=*reinterpret_cast<const bf16x8*>(kb+d0*2048);
    const bf16x8 b1=*reinterpret_cast<const bf16x8*>(kb+d0*2048+512);
    if(d0==0){p0=__builtin_amdgcn_mfma_f32_32x32x16_bf16(b0,qr[0],negm,0,0,0);p1=__builtin_amdgcn_mfma_f32_32x32x16_bf16(b1,qr[0],negm,0,0,0);}
    else{p0=__builtin_amdgcn_mfma_f32_32x32x16_bf16(b0,qr[d0],p0,0,0,0);p1=__builtin_amdgcn_mfma_f32_32x32x16_bf16(b1,qr[d0],p1,0,0,0);}}
}
typedef __attribute__((address_space(3))) const char* lds_cptr;
typedef short v4i16_t __attribute__((ext_vector_type(4)));
__device__ __forceinline__ void kload8(bf16x8*kf,lds_cptr kp){
  kf[0]=*(const __attribute__((address_space(3))) bf16x8*)(kp);      kf[1]=*(const __attribute__((address_space(3))) bf16x8*)(kp+512);
  kf[2]=*(const __attribute__((address_space(3))) bf16x8*)(kp+2048); kf[3]=*(const __attribute__((address_space(3))) bf16x8*)(kp+2560);
  kf[4]=*(const __attribute__((address_space(3))) bf16x8*)(kp+4096); kf[5]=*(const __attribute__((address_space(3))) bf16x8*)(kp+4608);
  kf[6]=*(const __attribute__((address_space(3))) bf16x8*)(kp+6144); kf[7]=*(const __attribute__((address_space(3))) bf16x8*)(kp+6656);
}
__device__ __forceinline__ void kload2(bf16x8*kf,lds_cptr kp,int j){ kf[2*j]=*(const __attribute__((address_space(3))) bf16x8*)(kp+j*2048); kf[2*j+1]=*(const __attribute__((address_space(3))) bf16x8*)(kp+j*2048+512); }
__device__ __forceinline__ s16x4 vtr(lds_cptr p){ return __builtin_bit_cast(s16x4,__builtin_amdgcn_ds_read_tr16_b64_v4i16((__attribute__((address_space(3))) v4i16_t*)p)); }
__device__ __forceinline__ void pv(f32x16*o,int vb,bf16x8 pa0,bf16x8 pa1,bf16x8 pa2,bf16x8 pa3){
  #pragma unroll
  for(int d0=0;d0<2;++d0){s16x4 lo[4],hi[4];
    #pragma unroll
    for(int ks=0;ks<4;++ks){
      asm volatile("ds_read_b64_tr_b16 %0,%1 offset:%c2":"=&v"(lo[ks]):"v"(vb),"i"(d0*4096+ks*1024):"memory");
      asm volatile("ds_read_b64_tr_b16 %0,%1 offset:%c2":"=&v"(hi[ks]):"v"(vb),"i"(d0*4096+ks*1024+512):"memory");}
    asm volatile("s_waitcnt lgkmcnt(0)":::"memory");SBAR();
    #define PK(k) (bf16x8){lo[k][0],lo[k][1],lo[k][2],lo[k][3],hi[k][0],hi[k][1],hi[k][2],hi[k][3]}
    o[d0]=__builtin_amdgcn_mfma_f32_32x32x16_bf16(pa0,PK(0),o[d0],0,0,0);
    o[d0]=__builtin_amdgcn_mfma_f32_32x32x16_bf16(pa1,PK(1),o[d0],0,0,0);
    o[d0]=__builtin_amdgcn_mfma_f32_32x32x16_bf16(pa2,PK(2),o[d0],0,0,0);
    o[d0]=__builtin_amdgcn_mfma_f32_32x32x16_bf16(pa3,PK(3),o[d0],0,0,0);
    #undef PK
  }
}

#ifndef ATTN_STORE16
#define ATTN_STORE16(p,v) (*(u32x4*)(p)=(v))
#endif
template<int THRL> __device__ __forceinline__ void attn_unit(abf16*Qb,abf16*Ob,const abf16*__restrict__ Kh,const abf16*__restrict__ Vh,const int NT,char*shm,const int tid,const float mref){
  const int lane=tid&63,r32=lane&31,hi=lane>>5; const int wid=__builtin_amdgcn_readfirstlane(tid>>6);
  const abf16*Qw=Qb+(long)(wid*QBLK)*DM;
  const unsigned lds0=(unsigned)(uintptr_t)shm;
  float*wsf=(float*)(shm+LDS_WS)+wid*64;
  const abf16*ksrc=Kh+(long)lane*KVPITCH+wid*8;
  const abf16*vsrc=Vh+(long)(16*(wid&3)+(lane>>2))*KVPITCH+(wid>>2)*32+(lane&3)*8;
  const unsigned kdst=lds0+LDS_K+wid*1024, vdst=lds0+LDS_V+wid*1024;
  #define DMA_K(t,slot) glds16(ksrc+(long)(t)*KVBLK*KVPITCH,(unsigned)__builtin_amdgcn_readfirstlane(kdst+(slot)))
  #define DMA_V(t,slot) glds16(vsrc+(long)(t)*KVBLK*KVPITCH,(unsigned)__builtin_amdgcn_readfirstlane(vdst+(slot)))
  const int vb0=(int)(lds0+LDS_V)+((lane>>4)&1)*32+(lane&3)*8+(4*hi+((lane&15)>>2))*64;
  const char*Kbase=shm+LDS_K; bf16x8 kf[8];
  const lds_cptr shm3=(lds_cptr)shm; const lds_cptr kp0=shm3+LDS_K+hi*1024+r32*16; const lds_cptr vp0=shm3+LDS_V+((lane>>4)&1)*32+(lane&3)*8+(4*hi+((lane&15)>>2))*64;
  DMA_K(0,0);DMA_V(0,0);DMA_K(1,SLOTB);
  bf16x8 qr[4];
  #pragma unroll
  for(int d0=0;d0<4;++d0)qr[d0]=*reinterpret_cast<const bf16x8*>(&Qw[(long)r32*DM+d0*16+hi*8]);
  float l_reg=0.f;f32x16 o[2];o[0]=f32x16{};o[1]=f32x16{};f32x16 negm;
  #pragma unroll
  for(int r=0;r<16;++r)negm[r]=-mref;
  asm volatile("":"+v"(negm));
  #define CMASK(P0,P1,t) do{}while(0)
  #define START(P0,P1) do{ _Pragma("unroll") for(int r=0;r<16;++r)P0[r]=__builtin_amdgcn_exp2f(P0[r]); }while(0)
  #define RESC() do{}while(0)
  f32x16 pA0,pA1,pB0,pB1;
  int sl_prev=0,sl_cur=0,sl_next=SLOTB;
  #define ROT() do{sl_prev=sl_cur;sl_cur=sl_next;sl_next=(sl_next==(NSLOT-1)*SLOTB)?0:sl_next+SLOTB;}while(0)
  DMA_K(2,2*SLOTB);
  WAIT_BAR(3);
  qkt(pA0,pA1,Kbase,qr,negm,r32,hi);asm volatile("s_nop 15\n\ts_nop 7":"+v"(pA0),"+v"(pA1));CMASK(pA0,pA1,0);
  START(pA0,pA1);
  _Pragma("unroll") for(int r=0;r<16;++r)pA1[r]=__builtin_amdgcn_exp2f(pA1[r]);
  WAIT_BAR(0);
  DMA_K(3,0);DMA_V(1,SLOTB);
  ROT();
  kload8(kf,kp0+sl_cur);
  WAIT_BAR(2);
  s16x4 vlo[8],vhi[8]; u32x4 pw0,pw1,pw2,pw3;
  #define PKW(P,B) cvtpk_s(P[B],P[B+1])
  #define PAF(k) __builtin_bit_cast(bf16x8,pw##k)
  #define VFR(i) (bf16x8){vlo[i][0],vlo[i][1],vlo[i][2],vlo[i][3],vhi[i][0],vhi[i][1],vhi[i][2],vhi[i][3]}
  #define PIN(x) asm volatile("":"+v"(x))
  #define MX3(a,b,c) __builtin_fmaxf(__builtin_fmaxf((a),(b)),(c))
  #define GAPA(MF,A0,A1,A2,A3,W0,W1,PW) do{ MF; sacc+=A0; sacc+=A1; sacc+=A2; sacc+=A3; PIN(sacc); W0; W1; PIN(PW); SBAR(); }while(0)
  #define EX(v) __builtin_amdgcn_exp2f(v)
  #define GAPB(MF,X,B) do{ MF; X[B]=EX(X[B]); X[B+1]=EX(X[B+1]); X[B+2]=EX(X[B+2]); X[B+3]=EX(X[B+3]); PIN(X); SBAR(); }while(0)
  #define VRD(i) do{ vlo[i]=vtr(vp_+(((i)>>2)*4096+((i)&3)*1024)); vhi[i]=vtr(vp_+(((i)>>2)*4096+((i)&3)*1024+512)); }while(0)
  #define KRD(G,j) do{ if(G){ kload2(kf,kp0+sl_next,j); SBAR(); } }while(0)
  #define STEP(C0,C1,P0,P1,t,GK,GV,GL) do{ SBAR(); \
    const lds_cptr vp_=vp0+sl_prev; \
    VRD(0); SBAR(); float sacc=(P0[0]+P0[1]); \
    GAPA(C0=__builtin_amdgcn_mfma_f32_32x32x16_bf16(kf[0],qr[0],negm,0,0,0), P0[2],P0[3],P0[4],P0[5],     pw0[0]=PKW(P0,0), pw0[1]=PKW(P0,2), pw0); \
    VRD(4); SBAR(); GAPA(C1=__builtin_amdgcn_mfma_f32_32x32x16_bf16(kf[1],qr[0],negm,0,0,0), P0[6],P0[7],P0[8],P0[9],     pw0[2]=PKW(P0,4), pw0[3]=PKW(P0,6), pw0); \
    VRD(1); SBAR(); GAPA(C0=__builtin_amdgcn_mfma_f32_32x32x16_bf16(kf[2],qr[1],C0,0,0,0),   P0[10],P0[11],P0[12],P0[13], pw1[0]=PKW(P0,8), pw1[1]=PKW(P0,10), pw1); \
    VRD(5); SBAR(); GAPA(C1=__builtin_amdgcn_mfma_f32_32x32x16_bf16(kf[3],qr[1],C1,0,0,0),   P0[14],P0[15],P1[0],P1[1],   pw1[2]=PKW(P0,12),pw1[3]=PKW(P0,14), pw1); \
    VRD(2); SBAR(); GAPA(C0=__builtin_amdgcn_mfma_f32_32x32x16_bf16(kf[4],qr[2],C0,0,0,0),   P1[2],P1[3],P1[4],P1[5],     pw2[0]=PKW(P1,0), pw2[1]=PKW(P1,2), pw2); \
    VRD(6); SBAR(); GAPA(C1=__builtin_amdgcn_mfma_f32_32x32x16_bf16(kf[5],qr[2],C1,0,0,0),   P1[6],P1[7],P1[8],P1[9],     pw2[2]=PKW(P1,4), pw2[3]=PKW(P1,6), pw2); \
    VRD(3); SBAR(); GAPA(C0=__builtin_amdgcn_mfma_f32_32x32x16_bf16(kf[6],qr[3],C0,0,0,0),   P1[10],P1[11],P1[12],P1[13], pw3[0]=PKW(P1,8), pw3[1]=PKW(P1,10), pw3); \
    VRD(7); SBAR(); GAPA(C1=__builtin_amdgcn_mfma_f32_32x32x16_bf16(kf[7],qr[3],C1,0,0,0),   P1[14],P1[15],0.f,0.f,       pw3[2]=PKW(P1,12),pw3[3]=PKW(P1,14), pw3); \
    l_reg+=sacc; \
    if(GK){DMA_K((t)+3,sl_cur);} if(GV){DMA_V((t)+1,sl_next);} \
    CMASK(C0,C1,t); \
    SBAR(); \
    GAPB(o[0]=__builtin_amdgcn_mfma_f32_32x32x16_bf16(PAF(0),VFR(0),o[0],0,0,0), C0,0); \
    GAPB(o[1]=__builtin_amdgcn_mfma_f32_32x32x16_bf16(PAF(0),VFR(4),o[1],0,0,0), C0,4); \
    KRD(GL,0); GAPB(o[0]=__builtin_amdgcn_mfma_f32_32x32x16_bf16(PAF(1),VFR(1),o[0],0,0,0), C0,8); \
    KRD(GL,1); GAPB(o[1]=__builtin_amdgcn_mfma_f32_32x32x16_bf16(PAF(1),VFR(5),o[1],0,0,0), C0,12); \
    KRD(GL,2); GAPB(o[0]=__builtin_amdgcn_mfma_f32_32x32x16_bf16(PAF(2),VFR(2),o[0],0,0,0), C1,0); \
    KRD(GL,3); GAPB(o[1]=__builtin_amdgcn_mfma_f32_32x32x16_bf16(PAF(2),VFR(6),o[1],0,0,0), C1,4); \
    GAPB(o[0]=__builtin_amdgcn_mfma_f32_32x32x16_bf16(PAF(3),VFR(3),o[0],0,0,0), C1,8); \
    GAPB(o[1]=__builtin_amdgcn_mfma_f32_32x32x16_bf16(PAF(3),VFR(7),o[1],0,0,0), C1,12); \
    }while(0)
  int t=1;
  #undef CMASK
  #define CMASK(P0,P1,t) do{}while(0)
  for(;t+5<NT;t+=2){
    STEP(pB0,pB1,pA0,pA1,t,true,true,true);     WAIT_BAR(2); RESC(); ROT();
    STEP(pA0,pA1,pB0,pB1,t+1,true,true,true);   WAIT_BAR(2); RESC(); ROT();
  }
  #undef CMASK
  #define CMASK(P0,P1,t) do{}while(0)
  #define ENDW(tt) do{ if((tt)+3<NT){WAIT_BAR(2);} else if((tt)+2<NT){WAIT_BAR(1);} else {WAIT_BAR(0);} }while(0)
  for(;t+1<NT;t+=2){
    STEP(pB0,pB1,pA0,pA1,t,(t+3<NT),(t+1<NT),(t+1<NT));       ENDW(t);   RESC(); ROT();
    STEP(pA0,pA1,pB0,pB1,t+1,(t+4<NT),(t+2<NT),(t+2<NT));     ENDW(t+1); RESC(); ROT();
  }
  STEP(pB0,pB1,pA0,pA1,NT-1,false,false,false); RESC();
  { float sacc=pB0[0]+pB0[1]; _Pragma("unroll") for(int r=2;r<16;++r)sacc+=pB0[r]; _Pragma("unroll") for(int r=0;r<16;++r)sacc+=pB1[r]; l_reg+=sacc;
    pw0=(u32x4){PKW(pB0,0),PKW(pB0,2),PKW(pB0,4),PKW(pB0,6)};pw1=(u32x4){PKW(pB0,8),PKW(pB0,10),PKW(pB0,12),PKW(pB0,14)};pw2=(u32x4){PKW(pB1,0),PKW(pB1,2),PKW(pB1,4),PKW(pB1,6)};pw3=(u32x4){PKW(pB1,8),PKW(pB1,10),PKW(pB1,12),PKW(pB1,14)};
    SBAR(); pv(o,vb0+sl_cur,PAF(0),PAF(1),PAF(2),PAF(3)); }
  #undef PKW
  #undef PAF
  #undef VFR
  #undef PIN
  #undef MX3
  #undef GAPA
  #undef GAPB
  #undef EX
  #undef VRD
  #undef KRD
  #undef STEP
  #undef ENDW
  {auto rr=__builtin_amdgcn_permlane32_swap(__float_as_uint(l_reg),__float_as_uint(l_reg),false,false);l_reg=__uint_as_float(rr[0])+__uint_as_float(rr[1]);}
  if(hi==0)wsf[32+r32]=l_reg;asm volatile("s_waitcnt lgkmcnt(0)":::"memory");
  float rli[16];
  #pragma unroll
  for(int r=0;r<16;++r)rli[r]=__builtin_amdgcn_rcpf(wsf[32+crow(r,hi)]);
  abf16*Ow=Ob+(long)(wid*QBLK)*DM;
  { abf16*stg=(abf16*)(shm+LDS_OST)+wid*2048;
    #pragma unroll
    for(int r=0;r<16;++r){const int orow=crow(r,hi);
      #pragma unroll
      for(int d0=0;d0<2;++d0)stg[orow*64+d0*32+r32]=__float2bfloat16(o[d0][r]*rli[r]);}
    asm volatile("s_waitcnt lgkmcnt(0)":::"memory");
    #pragma unroll
    for(int i=0;i<4;++i){const int row=i*8+(lane>>3),ch=lane&7; const u32x4 v=*(const u32x4*)(stg+row*64+ch*8); ATTN_STORE16(Ow+(long)row*DM+ch*8,v);} }
  asm volatile("s_waitcnt lgkmcnt(0)\n\ts_barrier":::"memory");
  #undef DMA_K
  #undef DMA_V
  #undef CMASK
  #undef START
  #undef RESC
  #undef ROT
}
constexpr int ATTN_LDS_BYTES=LDS_BYTES;
#undef SBAR
#undef WAIT_BAR
}

__device__ __forceinline__ void phase_attn_fast(const Ctx& C, int l, bool dummy_out = false) {
    using attn_body::abf16;
    abf16* MIX = (abf16*)(C.ws + WS_MIX); const abf16* KB = (const abf16*)(C.ws + WS_KB); const abf16* VB = (const abf16*)(C.ws + WS_VB);
    const int nctx = (l == 0) ? 64 : 0;
    float mq = fabsf(C.g_q[l * 64 + C.lane]), mk = fabsf(C.g_k[l * 64 + C.lane]);
#pragma unroll
    for (int o = 1; o < 64; o <<= 1) { mq = fmaxf(mq, shx(mq, o, C.lane)); mk = fmaxf(mk, shx(mk, o, C.lane)); }
    const float mref = fminf(64.0f * C2 * mq * mk * 1.02f + 0.5f, 96.0f);
    for (int i = 0;; ++i) {
        int U;
        if (C.G == 256) {
            if (i < 4) U = (C.vcu >> 5) * 128 + i * 32 + (C.vcu & 31);
            else if (i == 4 && nctx && (C.vcu & 3) == 0) U = 1024 + (C.vcu >> 2);
            else break;
        } else { U = i * C.G + C.vcu; if (U >= 1024 + nctx) break; }
        int b, h, qrow, key0, NT;
        if (U < 1024) { const int g = U >> 6, r = U & 63; b = g >> 1; h = (g & 1) * 4 + (r >> 4); qrow = b * SEQ + (r & 15) * 256; key0 = 0; NT = KVROWS / 64; }
        else { const int id = U - 1024; b = id >> 3; h = id & 7; qrow = M_LAT + b * CTXL; key0 = SEQ; NT = CTXL / 64; }
        const size_t kvoff = ((size_t)b * KVROWS + key0) * KVP + (h >> 2) * 64;
        abf16* Obase = dummy_out ? (abf16*)(C.ws + WS_AP) : MIX;
        attn_body::attn_unit<8>(MIX + (size_t)qrow * DM + h * 64, Obase + (size_t)qrow * DM + h * 64, KB + kvoff, VB + kvoff, NT, C.lds_gen, C.tid, mref);
    }
}

__device__ __forceinline__ void ffn_fix_panel(const Ctx& C, int l, int pm) {
    const bf16* EDGE = WSP(bf16, WS_EDGE); bf16* ACT = WSP(bf16, WS_ACT);
    for (int idx = C.tid; idx < 2 * 352; idx += NTHREADS) {
        const int side = idx >= 352 ? 1 : 0, j0 = (idx - side * 352) * 8, R = pm * 256;
        bool first, last; if (pm < 128) { first = (R & 4095) == 0; last = ((R + 255) & 4095) == 4095; } else { first = true; last = true; }
        const bf16 *pu, *px, *pd; bool hu, hd; int row;
        if (side == 0) { row = R; hu = !first; hd = true; pu = EDGE + (size_t)((pm - 1) * 4 + 3) * NUP; px = EDGE + (size_t)(pm * 4 + 0) * NUP; pd = EDGE + (size_t)(pm * 4 + 1) * NUP; }
        else { row = R + 255; hu = true; hd = !last; pu = EDGE + (size_t)(pm * 4 + 2) * NUP; px = EDGE + (size_t)(pm * 4 + 3) * NUP; pd = EDGE + (size_t)((pm + 1) * 4 + 0) * NUP; }
        float au[8], ag[8];
#pragma unroll
        for (int e = 0; e < 8; ++e) { au[e] = 0.f; ag[e] = 0.f; }
#pragma unroll
        for (int k = 0; k < 3; ++k) { const bool has = (k == 0) ? hu : (k == 2) ? hd : true; const bf16* rp = ((k == 0) ? pu : (k == 2) ? pd : px) + j0;
            if (has) { float u[8], g[8]; unpack8(*(const v4u*)rp, u); unpack8(*(const v4u*)(rp + DFF), g);
                const float* wu = C.ffn_conv_w + (size_t)(l * 3 + k) * NUP + j0; const f32x4 wu0 = *(const f32x4*)wu, wu1 = *(const f32x4*)(wu + 4), wg0 = *(const f32x4*)(wu + DFF), wg1 = *(const f32x4*)(wu + DFF + 4);
#pragma unroll
                for (int e = 0; e < 4; ++e) { au[e] += wu0[e] * u[e]; au[4 + e] += wu1[e] * u[4 + e]; ag[e] += wg0[e] * g[e]; ag[4 + e] += wg1[e] * g[4 + e]; } } }
        float o[8];
#pragma unroll
        for (int e = 0; e < 8; ++e) o[e] = silu_(ag[e]) * au[e];
        *(v4u*)(ACT + (size_t)row * DFF + j0) = pack8(o);
    }
}
__device__ __forceinline__ void phase_final(const Ctx& C) {
    const float* __restrict__ STA = WSP(float, WS_STA); const bf16* __restrict__ XR = WSP(bf16, WS_XR);
    f32x4 g[2][2];
#pragma unroll
    for (int j = 0; j < 2; ++j) { g[j][0] = *(const f32x4*)(C.g_final + C.lane * 8 + 512 * j); g[j][1] = *(const f32x4*)(C.g_final + C.lane * 8 + 512 * j + 4); }
    for (int m = C.gw; m < M_LAT; m += C.NGW) {
        float s = STA[(size_t)m * 16 + (C.lane & 15)];
        v4u w[2];
#pragma unroll
        for (int j = 0; j < 2; ++j) w[j] = *(const v4u*)(XR + (size_t)m * DM + C.lane * 8 + 512 * j);
        s += shx(s, 1, C.lane); s += shx(s, 2, C.lane); s += shx(s, 4, C.lane); s += shx(s, 8, C.lane);
        const float r = rsqrtf(s * (1.0f / DM) + EPS);
#pragma unroll
        for (int j = 0; j < 2; ++j) { float x[8]; unpack8(w[j], x); float* o = C.out + (size_t)m * DM + C.lane * 8 + 512 * j;
            *(f32x4*)o = (f32x4){x[0], x[1], x[2], x[3]} * r * g[j][0]; *(f32x4*)(o + 4) = (f32x4){x[4], x[5], x[6], x[7]} * r * g[j][1]; }
    }
}

namespace pg8 {
#define PG8_LAS __attribute__((address_space(3)))
typedef unsigned short bf16_t;
typedef short bf16x8 __attribute__((ext_vector_type(8)));
typedef float f32x4 __attribute__((ext_vector_type(4)));
typedef unsigned u32x4 __attribute__((ext_vector_type(4)));
constexpr int BM = 256, BK = 64, HALF = 128, HTB = HALF * BK * 2  , STAGE_BYTES = 8 * HTB, NXCD = 8, WGM = 8;

__host__ __device__ __forceinline__ int lds_byte(int r, int c) { const int st = (r >> 4) * 2 + (c >> 5), rr = r & 15, cc = c & 31, ob = rr * 64 + cc * 2; return st * 1024 + (ob ^ (((ob >> 9) & 1) << 5)); }
__host__ __device__ __forceinline__ void stage_rc(int b, int& R, int& C) { const int st = b / 1024, sb = b % 1024, swz = sb ^ (((sb >> 9) & 1) << 5); R = (st >> 1) * 16 + swz / 64; C = (st & 1) * 32 + (swz % 64) / 2; }
__host__ __device__ __forceinline__ int perm32(int rho) { const int n = rho >> 4, i = rho & 15; return 8 * (i >> 2) + 4 * n + (i & 3); }

struct Unit { int pm, pn; };
struct Gemm { const bf16_t* A; const bf16_t* Bt; int M, N, K; int ksub = 0; };

struct StaticOrder {
    int nM, nN, nwg, G, c;
    __host__ __device__ void init(int M, int N, int G_, int c_) { nM = M / BM; nN = N / BM; nwg = nM * nN; G = G_; c = c_; }
    __host__ __device__ bool next(int i, Unit& u) const {
        const long L = (long)i * G + c; if (L >= nwg) return false;
        int wgid = (int)L; { const int q = nwg / NXCD, r = nwg % NXCD, xcd = wgid % NXCD, off = wgid / NXCD; wgid = (xcd < r ? xcd * (q + 1) : r * (q + 1) + (xcd - r) * q) + off; }
        const int nig = WGM * nN, gid = wgid / nig, fm = gid * WGM, gsz = (nM - fm) < WGM ? (nM - fm) : WGM;
        u.pm = fm + ((wgid % nig) % gsz); u.pn = (wgid % nig) / gsz; return true;
    }
    __device__ __forceinline__ void a_ready(const Unit&) const {}
    __device__ __forceinline__ void done(const Unit&) const {}
};


template <class Epi, class Sched, bool ALIGN_EPI = false, bool SP2 = false>
__device__ __forceinline__ void gemm_phase(PG8_LAS unsigned char* lds, const Gemm g, const Sched& S, const Epi& E, const int tid) {
    const int wid = __builtin_amdgcn_readfirstlane(tid >> 6), lane = tid & 63, wr = wid >> 2, wc = wid & 3, fr = lane & 15, fq = lane >> 4;
    const int K = g.K, nt = (g.ksub ? g.ksub : K) / BK;
#define PG8_KOF(u) (g.ksub ? (size_t)((u).pn & 1) * (size_t)g.ksub * 2 : (size_t)0)
    unsigned voffA[2], voffB[2];
#pragma unroll
    for (int i = 0; i < 2; ++i) { int R, C; stage_rc(tid * 16 + i * 8192, R, C); const int Rb = Epi::PERM ? ((R & ~31) + perm32(R & 31)) : R;
        voffA[i] = (unsigned)(R * K + C) * 2u; voffB[i] = (unsigned)(Rb * K + C) * 2u; }
    const size_t kstep = (size_t)(BK * 2);
    const size_t hstep = (size_t)HALF * K * 2;
    const size_t tstep = 2 * hstep;
    const unsigned ldsw = (unsigned)wid * 1024u;
    const int aoff = lds_byte(wr * 64 + fr, fq * 8), boff = lds_byte(wc * 32 + fr, fq * 8);
#define PG8_SA(b, h) (((b) * 2 + (h)) * HTB)
#define PG8_SB(b, h) ((4 + (b) * 2 + (h)) * HTB)
#define PG8_STAGE(bufoff, gbase, voff) do { _Pragma("unroll") for (int _i = 0; _i < 2; ++_i) \
        __builtin_amdgcn_global_load_lds((const unsigned*)((const char*)(gbase) + (voff)[_i]), (PG8_LAS unsigned*)(lds + (bufoff) + ldsw + _i * 8192), 16, 0, 0); } while (0)
#define PG8_LDA(dst, b, h) do { _Pragma("unroll") for (int m = 0; m < 4; ++m) _Pragma("unroll") for (int k = 0; k < 2; ++k) dst[m][k] = *(const PG8_LAS bf16x8*)(lds + PG8_SA(b, h) + aoff + m * 2048 + k * 1024); } while (0)
#define PG8_LDB(dst, b, h) do { _Pragma("unroll") for (int n = 0; n < 2; ++n) _Pragma("unroll") for (int k = 0; k < 2; ++k) dst[n][k] = *(const PG8_LAS bf16x8*)(lds + PG8_SB(b, h) + boff + n * 2048 + k * 1024); } while (0)
#define PG8_MMA(ai, bj, At, Bt) do { __builtin_amdgcn_s_setprio(1); _Pragma("unroll") for (int m = 0; m < 4; ++m) _Pragma("unroll") for (int n = 0; n < 2; ++n) _Pragma("unroll") for (int k = 0; k < 2; ++k) \
        acc[ai][bj][m][n] = __builtin_amdgcn_mfma_f32_16x16x32_bf16(Bt[n][k], At[m][k], acc[ai][bj][m][n], 0, 0, 0); __builtin_amdgcn_s_setprio(0); } while (0)
#define PG8_WAIT_V(n) asm volatile("s_waitcnt vmcnt(" #n ")" ::: "memory")
#define PG8_WAIT_L(n) asm volatile("s_waitcnt lgkmcnt(" #n ")" ::: "memory")
#define PG8_BAR __builtin_amdgcn_s_barrier()
#define PG8_SCHED __builtin_amdgcn_sched_barrier(0)
    Unit cur, nxt; int ui = 0;
    if (!S.next(0, cur)) return;
    f32x4 acc[2][2][4][2];
#pragma unroll
    for (int a = 0; a < 2; ++a)
#pragma unroll
        for (int b = 0; b < 2; ++b)
#pragma unroll
            for (int m = 0; m < 4; ++m)
#pragma unroll
                for (int n = 0; n < 2; ++n) acc[a][b][m][n] = (f32x4){0.f, 0.f, 0.f, 0.f};
    bf16x8 At[4][2], B0[2][2], B1[2][2];
    const char* cA = (const char*)g.A + (size_t)cur.pm * tstep + PG8_KOF(cur); const char* cB = (const char*)g.Bt + (size_t)cur.pn * tstep + PG8_KOF(cur);
    S.a_ready(cur);
    if constexpr (SP2) {
        PG8_STAGE(PG8_SB(0, 0), cB, voffB); PG8_STAGE(PG8_SB(0, 1), cB + hstep, voffB); PG8_STAGE(PG8_SA(0, 0), cA, voffA); PG8_STAGE(PG8_SA(0, 1), cA + hstep, voffA);
        if (wr == 1) PG8_BAR;
        PG8_WAIT_V(2); PG8_BAR;
        PG8_STAGE(PG8_SB(1, 0), cB + kstep, voffB); PG8_STAGE(PG8_SA(1, 0), cA + kstep, voffA); PG8_STAGE(PG8_SB(1, 1), cB + hstep + kstep, voffB);
        PG8_WAIT_V(6); PG8_BAR;
    } else {
        PG8_STAGE(PG8_SB(0, 0), cB, voffB); PG8_STAGE(PG8_SA(0, 0), cA, voffA); PG8_STAGE(PG8_SB(0, 1), cB + hstep, voffB); PG8_STAGE(PG8_SA(0, 1), cA + hstep, voffA);
        if (wr == 1) PG8_BAR;
        PG8_WAIT_V(4); PG8_BAR;
        PG8_STAGE(PG8_SB(1, 0), cB + kstep, voffB); PG8_STAGE(PG8_SA(1, 0), cA + kstep, voffA); PG8_STAGE(PG8_SB(1, 1), cB + hstep + kstep, voffB);
        PG8_WAIT_V(6); PG8_BAR;
    }
    for (;;) {
        const bool has_next = S.next(ui + 1, nxt);
        const char* nA = has_next ? (const char*)g.A + (size_t)nxt.pm * tstep + PG8_KOF(nxt) : cA; const char* nB = has_next ? (const char*)g.Bt + (size_t)nxt.pn * tstep + PG8_KOF(nxt) : cB;
        for (int t = 0; t < nt; t += 2) {
            const bool last = (t == nt - 2);
            const char* a1 = cA + (size_t)(t + 1) * kstep;
            const char* a2 = last ? nA : cA + (size_t)(t + 2) * kstep; const char* b2 = last ? nB : cB + (size_t)(t + 2) * kstep;
            const char* a3 = a2 + kstep; const char* b3 = b2 + kstep;
            if (last && has_next) S.a_ready(nxt);
            if constexpr (SP2) {
            PG8_LDB(B0, 0, 0); PG8_LDB(B1, 0, 1); PG8_SCHED; PG8_LDA(At, 0, 0); PG8_STAGE(PG8_SA(1, 1), a1 + hstep, voffA);
            PG8_WAIT_V(8); PG8_WAIT_L(0); PG8_BAR; PG8_MMA(0, 0, At, B0); PG8_MMA(0, 1, At, B1); PG8_BAR; PG8_SCHED;
            PG8_LDA(At, 0, 1); PG8_STAGE(PG8_SB(0, 0), b2, voffB); PG8_STAGE(PG8_SB(0, 1), b2 + hstep, voffB); PG8_STAGE(PG8_SA(0, 0), a2, voffA);
            PG8_WAIT_V(8); PG8_WAIT_L(0); PG8_BAR; PG8_MMA(1, 0, At, B0); PG8_MMA(1, 1, At, B1); PG8_BAR; PG8_SCHED;
            PG8_LDB(B0, 1, 0); PG8_LDB(B1, 1, 1); PG8_SCHED; PG8_LDA(At, 1, 0); PG8_STAGE(PG8_SA(0, 1), a2 + hstep, voffA);
            PG8_WAIT_V(8); PG8_WAIT_L(0); PG8_BAR; PG8_MMA(0, 0, At, B0); PG8_MMA(0, 1, At, B1); PG8_BAR; PG8_SCHED;
            PG8_LDA(At, 1, 1); PG8_STAGE(PG8_SB(1, 0), b3, voffB); PG8_STAGE(PG8_SB(1, 1), b3 + hstep, voffB); PG8_STAGE(PG8_SA(1, 0), a3, voffA);
            PG8_WAIT_V(8); PG8_WAIT_L(0); PG8_BAR; PG8_MMA(1, 0, At, B0); PG8_MMA(1, 1, At, B1); PG8_BAR; PG8_SCHED;
            } else {
            PG8_LDB(B0, 0, 0); PG8_SCHED; PG8_LDA(At, 0, 0); PG8_STAGE(PG8_SA(1, 1), a1 + hstep, voffA);
            PG8_WAIT_L(8); PG8_BAR; PG8_WAIT_L(0); PG8_MMA(0, 0, At, B0); PG8_BAR; PG8_SCHED;
            PG8_LDB(B1, 0, 1); PG8_STAGE(PG8_SB(0, 0), b2, voffB);
            PG8_BAR; PG8_WAIT_L(0); PG8_MMA(0, 1, At, B1); PG8_BAR;
            PG8_LDA(At, 0, 1); PG8_STAGE(PG8_SA(0, 0), a2, voffA);
            PG8_BAR; PG8_WAIT_L(0); PG8_MMA(1, 0, At, B0); PG8_BAR; PG8_SCHED;
            PG8_STAGE(PG8_SB(0, 1), b2 + hstep, voffB);
            PG8_WAIT_V(6); PG8_BAR; PG8_MMA(1, 1, At, B1); PG8_BAR;
            PG8_LDB(B0, 1, 0); PG8_SCHED; PG8_LDA(At, 1, 0); PG8_STAGE(PG8_SA(0, 1), a2 + hstep, voffA);
            PG8_WAIT_L(8); PG8_BAR; PG8_WAIT_L(0); PG8_MMA(0, 0, At, B0); PG8_BAR; PG8_SCHED;
            PG8_LDB(B1, 1, 1); PG8_STAGE(PG8_SB(1, 0), b3, voffB);
            PG8_BAR; PG8_WAIT_L(0); PG8_MMA(0, 1, At, B1); PG8_BAR;
            PG8_LDA(At, 1, 1); PG8_STAGE(PG8_SA(1, 0), a3, voffA);
            PG8_BAR; PG8_WAIT_L(0); PG8_MMA(1, 0, At, B0); PG8_BAR; PG8_SCHED;
            PG8_STAGE(PG8_SB(1, 1), b3 + hstep, voffB);
            PG8_WAIT_V(6); PG8_BAR; PG8_MMA(1, 1, At, B1); PG8_BAR;
            }
        }
        if constexpr (ALIGN_EPI) { if (wr == 0) PG8_BAR; }
        if constexpr (!Epi::AFTER_DRAIN) { E(acc, cur, wr, wc, fr, fq); S.done(cur); }
        if (!has_next) break;
#pragma unroll
        for (int a = 0; a < 2; ++a)
#pragma unroll
            for (int b = 0; b < 2; ++b)
#pragma unroll
                for (int m = 0; m < 4; ++m)
#pragma unroll
                    for (int n = 0; n < 2; ++n) acc[a][b][m][n] = (f32x4){0.f, 0.f, 0.f, 0.f};
        cur = nxt; cA = nA; cB = nB; ++ui;
        if constexpr (ALIGN_EPI) { if (wr == 1) PG8_BAR; }
    }
    PG8_WAIT_V(0);
    if constexpr (!ALIGN_EPI) { if (wr == 0) PG8_BAR; }
    PG8_BAR;
    if constexpr (Epi::AFTER_DRAIN) { E.fused(acc, cur, wr, wc, fr, fq, lds, wid, lane); S.done(cur); }
#undef PG8_KOF
#undef PG8_SA
#undef PG8_SB
#undef PG8_STAGE
#undef PG8_LDA
#undef PG8_LDB
#undef PG8_MMA
#undef PG8_WAIT_V
#undef PG8_WAIT_L
#undef PG8_BAR
#undef PG8_SCHED
}
}


struct FastProj {
    static constexpr bool PERM = true, AFTER_DRAIN = false; ProjEpi e; LAS unsigned char* xl;
    __device__ __forceinline__ void operator()(const f32x4 (&acc)[2][2][4][2], const pg8::Unit& u, int wr, int wc, int fr, int fq) const {
        asm volatile("" : "+v"(fr), "+v"(fq));
        LAS float* HS = (LAS float*)xl;
        LAS float* GL = (LAS float*)(xl + 8192);
        const int lrow0 = u.pm * 256 + wr * 64 + fr, grow0 = e.row_off + lrow0, bi = row_bi(e.row_off + u.pm * 256), col0 = u.pn * 256 + wc * 32 + 8 * fq, lane = fq * 16 + fr;
        const int gtile = e.tile0 + u.pn, hsub = wc >> 1, half = wc & 1, tid = (wr * 4 + wc) * 64 + lane;
        const bool qkv = gtile < 3, isq = gtile < 2;
        float rsv[2][4];
        { f32x4 sv[2][4];
#pragma unroll
          for (int ai = 0; ai < 2; ++ai)
#pragma unroll
              for (int m = 0; m < 4; ++m) sv[ai][m] = *(const f32x4*)(e.stats + (size_t)(grow0 + ai * 128 + m * 16) * 16 + fq * 4);
          if (tid < 128) GL[tid] = tid < 64 ? e.gq[tid] : e.gk[tid - 64];
#pragma unroll
          for (int ai = 0; ai < 2; ++ai)
#pragma unroll
              for (int m = 0; m < 4; ++m) { float s = (sv[ai][m].x + sv[ai][m].y) + (sv[ai][m].z + sv[ai][m].w); s += shx(s, 16, lane); s += shx(s, 32, lane); rsv[ai][m] = rsqrtf(s * (1.0f / DM) + EPS); } }
        f32x4 bv[2][2];
#pragma unroll
        for (int bj = 0; bj < 2; ++bj)
#pragma unroll
            for (int n = 0; n < 2; ++n) bv[bj][n] = *(const f32x4*)(e.bias + (size_t)bi * e.ldb + col0 + bj * 128 + 4 * n);
        if (qkv) {
#pragma unroll
            for (int ai = 0; ai < 2; ++ai)
#pragma unroll
                for (int m = 0; m < 4; ++m)
#pragma unroll
                    for (int bj = 0; bj < 2; ++bj) { const f32x4 v0 = acc[ai][bj][m][0] * rsv[ai][m] + bv[bj][0], v1 = acc[ai][bj][m][1] * rsv[ai][m] + bv[bj][1];
                        float q = ((v0.x * v0.x + v0.y * v0.y) + (v0.z * v0.z + v0.w * v0.w)) + ((v1.x * v1.x + v1.y * v1.y) + (v1.z * v1.z + v1.w * v1.w));
                        q += shx(q, 16, lane); q += shx(q, 32, lane);
                        if (fq == 0) HS[((ai * 128 + wr * 64 + m * 16 + fr) * 4 + 2 * bj + hsub) * 2 + half] = q; }
        }
        asm volatile("s_waitcnt lgkmcnt(0)" ::: "memory"); __builtin_amdgcn_s_barrier(); asm volatile("" ::: "memory");
        const int ib = 16 * half + 4 * fq;
#pragma unroll
        for (int ai = 0; ai < 2; ++ai)
#pragma unroll
            for (int m = 0; m < 4; ++m) { int grow = grow0 + ai * 128 + m * 16, hrow = ai * 128 + wr * 64 + m * 16 + fr, lrow = lrow0 + ai * 128 + m * 16;
                asm volatile("" : "+v"(grow), "+v"(hrow), "+v"(lrow));
                const float rs = rsv[ai][m];
                if (!qkv) {
                    bf16* rowp = e.Cout + ((size_t)(gtile - 3) * M_ALL + grow) * 256 + wc * 32 + 8 * fq;
#pragma unroll
                    for (int bj = 0; bj < 2; ++bj) { const f32x4 v0 = acc[ai][bj][m][0] * rs + bv[bj][0], v1 = acc[ai][bj][m][1] * rs + bv[bj][1];
                        v4u w; w.x = pk2(v0.x, v0.y); w.y = pk2(v0.z, v0.w); w.z = pk2(v1.x, v1.y); w.w = pk2(v1.z, v1.w); *(v4u*)(rowp + bj * 128) = w; }
                } else {
                    const bool lat = grow < M_LAT; const int t = grow & 4095, pos = half ? (t & 63) : (t >> 6);
                    const f32x4 cs = *(const f32x4*)(e.ropeT + pos * 16 + 4 * fq), sn = *(const f32x4*)(e.ropeT + 1024 + pos * 16 + 4 * fq);
                    int b, kpos; if (lat) { b = grow >> 12; kpos = t; } else { const int mc = grow - M_LAT; b = mc >> 8; kpos = SEQ + (mc & 255); }
#pragma unroll
                    for (int bj = 0; bj < 2; ++bj) { const bool isv = (!isq) && (bj == 1);
                        const f32x2 hp = *(const LAS f32x2*)(HS + (hrow * 4 + 2 * bj + hsub) * 2); const float rinv = rsqrtf((hp.x + hp.y) * (1.0f / 64.0f) + EPS);
                        const int gsel = (isq ? 0 : 64);
                        const f32x4 ga = *(const LAS f32x4*)(GL + gsel + ib), gb = *(const LAS f32x4*)(GL + gsel + 32 + ib);
                        float o[8];
#pragma unroll
                        for (int n = 0; n < 2; ++n) { const f32x4 v = acc[ai][bj][m][n] * rs + bv[bj][n];
                            float a1 = v.x * rinv * ga[2 * n], a2 = v.y * rinv * gb[2 * n], b1 = v.z * rinv * ga[2 * n + 1], b2 = v.w * rinv * gb[2 * n + 1];
                            if (lat) { const float c0 = cs[2 * n], s0 = sn[2 * n], c1 = cs[2 * n + 1], s1 = sn[2 * n + 1];
                                const float ta = a1 * c0 - a2 * s0, tb = a1 * s0 + a2 * c0, tc = b1 * c1 - b2 * s1, td = b1 * s1 + b2 * c1; a1 = ta; a2 = tb; b1 = tc; b2 = td; }
                            const float sc = isq ? C2 : 1.0f;
                            o[4 * n] = isv ? v.x : a1 * sc; o[4 * n + 1] = isv ? v.y : a2 * sc; o[4 * n + 2] = isv ? v.z : b1 * sc; o[4 * n + 3] = isv ? v.w : b2 * sc; }
                        v4u w; w.x = pk2(o[0], o[1]); w.y = pk2(o[2], o[3]); w.z = pk2(o[4], o[5]); w.w = pk2(o[6], o[7]);
                        bf16* dq = e.MIX + (size_t)grow * DM + (gtile * 4 + 2 * bj + hsub) * 64 + 32 * half + 8 * fq;
                        bf16* dkv = (isv ? e.VB : e.KB) + ((size_t)b * KVROWS + kpos) * KVP + hsub * 64 + 32 * half + 8 * fq;
                        *(v4u*)(isq ? dq : dkv) = w; }
                }
                asm volatile("" ::: "memory"); __builtin_amdgcn_sched_barrier(0);
            }
    }
};
template <bool XIN_F32> struct FastRes {
    static constexpr bool PERM = true, AFTER_DRAIN = false; ResEpi e;
    __device__ __forceinline__ void operator()(const f32x4 (&acc)[2][2][4][2], const pg8::Unit& u, int wr, int wc, int fr, int fq) const {
        asm volatile("" : "+v"(fr), "+v"(fq));
        const int pmg = e.pm_off + u.pm, grow0 = pmg * 256 + wr * 64 + fr, bi = row_bi(pmg * 256), col8 = u.pn * 256 + wc * 32 + 8 * fq, lane = fq * 16 + fr;
        f32x4 gt[2][2], gg[2][2], gc[2][2], xf[2][2][2]; v4u xb[2][2];
#pragma unroll
        for (int bj = 0; bj < 2; ++bj) {
#pragma unroll
            for (int n = 0; n < 2; ++n) { const int c = col8 + bj * 128 + 4 * n; gt[bj][n] = *(const f32x4*)(e.gate + (size_t)bi * 6144 + c);
                gg[bj][n] = *(const f32x4*)(e.gn + c); gc[bj][n] = *(const f32x4*)(e.cn + (size_t)bi * 6144 + c);
                if (XIN_F32) xf[0][bj][n] = *(const f32x4*)(e.xi_row(grow0) + c); }
            if (!XIN_F32) xb[0][bj] = *(const v4u*)(e.XR + (size_t)grow0 * DM + col8 + bj * 128); }
#pragma unroll
        for (int bj = 0; bj < 2; ++bj)
#pragma unroll
            for (int n = 0; n < 2; ++n) gg[bj][n] = gg[bj][n] * (gc[bj][n] + 1.0f);
#pragma unroll
        for (int g = 0; g < 8; ++g) { const int ai = g >> 2, m = g & 3, grow = grow0 + ai * 128 + m * 16; float ss = 0.f;
            const int aprow = e.ap_perm ? (grow & ~63) + 16 * (grow & 3) + ((grow & 63) >> 2) : grow;
            if (g < 7) { const int grow1 = grow0 + ((g + 1) >> 2) * 128 + ((g + 1) & 3) * 16;
#pragma unroll
                for (int bj = 0; bj < 2; ++bj) {
                    if (XIN_F32) {
#pragma unroll
                        for (int n = 0; n < 2; ++n) xf[(g + 1) & 1][bj][n] = *(const f32x4*)(e.xi_row(grow1) + col8 + bj * 128 + 4 * n); }
                    else xb[(g + 1) & 1][bj] = *(const v4u*)(e.XR + (size_t)grow1 * DM + col8 + bj * 128); } }
#pragma unroll
            for (int bj = 0; bj < 2; ++bj) { f32x4 x0, x1;
                if (XIN_F32) { x0 = xf[g & 1][bj][0]; x1 = xf[g & 1][bj][1]; }
                else { const v4u w = xb[g & 1][bj]; x0 = (f32x4){bflo(w.x), bfhi(w.x), bflo(w.y), bfhi(w.y)}; x1 = (f32x4){bflo(w.z), bfhi(w.z), bflo(w.w), bfhi(w.w)}; }
                const f32x4 v0 = x0 + gt[bj][0] * acc[ai][bj][m][0], v1 = x1 + gt[bj][1] * acc[ai][bj][m][1];
                ss += ((v0.x * v0.x + v0.y * v0.y) + (v0.z * v0.z + v0.w * v0.w)) + ((v1.x * v1.x + v1.y * v1.y) + (v1.z * v1.z + v1.w * v1.w));
                v4u xo; xo.x = pk2(v0.x, v0.y); xo.y = pk2(v0.z, v0.w); xo.z = pk2(v1.x, v1.y); xo.w = pk2(v1.z, v1.w);
                *(v4u*)(e.XR + (size_t)grow * DM + col8 + bj * 128) = xo;
                if (e.has_ap) { const f32x4 a0 = v0 * gg[bj][0], a1 = v1 * gg[bj][1]; v4u w; w.x = pk2(a0.x, a0.y); w.y = pk2(a0.z, a0.w); w.z = pk2(a1.x, a1.y); w.w = pk2(a1.z, a1.w);
                    *(v4u*)(e.AP + (size_t)aprow * DM + col8 + bj * 128) = w; } }
            ss += shx(ss, 16, lane); ss += shx(ss, 32, lane);
            if (fq == 0) e.stats[(size_t)grow * 16 + u.pn * 4 + wc] = ss;
            asm volatile("" ::: "memory");
        }
    }
};

constexpr int CW_FIN = 8192;
struct FastResFinal {
    static constexpr bool PERM = true, AFTER_DRAIN = false; ResEpi e; const float* gfin; float* outp; float* XB; unsigned* ctl; LAS unsigned char* xl;
    __device__ __forceinline__ void operator()(f32x4 (&acc)[2][2][4][2], const pg8::Unit& u, int wr, int wc, int fr, int fq) const {
        asm volatile("" : "+v"(fr), "+v"(fq));
        LAS float* PL = (LAS float*)xl; LAS float* RS = (LAS float*)(xl + 4096);
        const int grow0 = u.pm * 256 + wr * 64 + fr, bi = row_bi(u.pm * 256), col8 = u.pn * 256 + wc * 32 + 8 * fq, tid = (wr * 4 + wc) * 64 + fq * 16 + fr, lane = fq * 16 + fr;
        f32x4 gt[2][2]; v4u xb[2][2];
#pragma unroll
        for (int bj = 0; bj < 2; ++bj) {
#pragma unroll
            for (int n = 0; n < 2; ++n) gt[bj][n] = *(const f32x4*)(e.gate + (size_t)bi * 6144 + col8 + bj * 128 + 4 * n);
            xb[0][bj] = *(const v4u*)(e.XR + (size_t)grow0 * DM + col8 + bj * 128); }
#pragma unroll
        for (int g = 0; g < 8; ++g) { const int ai = g >> 2, m = g & 3; float ss = 0.f;
            if (g < 7) { const int grow1 = grow0 + ((g + 1) >> 2) * 128 + ((g + 1) & 3) * 16;
#pragma unroll
                for (int bj = 0; bj < 2; ++bj) xb[(g + 1) & 1][bj] = *(const v4u*)(e.XR + (size_t)grow1 * DM + col8 + bj * 128); }
#pragma unroll
            for (int bj = 0; bj < 2; ++bj) { const v4u w = xb[g & 1][bj];
                const f32x4 x0 = (f32x4){bflo(w.x), bfhi(w.x), bflo(w.y), bfhi(w.y)}, x1 = (f32x4){bflo(w.z), bfhi(w.z), bflo(w.w), bfhi(w.w)};
                const f32x4 v0 = x0 + gt[bj][0] * acc[ai][bj][m][0], v1 = x1 + gt[bj][1] * acc[ai][bj][m][1]; acc[ai][bj][m][0] = v0; acc[ai][bj][m][1] = v1;
                ss += ((v0.x * v0.x + v0.y * v0.y) + (v0.z * v0.z + v0.w * v0.w)) + ((v1.x * v1.x + v1.y * v1.y) + (v1.z * v1.z + v1.w * v1.w)); }
            ss += shx(ss, 16, lane); ss += shx(ss, 32, lane);
            if (fq == 0) PL[(ai * 128 + wr * 64 + m * 16 + fr) * 4 + wc] = ss;
            asm volatile("" ::: "memory"); }
        asm volatile("s_waitcnt lgkmcnt(0)" ::: "memory"); __builtin_amdgcn_s_barrier(); asm volatile("" ::: "memory");
        if (tid < 256) { const f32x4 p = *(const LAS f32x4*)(PL + tid * 4); const float s = (p.x + p.y) + (p.z + p.w);
            __hip_atomic_store(XB + (size_t)(u.pm * 256 + tid) * 4 + u.pn, s, __ATOMIC_RELAXED, __HIP_MEMORY_SCOPE_AGENT); }
        asm volatile("s_waitcnt vmcnt(0)" ::: "memory"); __builtin_amdgcn_s_barrier(); asm volatile("" ::: "memory");
        if (tid == 0) __hip_atomic_fetch_add(ctl + CW_FIN + 64 * u.pm, 1u, __ATOMIC_RELAXED, __HIP_MEMORY_SCOPE_AGENT);
        if (tid < 64) { unsigned sp = 0;
            while ((unsigned)__builtin_amdgcn_readfirstlane((int)__hip_atomic_load(ctl + CW_FIN + 64 * u.pm, __ATOMIC_RELAXED, __HIP_MEMORY_SCOPE_AGENT)) < 4u) { __builtin_amdgcn_s_sleep(2); if (++sp > (1u << 22)) break; }
            __builtin_amdgcn_fence(__ATOMIC_ACQUIRE, "agent"); asm volatile("s_waitcnt vmcnt(0)" ::: "memory"); }
        asm volatile("" ::: "memory"); __builtin_amdgcn_s_barrier(); asm volatile("" ::: "memory");
        if (tid < 256) { const float* xbp = XB + (size_t)(u.pm * 256 + tid) * 4; float t = 0.f;
#pragma unroll
            for (int p = 0; p < 4; ++p) t += __hip_atomic_load(xbp + p, __ATOMIC_RELAXED, __HIP_MEMORY_SCOPE_AGENT);
            RS[tid] = rsqrtf(t * (1.0f / DM) + EPS); }
        asm volatile("s_waitcnt lgkmcnt(0)" ::: "memory"); __builtin_amdgcn_s_barrier(); asm volatile("" ::: "memory");
        f32x4 gf[2][2];
#pragma unroll
        for (int bj = 0; bj < 2; ++bj)
#pragma unroll
            for (int n = 0; n < 2; ++n) gf[bj][n] = *(const f32x4*)(gfin + col8 + bj * 128 + 4 * n);
#pragma unroll
        for (int g = 0; g < 8; ++g) { const int ai = g >> 2, m = g & 3, grow = grow0 + ai * 128 + m * 16; const float rs = RS[ai * 128 + wr * 64 + m * 16 + fr]; float* xn = outp + (size_t)grow * DM + col8;
#pragma unroll
            for (int bj = 0; bj < 2; ++bj)
#pragma unroll
                for (int n = 0; n < 2; ++n) *(f32x4*)(xn + bj * 128 + 4 * n) = acc[ai][bj][m][n] * rs * gf[bj][n]; }
    }
};

__device__ __forceinline__ unsigned dpp_ror1(unsigned v) { return (unsigned)__builtin_amdgcn_update_dpp(0, (int)v, 0x121, 0xf, 0xf, false); }
__device__ __forceinline__ unsigned dpp_ror15(unsigned v) { return (unsigned)__builtin_amdgcn_update_dpp(0, (int)v, 0x12F, 0xf, 0xf, false); }
struct FastUpConv {
    static constexpr bool PERM = true, AFTER_DRAIN = false;
    bf16* ACT; bf16* EDGE; const float* stats; const float* bias; const float* cw; LAS unsigned char* xl;
    static __device__ __forceinline__ float ror1f(float v) { return __int_as_float(__builtin_amdgcn_mov_dpp(__float_as_int(v), 0x121, 0xf, 0xf, false)); }
    static __device__ __forceinline__ float shr1_old(float old, float v) { return __int_as_float(__builtin_amdgcn_update_dpp(__float_as_int(old), __float_as_int(v), 0x111, 0xf, 0xf, false)); }
    static __device__ __forceinline__ float shl1_old(float old, float v) { return __int_as_float(__builtin_amdgcn_update_dpp(__float_as_int(old), __float_as_int(v), 0x101, 0xf, 0xf, false)); }
    static __device__ __forceinline__ float sg_(float g2, float u2) { return g2 * u2 * __builtin_amdgcn_rcpf(1.0f + __builtin_amdgcn_exp2f(g2)); }
    static __device__ __forceinline__ float ror15f(float v) { return __int_as_float(__builtin_amdgcn_mov_dpp(__float_as_int(v), 0x12F, 0xf, 0xf, false)); }
    __device__ __forceinline__ void operator()(f32x4 (&acc)[2][2][4][2], const pg8::Unit& u, int wr, int wc, int fr, int fq) const {
        asm volatile("" : "+v"(fr), "+v"(fq));
        LAS float* EX = (LAS float*)xl; LAS float* RS = (LAS float*)(xl + 8192); LAS float* CT = (LAS float*)(xl + 9216);
        const int trow0 = wr * 64 + 4 * fr;
        const int bi = row_bi(u.pm * 256), j0 = u.pn * 128 + wc * 32 + 8 * fq, tid = (wr * 4 + wc) * 64 + fq * 16 + fr;
        const int ct0 = wc * 32 + 8 * fq;
        { const int which = (wr * 4 + wc) >> 1  , c = (tid * 2) & 255, col = (c >> 7) * DFF + u.pn * 128 + (c & 127);
          const f32x2 vb = *(const f32x2*)(bias + (size_t)bi * NUP + col), vw = *(const f32x2*)(cw + (size_t)(which > 0 ? which - 1 : 0) * NUP + col);
          const float csc = (c >> 7) ? -1.4426950408889634f : -0.6931471805599453f;
          const f32x2 v = which == 0 ? vb : vw * csc;
          if (tid < 256) { const f32x4* sp = (const f32x4*)(stats + (size_t)(u.pm * 256 + tid) * 16); const f32x4 a = sp[0], b = sp[1], c4 = sp[2], d = sp[3];
              const float s = ((a.x + a.y) + (a.z + a.w)) + ((b.x + b.y) + (b.z + b.w)) + ((c4.x + c4.y) + (c4.z + c4.w)) + ((d.x + d.y) + (d.z + d.w));
              RS[tid] = rsqrtf(s * (1.0f / DM) + EPS); }
          *(LAS f32x2*)(CT + which * 256 + c) = v; }
        asm volatile("s_waitcnt lgkmcnt(0)" ::: "memory"); __builtin_amdgcn_s_barrier(); asm volatile("" ::: "memory");
        { f32x4 bv[2][2];
#pragma unroll
          for (int bj = 0; bj < 2; ++bj)
#pragma unroll
              for (int n = 0; n < 2; ++n) bv[bj][n] = *(const LAS f32x4*)(CT + bj * 128 + ct0 + 4 * n);
#pragma unroll
          for (int ai = 0; ai < 2; ++ai) { const f32x4 rs4 = *(const LAS f32x4*)(RS + ai * 128 + trow0);
#pragma unroll
              for (int m = 0; m < 4; ++m)
#pragma unroll
                  for (int bj = 0; bj < 2; ++bj)
#pragma unroll
                      for (int n = 0; n < 2; ++n) acc[ai][bj][m][n] = acc[ai][bj][m][n] * rs4[m] + bv[bj][n]; } }
#pragma unroll
        for (int ai = 0; ai < 2; ++ai) { const int s = 2 * ai + wr;
#pragma unroll
            for (int bj = 0; bj < 2; ++bj)
#pragma unroll
                for (int n = 0; n < 2; ++n) {
                    if (fr == 0) *(LAS f32x4*)(EX + ((s * 2 + 0) * 4 + wc) * 64 + (bj * 2 + n) * 16 + fq * 4) = acc[ai][bj][0][n];
                    if (fr == 15) *(LAS f32x4*)(EX + ((s * 2 + 1) * 4 + wc) * 64 + (bj * 2 + n) * 16 + fq * 4) = acc[ai][bj][3][n]; } }
        if (wr == 0 && fr == 0) {
#pragma unroll
            for (int m = 0; m < 2; ++m)
#pragma unroll
                for (int bj = 0; bj < 2; ++bj)
#pragma unroll
                    for (int n = 0; n < 2; ++n) { const f32x4 v = acc[0][bj][m][n]; v2u w; w.x = pk2(v.x, v.y); w.y = pk2(v.z, v.w); *(v2u*)(EDGE + (size_t)(u.pm * 4 + m) * NUP + bj * DFF + j0 + 4 * n) = w; } }
        if (wr == 1 && fr == 15) {
#pragma unroll
            for (int m = 2; m < 4; ++m)
#pragma unroll
                for (int bj = 0; bj < 2; ++bj)
#pragma unroll
                    for (int n = 0; n < 2; ++n) { const f32x4 v = acc[1][bj][m][n]; v2u w; w.x = pk2(v.x, v.y); w.y = pk2(v.z, v.w); *(v2u*)(EDGE + (size_t)(u.pm * 4 + m) * NUP + bj * DFF + j0 + 4 * n) = w; } }
        asm volatile("s_waitcnt lgkmcnt(0)" ::: "memory"); __builtin_amdgcn_s_barrier(); asm volatile("" ::: "memory");
#pragma unroll
        for (int ai = 0; ai < 2; ++ai) { const int s = 2 * ai + wr; v2u keep[4];
#pragma unroll
            for (int n = 0; n < 2; ++n) { f32x4 cv[2][4];
#pragma unroll
                for (int bj = 0; bj < 2; ++bj) {
                    const f32x4 top = *(const LAS f32x4*)(EX + (((ai == 0 ? 0 : s - 1) * 2 + 1) * 4 + wc) * 64 + (bj * 2 + n) * 16 + fq * 4);
                    const f32x4 bot = *(const LAS f32x4*)(EX + (((ai == 1 ? 3 : s + 1) * 2 + 0) * 4 + wc) * 64 + (bj * 2 + n) * 16 + fq * 4);
                    const f32x4 w0 = *(const LAS f32x4*)(CT + 1 * 256 + bj * 128 + ct0 + 4 * n), w1 = *(const LAS f32x4*)(CT + 2 * 256 + bj * 128 + ct0 + 4 * n), w2 = *(const LAS f32x4*)(CT + 3 * 256 + bj * 128 + ct0 + 4 * n);
                    f32x4 up0, dn3;
#pragma unroll
                    for (int k = 0; k < 4; ++k) { up0[k] = shr1_old(top[k], acc[ai][bj][3][n][k]); dn3[k] = shl1_old(bot[k], acc[ai][bj][0][n][k]); }
#pragma unroll
                    for (int m = 0; m < 4; ++m) { const f32x4 up = (m > 0) ? acc[ai][bj][m - 1][n] : up0, dn = (m < 3) ? acc[ai][bj][m + 1][n] : dn3;
                        cv[bj][m] = w0 * up + w1 * acc[ai][bj][m][n] + w2 * dn; } }
#pragma unroll
                for (int m = 0; m < 4; ++m) { v2u o; o.x = pk2(sg_(cv[1][m].x, cv[0][m].x), sg_(cv[1][m].y, cv[0][m].y)); o.y = pk2(sg_(cv[1][m].z, cv[0][m].z), sg_(cv[1][m].w, cv[0][m].w));
                    if (n == 0) keep[m] = o;
                    else { v4u w4; w4.x = keep[m].x; w4.y = keep[m].y; w4.z = o.x; w4.w = o.y; *(v4u*)(ACT + (size_t)(u.pm * 256 + ai * 128 + trow0 + m) * DFF + j0) = w4; } }
            } }
    }
};

template <int DSH> __device__ __forceinline__ float dpp_up(float v) { return __int_as_float(__builtin_amdgcn_mov_dpp(__float_as_int(v), 0x120 + (16 - DSH), 0xf, 0xf, false)); }
template <int DIR> __device__ __forceinline__ void aff_step(float& P, float& B, const float Ps, const float Bs) {
    if (DIR == 0) { B = Ps * B + Bs; P = P * Ps; } else { B = P * Bs + B; P = P * Ps; }
}
struct FastGates {
    static constexpr bool PERM = false, AFTER_DRAIN = false; GatesEpi e; LAS unsigned char* xl;
    __device__ __forceinline__ void operator()(const f32x4 (&acc)[2][2][4][2], const pg8::Unit& u, int wr, int wc, int fr, int fq) const {
        asm volatile("" : "+v"(fr), "+v"(fq));
        LAS float* PR = (LAS float*)xl;
        const int srow0 = u.pm * 256 + wr * 64 + fr;
        const int trow0 = u.pm * 256 + wr * 64 + 4 * fr;
        const int dir = u.pn >> 1, chb = (u.pn & 1) * 128, cl0 = wc * 32 + 4 * fq, ch0 = chb + cl0, tid = (wr * 4 + wc) * 64 + fq * 16 + fr;
        { const int which = (wr * 4 + wc) >> 1  , c = tid & 127;
          if (which < 3) { const int i = dir * 256 + chb + c; const float v0 = e.ba[i], v1 = e.bi_[i], v2 = e.spl[i] * (-8.0f * 1.4426950408889634f);
              PR[which * 128 + c] = which == 0 ? v0 * -1.4426950408889634f : which == 1 ? v1 * -1.4426950408889634f : v2; } }
        asm volatile("s_waitcnt lgkmcnt(0)" ::: "memory"); __builtin_amdgcn_s_barrier(); asm volatile("" ::: "memory");
#pragma unroll
        for (int ai = 0; ai < 2; ++ai) {
            v2u xr[4][2];
#pragma unroll
            for (int m = 0; m < 4; ++m)
#pragma unroll
                for (int n = 0; n < 2; ++n) xr[m][n] = *(const v2u*)(e.RC + (size_t)(srow0 + ai * 128 + m * 16) * 256 + ch0 + 16 * n);
#pragma unroll
            for (int n = 0; n < 2; ++n) {
                const f32x4 vba = *(const LAS f32x4*)(PR + cl0 + 16 * n), vbi = *(const LAS f32x4*)(PR + 128 + cl0 + 16 * n), vsp = *(const LAS f32x4*)(PR + 256 + cl0 + 16 * n);
                float Pa[4], Ba[4];
#pragma unroll
                for (int m = 0; m < 4; ++m) {
                    const v2u xw = xr[m][n]; const float xf[4] = {bflo(xw.x), bfhi(xw.x), bflo(xw.y), bfhi(xw.y)};
                    const f32x4 ya = acc[ai][0][m][n], yi = acc[ai][1][m][n];
                    v4u pw;
#pragma unroll
                    for (int k = 0; k < 4; ++k) { const float rg = __builtin_amdgcn_rcpf(1.0f + __builtin_amdgcn_exp2f(__builtin_fmaf(ya[k], -1.4426950408889634f, vba[k]))), ig = __builtin_amdgcn_rcpf(1.0f + __builtin_amdgcn_exp2f(__builtin_fmaf(yi[k], -1.4426950408889634f, vbi[k])));
                        const float la2 = bflo(pk2(rg * vsp[k], 0.f));
                        const float P = __builtin_amdgcn_exp2f(la2);
                        const float bb = __builtin_amdgcn_sqrtf(__builtin_fminf(__builtin_fmaxf(1.0f - P * P, 0.f), 1.0f)) * (ig * xf[k]);
                        const unsigned w = pk2(la2, bb); pw[k] = w; const float B = bfhi(w);
                        if (m == 0) { Pa[k] = P; Ba[k] = B; } else if (dir == 0) aff_step<0>(Pa[k], Ba[k], P, B); else aff_step<1>(Pa[k], Ba[k], P, B); }
                    *(v4u*)(e.LAB + ((size_t)dir * M_ALL + trow0 + ai * 128 + m) * 256 + ch0 + 16 * n) = pw;
                }
                if (dir == 0) {
#pragma unroll
                    for (int k = 0; k < 4; ++k) { aff_step<0>(Pa[k], Ba[k], dpp_up<1>(Pa[k]), dpp_up<1>(Ba[k])); aff_step<0>(Pa[k], Ba[k], dpp_up<2>(Pa[k]), dpp_up<2>(Ba[k]));
                        aff_step<0>(Pa[k], Ba[k], dpp_up<4>(Pa[k]), dpp_up<4>(Ba[k])); aff_step<0>(Pa[k], Ba[k], dpp_up<8>(Pa[k]), dpp_up<8>(Ba[k])); }
                } else {
#pragma unroll
                    for (int k = 0; k < 4; ++k) { aff_step<1>(Pa[k], Ba[k], dpp_up<1>(Pa[k]), dpp_up<1>(Ba[k])); aff_step<1>(Pa[k], Ba[k], dpp_up<2>(Pa[k]), dpp_up<2>(Ba[k]));
                        aff_step<1>(Pa[k], Ba[k], dpp_up<4>(Pa[k]), dpp_up<4>(Ba[k])); aff_step<1>(Pa[k], Ba[k], dpp_up<8>(Pa[k]), dpp_up<8>(Ba[k])); }
                }
                if (fr == 0) { const int s = 2 * ai + wr; int b, c; if (u.pm < 128) { b = u.pm >> 4; c = 4 + (u.pm & 15) * 4 + s; } else { b = u.pm - 128; c = s; }
                    const size_t o = ((size_t)(dir * NB + b) * NCHUNK + c) * 256 + ch0 + 16 * n;
                    *(f32x4*)(e.AGP + o) = (f32x4){Pa[0], Pa[1], Pa[2], Pa[3]}; *(f32x4*)(e.AGB + o) = (f32x4){Ba[0], Ba[1], Ba[2], Ba[3]}; }
                asm volatile("" ::: "memory"); __builtin_amdgcn_sched_barrier(0);
            }
        }
    }
};

struct GenOrder {
    pg8::StaticOrder map; int b1, s1, n1, b2, s2, n2;
    __device__ __forceinline__ void strided(int M, int N, int first, int stride) { map.init(M, N, 1, 0); b1 = first; s1 = stride; n1 = 1 << 20; b2 = 0; s2 = 0; n2 = 0; }
    __device__ __forceinline__ bool next(int i, pg8::Unit& u) const { int L; if (i < n1) L = b1 + i * s1; else if (i < n1 + n2) L = b2 + (i - n1) * s2; else return false; return map.next(L, u); }
    __device__ __forceinline__ void a_ready(const pg8::Unit&) const {}
    __device__ __forceinline__ void done(const pg8::Unit&) const {}
};
__device__ __forceinline__ void gemm_proj(const Ctx& C, const bf16* A, const bf16* Bt, int Mrows, int N, int K, const GenOrder& S, const ProjEpi& E) {
    pg8::Gemm g{A, Bt, Mrows, N, K}; FastProj F{E, C.lds + EXCH_OFF};
    pg8::gemm_phase<FastProj, GenOrder, true, true>(C.lds, g, S, F, C.tid);
}
template <bool XIN_F32> __device__ __forceinline__ void gemm_res(const Ctx& C, const bf16* A, const bf16* Bt, int Mrows, int K, const GenOrder& S, const ResEpi& E) {
    pg8::Gemm g{A, Bt, Mrows, DM, K}; FastRes<XIN_F32> F{E};
    pg8::gemm_phase<FastRes<XIN_F32>, GenOrder, true, true>(C.lds, g, S, F, C.tid);
}
__device__ __forceinline__ void gemm_res_final(const Ctx& C, const bf16* A, const bf16* Bt, int Mrows, int K, const GenOrder& S, const ResEpi& E) {
    pg8::Gemm g{A, Bt, Mrows, DM, K}; FastResFinal F{E, C.g_final, C.out, (float*)(C.ws + WS_AGP), (unsigned*)(C.ws + WS_CTL), C.lds + EXCH_OFF};
    pg8::gemm_phase<FastResFinal, GenOrder, true, true>(C.lds, g, S, F, C.tid);
}
__device__ __forceinline__ void gemm_gates(const Ctx& C, const bf16* A, const bf16* Bt, const GatesEpi& E) {
    pg8::Gemm g{A, Bt, M_ALL, 1024, 256, 128}; GenOrder S; S.strided(M_ALL, 1024, (int)blockIdx.x, C.G); FastGates F{E, C.lds + EXCH_OFF};
    pg8::gemm_phase<FastGates, GenOrder, true, true>(C.lds, g, S, F, C.tid);
}
__device__ __forceinline__ void gemm_upconv(const Ctx& C, int l, int Mrows) {
    pg8::Gemm g{(const bf16*)(C.ws + WS_AP), (const bf16*)(C.ws + WS_WUP + l * SZ_WUP), Mrows, NUP, DM}; GenOrder S; S.strided(Mrows, NUP, (int)blockIdx.x, C.G);
    FastUpConv F{(bf16*)(C.ws + WS_ACT), (bf16*)(C.ws + WS_EDGE), (const float*)(C.ws + WS_STB), (const float*)(C.ws + WS_BUP) + (size_t)l * 9 * NUP, C.ffn_conv_w + (size_t)l * 3 * NUP, C.lds + EXCH_OFF};
    pg8::gemm_phase<FastUpConv, GenOrder, true, true>(C.lds, g, S, F, C.tid);
}


typedef GAS unsigned gu32;
#define RLX_AGENT __ATOMIC_RELAXED, __HIP_MEMORY_SCOPE_AGENT
#define XB_TMO      128
#define XB_XCNT(j)  (256  + 64 * (j))
#define XB_XSUB(j)  (1280 + 64 * (j))
#define XB_XGEN(j)  (2304 + 64 * (j))
#define XB_TOP      3328
#define XB_TOPGEN   3392
#define XCD_BAR_WORDS 3456
#define XB_SPIN_CAP (1u << 18)

__device__ __forceinline__ unsigned xb_ld(unsigned* p)              { return __hip_atomic_load(p, __ATOMIC_RELAXED, __HIP_MEMORY_SCOPE_AGENT); }
__device__ __forceinline__ unsigned xb_add(unsigned* p, unsigned v) { return __hip_atomic_fetch_add(p, v, __ATOMIC_RELAXED, __HIP_MEMORY_SCOPE_AGENT); }
__device__ __forceinline__ unsigned xb_xcc_id() { return (unsigned)__builtin_amdgcn_s_getreg((3 << 11) | 20) & 0xFu; }
#define XB_SPIN(cond, bar) do { unsigned _sp = 0; while (cond) { __builtin_amdgcn_s_sleep(1); \
    if ((++_sp & 255u) == 0u) { if (xb_ld(&(bar)[XB_TMO])) break; if (_sp > XB_SPIN_CAP) { atomicAdd(&(bar)[XB_TMO], 1u); break; } } } } while (0)

struct XcdBarrier {
    int wave;
    unsigned* bar; unsigned x;
    volatile LAS unsigned* st;
};

__device__ __forceinline__ bool xb_leader(int wave) { return wave == 0 && __builtin_amdgcn_mbcnt_hi(~0u, __builtin_amdgcn_mbcnt_lo(~0u, 0u)) == 0u; }
__device__ __forceinline__ XcdBarrier xcd_barrier_post(unsigned* bar, volatile LAS unsigned* st, int wave) {
    XcdBarrier b; b.wave = wave; b.bar = bar; b.x = xb_xcc_id(); b.st = st;
    if (xb_leader(wave)) (void)xb_add(&bar[XB_XCNT(b.x)], 1u);
    return b;
}
__device__ __forceinline__ void xcd_barrier_complete(unsigned* bar, unsigned x, unsigned& nloc, unsigned& nx) {
    const unsigned G = gridDim.x * gridDim.y * gridDim.z;
    unsigned sum, cnt, mine, sp = 0u;
    for (;;) {
        sum = 0u; cnt = 0u; mine = 0u;
#pragma unroll
        for (unsigned j = 0; j < 16; ++j) { const unsigned c = xb_ld(&bar[XB_XCNT(j)]); sum += c; cnt += (c > 0u) ? 1u : 0u; mine = (j == x) ? c : mine; }
        if (sum == G) break;
        __builtin_amdgcn_s_sleep(1);
        if ((++sp & 255u) == 0u) { if (xb_ld(&bar[XB_TMO])) break; if (sp > XB_SPIN_CAP) { atomicAdd(&bar[XB_TMO], 1u); break; } }
    }
    nloc = mine > 0u ? mine : 1u; nx = cnt > 0u ? cnt : 1u;
}

__device__ __forceinline__ void xcd_barrier(const XcdBarrier& b) {
    asm volatile("s_waitcnt vmcnt(0)" ::: "memory");
    __syncthreads();
    if (xb_leader(b.wave)) {
        unsigned* bar = b.bar;
        __builtin_amdgcn_s_waitcnt(0);
        unsigned nloc = b.st[0], nx = b.st[1];
        if (nloc == 0u) { xcd_barrier_complete(bar, b.x, nloc, nx); b.st[0] = nloc; b.st[1] = nx; }
        const unsigned old = xb_add(&bar[XB_XSUB(b.x)], 1u);
        const unsigned gen = old / nloc;
        if (old + 1u == (gen + 1u) * nloc) {
            __builtin_amdgcn_fence(__ATOMIC_RELEASE, "agent");
            asm volatile("s_waitcnt vmcnt(0)" ::: "memory");
            const unsigned og = xb_add(&bar[XB_TOP], 1u);
            const unsigned tg = og / nx;
            if (og + 1u == (tg + 1u) * nx) xb_add(&bar[XB_TOPGEN], 1u);
            else XB_SPIN(xb_ld(&bar[XB_TOPGEN]) == tg, bar);
            __builtin_amdgcn_fence(__ATOMIC_ACQUIRE, "agent");
            xb_add(&bar[XB_XGEN(b.x)], 1u);
            asm volatile("s_waitcnt vmcnt(0)" ::: "memory");
        } else {
            XB_SPIN(xb_ld(&bar[XB_XGEN(b.x)]) == gen, bar);
            __builtin_amdgcn_fence(__ATOMIC_ACQUIRE, "agent");
            asm volatile("s_waitcnt vmcnt(0)" ::: "memory");
        }
    }
    __syncthreads();
}

constexpr int CW_GSYNC = 3840;
__device__ __forceinline__ void grid_arrive(unsigned* word, int wave) {
    asm volatile("s_waitcnt vmcnt(0)" ::: "memory"); __syncthreads();
    if (xb_leader(wave)) { __builtin_amdgcn_fence(__ATOMIC_RELEASE, "agent"); asm volatile("s_waitcnt vmcnt(0)" ::: "memory"); (void)xb_add(word, 1u); }
}
__device__ __forceinline__ void grid_wait(unsigned* word, unsigned target, int wave) {
    if (xb_leader(wave)) { unsigned sp = 0; while (xb_ld(word) < target) { __builtin_amdgcn_s_sleep(2); if (++sp > (1u << 22)) break; }
        __builtin_amdgcn_fence(__ATOMIC_ACQUIRE, "agent"); asm volatile("s_waitcnt vmcnt(0)" ::: "memory"); }
    __syncthreads();
}

constexpr int PH_PER_LAYER = 7, PH_FINAL = 2 + DEPTH * PH_PER_LAYER, N_PHASES = PH_FINAL + 1;
__global__ void __launch_bounds__(NTHREADS, 2) fwd_kernel(Args args) {
    extern __shared__ __attribute__((aligned(16))) unsigned char lds_raw[];
    Ctx C;
    C.lds = (LAS unsigned char*)lds_raw; C.lds_gen = (char*)lds_raw; C.wave = __builtin_amdgcn_readfirstlane((int)threadIdx.x >> 6); C.lane = (int)__builtin_amdgcn_mbcnt_hi(~0u, __builtin_amdgcn_mbcnt_lo(~0u, 0u)); C.tid = C.wave * 64 + C.lane;
    C.G = gridDim.x; { const int bx = blockIdx.x; C.vcu = (C.G % 8 == 0) ? (bx % 8) * (C.G / 8) + bx / 8 : bx; }
    C.gw = C.vcu * NWAVES + C.wave; C.NGW = C.G * NWAVES;
    const int lo = args.ph_lo, hi = args.ph_hi;
    for (int u = C.tid; u < (LDS_BYTES - LDSCTL_OFF) / 4; u += NTHREADS) ((LAS unsigned*)(C.lds + LDSCTL_OFF))[u] = 0u;
    __syncthreads();
    XcdBarrier bar; bar.wave = C.wave; bar.bar = (unsigned*)(args.ws + WS_CTL) + CW_BAR; bar.x = 0; bar.st = nullptr;
    if (hi - lo > 1) bar = xcd_barrier_post((unsigned*)(args.ws + WS_CTL) + CW_BAR, (volatile LAS unsigned*)(C.lds + MISC_OFF) + 8, C.wave);
#define IN(k) (lo <= (k) && (k) < hi)
#define PCTX Ctx L = C; asm volatile("v_mbcnt_lo_u32_b32 %0, -1, 0\n\tv_mbcnt_hi_u32_b32 %0, -1, %0" : "=v"(L.lane)); L.tid = L.wave * 64 + L.lane; asm volatile("" : "+s"(L.vcu), "+s"(L.gw)); { const __attribute__((address_space(4))) Args* ka_ = (const __attribute__((address_space(4))) Args*)__builtin_amdgcn_kernarg_segment_ptr(); asm volatile("" : "+s"(ka_)); L.x = (const float*)ka_->in[0]; L.c = (const float*)ka_->in[1]; L.ctx = (const float*)ka_->in[2]; L.c_ctx = (const float*)ka_->in[3]; L.w_mod = (const float*)ka_->in[4]; L.b_mod = (const float*)ka_->in[5]; L.g_mix = (const float*)ka_->in[6]; L.g_ffn = (const float*)ka_->in[7]; L.w_in = (const float*)ka_->in[8]; L.g_q = (const float*)ka_->in[9]; L.g_k = (const float*)ka_->in[10]; L.lru_conv_w = (const float*)ka_->in[11]; L.lru_conv_b = (const float*)ka_->in[12]; L.lru_wa = (const float*)ka_->in[13]; L.lru_ba = (const float*)ka_->in[14]; L.lru_wi = (const float*)ka_->in[15]; L.lru_bi = (const float*)ka_->in[16]; L.lru_lam = (const float*)ka_->in[17]; L.sc_conv_w = (const float*)ka_->in[18]; L.w_out = (const float*)ka_->in[19]; L.w_up = (const float*)ka_->in[20]; L.ffn_conv_w = (const float*)ka_->in[21]; L.w_down = (const float*)ka_->in[22]; L.g_final = (const float*)ka_->in[23]; L.out = ka_->out; { GAS unsigned char* wsg_ = (GAS unsigned char*)ka_->ws; asm volatile("" : "+s"(wsg_)); L.ws = (unsigned char*)wsg_; } }
#define SEAM(k) do { if (IN(k) && IN((k) + 1)) { xcd_barrier(bar); } } while (0)
    if (IN(0)) REP(0) { PCTX; phase_p0a(L); } SEAM(0);
    if (IN(1)) REP(1) { PCTX; phase_p0b(L); } SEAM(1);
    for (int l = 0; l < DEPTH; ++l) {
        const int P = 2 + l * PH_PER_LAYER;
        const int Mff = (l == 0) ? M_ALL : M_LAT;
        if (IN(P + 0)) REP(2) {
            PCTX; int bx = (int)blockIdx.x; asm volatile("" : "+s"(bx));
            if (l == 0) {
                ProjEpi E{(bf16*)(L.ws + WS_PROJ), NPROJ, (const float*)(L.ws + WS_STA), (const float*)(L.ws + WS_BIN), NPROJ, 0, 0, (bf16*)(L.ws + WS_MIX), (bf16*)(L.ws + WS_KB), (bf16*)(L.ws + WS_VB), (const float*)(L.ws + WS_ROPE), L.g_q + (0) * 64, L.g_k + (0) * 64};
                GenOrder S; S.strided(M_ALL, NPROJ, bx, L.G);
                gemm_proj(L, (const bf16*)(L.ws + WS_AP), (const bf16*)(L.ws + WS_WIN), M_ALL, NPROJ, DM, S, E);
                { const int rem = (L.G == 256) ? ((M_ALL / 256) * (NPROJ / 256)) & 255 : 0; if (bx >= rem) { __syncthreads(); deferred_work(L, 0, bx - rem, L.G - rem); } }
            } else {
                { const float* mod = (const float*)(L.ws + WS_MOD) + (size_t)(l - 1) * 9 * 6144;
                  ResEpi E{L.x, L.ctx, (bf16*)(L.ws + WS_XR), mod + 5 * 1024, L.g_mix + l * DM, mod + 9 * 6144 + 1 * 1024, (bf16*)(L.ws + WS_AP), (float*)(L.ws + WS_STA), true, M_LAT / 256, false};
                  GenOrder S; S.strided(M_CTX, DM, bx, L.G);
                  { pg8::Unit fu; int prev = -1; for (int i = 0; S.next(i, fu); ++i) { if (fu.pm != prev) ffn_fix_panel(L, l - 1, M_LAT / 256 + fu.pm); prev = fu.pm; } asm volatile("s_waitcnt vmcnt(0)" ::: "memory"); __syncthreads(); }
                  gemm_res<false>(L, (const bf16*)(L.ws + WS_ACT) + (size_t)M_LAT * DFF, (const bf16*)(L.ws + WS_WDN + (l - 1) * SZ_WDN), M_CTX, DFF, S, E); }
                { ProjEpi E{(bf16*)(L.ws + WS_PROJ), NPROJ, (const float*)(L.ws + WS_STA), (const float*)(L.ws + WS_BIN) + (size_t)l * 9 * NPROJ, NPROJ, 0, 0, (bf16*)(L.ws + WS_MIX), (bf16*)(L.ws + WS_KB), (bf16*)(L.ws + WS_VB), (const float*)(L.ws + WS_ROPE), L.g_q + (l) * 64, L.g_k + (l) * 64};
                  GenOrder S; S.strided(M_LAT, NPROJ, bx, L.G);
                  if (L.G == 256) {
                      if (bx < 32) { S.b1 = 896 + bx; S.s1 = 32; S.n1 = 2; }
                      else { const int j = bx - 32; S.b1 = j; S.s1 = 224; S.n1 = 4; S.b2 = 960 + j; S.s2 = 0; S.n2 = j < 64 ? 1 : 0; } }
                  gemm_proj(L, (const bf16*)(L.ws + WS_AP), (const bf16*)(L.ws + WS_WIN + l * SZ_WIN), M_LAT, NPROJ, DM, S, E); }
            }
        } SEAM(P + 0);
        if (IN(P + 1)) {
            if ((PROBE_REP_MASK >> 3) & 1) { PCTX; if (l == 0) phase_post(L, l, 0, M_ALL, 12, L.gw, L.NGW); }
            PCTX;
            if (l == 0) phase_post(L, l, 0, M_ALL, 12, L.gw, L.NGW);
            else {
                const int gs = L.G >> 3; const bool split = gs >= 2; int q = 0, below = 0, role = 0;
#pragma unroll
                for (int p = 0; p < 8; ++p) { if (L.vcu == p * gs) { role = 1; q = p; } if (split && L.vcu == p * gs + 1) { role = 2; q = p; } if (p * gs < L.vcu) ++below; if (split && p * gs + 1 < L.vcu) ++below; }
                if (role != 0) {
                    const int r0 = M_LAT + 256 * q, c0 = (role == 2 || !split) ? 512 : 768, ncol = split ? 256 : 512;
                    ProjEpi E{(bf16*)(L.ws + WS_PROJ), NPROJ, (const float*)(L.ws + WS_STA), (const float*)(L.ws + WS_BIN) + (size_t)l * 9 * NPROJ + c0, NPROJ, r0, c0 >> 8, (bf16*)(L.ws + WS_MIX), (bf16*)(L.ws + WS_KB), (bf16*)(L.ws + WS_VB), (const float*)(L.ws + WS_ROPE), L.g_q + l * 64, L.g_k + l * 64};
                    GenOrder S; S.strided(256, ncol, 0, 1);
                    gemm_proj(L, (const bf16*)(L.ws + WS_AP) + (size_t)r0 * DM, (const bf16*)(L.ws + WS_WIN + l * SZ_WIN) + (size_t)c0 * DM, 256, ncol, DM, S, E);
                    if (role == 1) { asm volatile("s_waitcnt vmcnt(0)" ::: "memory"); __syncthreads(); phase_post(L, l, r0, r0 + 256, 4, L.wave, NWAVES); }
                } else {
                    const int j = L.vcu - below, nl = L.G - (split ? 16 : 8);
                    phase_post(L, l, 0, M_LAT, 12, j * NWAVES + L.wave, nl * NWAVES);
                }
            }
        } SEAM(P + 1);
        const bool fuse23 = IN(P + 2) && IN(P + 3);
        if (IN(P + 2)) REP(4) {
            PCTX;
            GatesEpi E{(const bf16*)(L.ws + WS_RC), L.lru_ba + l * 512, L.lru_bi + l * 512, (const float*)(L.ws + WS_SPL) + l * 512, (unsigned*)(L.ws + WS_LA), (float*)(L.ws + WS_AGP), (float*)(L.ws + WS_AGB)};
            gemm_gates(L, (const bf16*)(L.ws + WS_RC), (const bf16*)(L.ws + WS_GW + l * SZ_GW), E);
            if (l == 0) { const int bx = (int)blockIdx.x, rem = (L.G == 256) ? ((M_ALL / 256) * 4) & 255 : 0; if (bx >= rem) { __syncthreads(); deferred_work(L, 1, bx - rem, L.G - rem); } }
            if (fuse23) grid_arrive((unsigned*)(L.ws + WS_CTL) + CW_GSYNC + 64 * l, L.wave);
        } if (!fuse23) SEAM(P + 2);
        if (IN(P + 3)) { { PCTX;
            REP(6) phase_attn_fast(L, l, rep_ == 0 && ((PROBE_REP_MASK >> 6) & 1));
            } REP(7) { PCTX; if (fuse23) grid_wait((unsigned*)(L.ws + WS_CTL) + CW_GSYNC + 64 * l, (unsigned)L.G, L.wave); phase_scan2(L, l); } } SEAM(P + 3);
        if (IN(P + 4)) for (int rep_ = 0; rep_ < ((((PROBE_REP_MASK) >> 8) & 1) && l == 0 ? 2 : 1); ++rep_) {
            PCTX; const float* mod = (const float*)(L.ws + WS_MOD) + (size_t)l * 9 * 6144;
            ResEpi E{L.x, L.ctx, (bf16*)(L.ws + WS_XR), mod + 2 * 1024, L.g_ffn + l * DM, mod + 4 * 1024, (bf16*)(L.ws + WS_AP), (float*)(L.ws + WS_STB), true, 0, true};
            GenOrder S; S.strided(Mff, DM, (int)blockIdx.x, L.G);
            if (l == 0) gemm_res<true>(L, (const bf16*)(L.ws + WS_MIX), (const bf16*)(L.ws + WS_WOUT + l * SZ_WOUT), Mff, DM, S, E);
            else gemm_res<false>(L, (const bf16*)(L.ws + WS_MIX), (const bf16*)(L.ws + WS_WOUT + l * SZ_WOUT), Mff, DM, S, E);
            if (l == 0) { const int bx = (int)blockIdx.x, rem = (L.G == 256) ? ((M_ALL / 256) * 4) & 255 : 0; if (bx >= rem) { __syncthreads(); deferred_work(L, 2, bx - rem, L.G - rem); } }
        } SEAM(P + 4);
        if (IN(P + 5)) REP(9) { PCTX; gemm_upconv(L, l, Mff); } SEAM(P + 5);
        if (IN(P + 6)) {
            PCTX; const float* mod = (const float*)(L.ws + WS_MOD) + (size_t)l * 9 * 6144;
            const bool last = (l == DEPTH - 1);
            ResEpi E{L.x, L.ctx, (bf16*)(L.ws + WS_XR), mod + 5 * 1024, last ? L.g_final : L.g_mix + (l + 1) * DM, last ? mod : mod + 9 * 6144 + 1 * 1024, (bf16*)(L.ws + WS_AP), (float*)(L.ws + WS_STA), !last, 0, false};
            GenOrder S; S.strided(M_LAT, DM, (int)blockIdx.x, L.G);
            { pg8::Unit fu; int prev = -1; for (int i = 0; S.next(i, fu); ++i) { if (fu.pm != prev) ffn_fix_panel(L, l, fu.pm); prev = fu.pm; } asm volatile("s_waitcnt vmcnt(0)" ::: "memory"); __syncthreads(); }
            if (last && L.G == 256) gemm_res_final(L, (const bf16*)(L.ws + WS_ACT), (const bf16*)(L.ws + WS_WDN + l * SZ_WDN), M_LAT, DFF, S, E);
            else gemm_res<false>(L, (const bf16*)(L.ws + WS_ACT), (const bf16*)(L.ws + WS_WDN + l * SZ_WDN), M_LAT, DFF, S, E);
        } if (!(l == DEPTH - 1 && C.G == 256)) SEAM(P + 6);
    }
    if (IN(PH_FINAL) && C.G != 256) { PCTX; phase_final(L); }
#undef IN
#undef SEAM
}

extern "C" void kernel_launch(void* const* d_in, const int* in_sizes, int n_in, void* d_out, int out_size, void* d_ws, size_t ws_size, hipStream_t stream) {
    static int grid = 0;
    if (grid == 0) {
        if (n_in != 24 || out_size != M_LAT * DM || ws_size < WS_END) { fprintf(stderr, "kernel_launch: unexpected problem (n_in %d, out %d, ws %zu)\n", n_in, out_size, ws_size); grid = -1; return; }
        int dev = 0, cus = 0, per_cu = 0;
        if (hipGetDevice(&dev) != hipSuccess || hipDeviceGetAttribute(&cus, hipDeviceAttributeMultiprocessorCount, dev) != hipSuccess) { grid = -1; return; }
        if (hipFuncSetAttribute((const void*)fwd_kernel, hipFuncAttributeMaxDynamicSharedMemorySize, LDS_BYTES) != hipSuccess) { fprintf(stderr, "kernel_launch: hipFuncSetAttribute failed\n"); grid = -1; return; }
        if (hipOccupancyMaxActiveBlocksPerMultiprocessor(&per_cu, (const void*)fwd_kernel, NTHREADS, LDS_BYTES) != hipSuccess || per_cu < 1) { fprintf(stderr, "kernel_launch: occupancy query says %d blocks per CU\n", per_cu); }
        (void)hipGetLastError();
        grid = cus;
    }
    if (grid < 0) return;
    (void)hipMemsetAsync((char*)d_ws + WS_CTL, 0, CTL_ZERO_BYTES, stream);
    Args a{};
    for (int i = 0; i < 24; ++i) a.in[i] = d_in[i];
    a.out = (float*)d_out; a.ws = (unsigned char*)d_ws;
#if MK_N_LAUNCHES == 1
    a.ph_lo = 0; a.ph_hi = N_PHASES;
    void* kargs[] = {&a};
    hipError_t e = hipLaunchCooperativeKernel((const void*)fwd_kernel, dim3(grid), dim3(NTHREADS), kargs, LDS_BYTES, stream);
    if (e != hipSuccess) fprintf(stderr, "kernel_launch: cooperative launch failed: %s (grid %d)\n", hipGetErrorString(e), grid);
#else
    for (int p = 0; p < N_PHASES; ++p) {
        a.ph_lo = p; a.ph_hi = p + 1;
        hipLaunchKernelGGL(fwd_kernel, dim3(grid), dim3(NTHREADS), LDS_BYTES, stream, a);
    }
#endif
}
```

```cpp
#include <hip/hip_runtime.h>
#include <cstdio>
#include <cstdint>
#include <cmath>
#include <hip/hip_bf16.h>

#ifndef MK_N_LAUNCHES
#define MK_N_LAUNCHES 1
#endif
#ifndef PROBE_REP_MASK
#define PROBE_REP_MASK 0
#endif
#define REP(kind) for (int rep_ = 0; rep_ < (((PROBE_REP_MASK) >> (kind)) & 1) + 1; ++rep_)

#define LAS __attribute__((address_space(3)))
#define GAS __attribute__((address_space(1)))
typedef unsigned short bf16;
typedef unsigned v4u __attribute__((ext_vector_type(4)));
typedef unsigned v2u __attribute__((ext_vector_type(2)));
typedef float f32x4 __attribute__((ext_vector_type(4)));
typedef float f32x2 __attribute__((ext_vector_type(2)));

constexpr int NB = 8, SEQ = 4096, CTXL = 256, DM = 1024, DEPTH = 2;
constexpr int M_LAT = NB * SEQ, M_CTX = NB * CTXL, M_ALL = M_LAT + M_CTX;
constexpr int NPROJ = 2048, DFF = 2816, NUP = 2 * DFF, KVROWS = SEQ + CTXL, KVP = 128;
constexpr int NCHUNK = 68;
constexpr float EPS = 1e-6f;
constexpr float C2 = 0.125f * 1.4426950408889634f;
constexpr int NWAVES = 8, NTHREADS = 512;

constexpr size_t MiB = 1u << 20;
constexpr size_t WS_CTL = 0, CTL_ZERO_BYTES = 1 * MiB;
constexpr size_t WS_WIN = 1 * MiB, WS_WOUT = 9 * MiB, WS_WUP = 13 * MiB, WS_WDN = 35 * MiB, WS_GW = 46 * MiB;
constexpr size_t SZ_WIN = 4 * MiB, SZ_WOUT = 2 * MiB, SZ_WUP = 11 * MiB, SZ_WDN = 11 * MiB / 2, SZ_GW = MiB / 2;
constexpr size_t WS_MOD = 47 * MiB, WS_BIN = 47 * MiB + 512 * 1024, WS_BUP = 48 * MiB, WS_ROPE = 48 * MiB + 512 * 1024, WS_SPL = WS_ROPE + 16384;
constexpr size_t WS_STA = 49 * MiB, WS_STB = 51 * MiB + 512 * 1024, WS_AGP = 54 * MiB, WS_AGB = 55 * MiB + 512 * 1024;
constexpr size_t WS_XC = 57 * MiB, WS_AP = 65 * MiB, WS_BIG = 133 * MiB;
constexpr size_t WS_PROJ = WS_BIG, WS_MIX = WS_BIG + 136 * MiB, WS_KB = WS_MIX + 68 * MiB, WS_VB = WS_KB + 17 * MiB / 2, WS_RC = WS_VB + 17 * MiB / 2;
constexpr size_t WS_LA = WS_RC + 17 * MiB, WS_XR = WS_LA + 68 * MiB, WS_END1 = WS_XR + 68 * MiB;
constexpr size_t WS_ACT = WS_BIG, WS_EDGE = WS_BIG + 187 * MiB, WS_END2 = WS_EDGE + 8 * MiB;
constexpr size_t WS_END = 512 * MiB;
static_assert(WS_END1 <= WS_END && WS_END2 <= WS_XR, "d_ws map");
static_assert((size_t)M_ALL * NPROJ * 2 == 136 * MiB && (size_t)M_ALL * DM * 2 == 68 * MiB && (size_t)M_ALL * 256 * 2 == 17 * MiB && (size_t)M_ALL * DFF * 2 == 187 * MiB, "sizes");
static_assert((size_t)136 * 4 * NUP * 2 <= 8 * MiB && (size_t)NB * KVROWS * KVP * 2 * 2 == 17 * MiB && (size_t)M_ALL * 256 * 4 * 2 == 68 * MiB, "sizes2");
constexpr int CW_BAR = 4096;

constexpr int RING_BYTES = 131072, LDSCTL_OFF = RING_BYTES, MISC_OFF = LDSCTL_OFF + 320, EXCH_OFF = RING_BYTES + 1024  , LDS_BYTES = 147456;

__device__ __forceinline__ float bflo(unsigned w) { return __uint_as_float(w << 16); }
__device__ __forceinline__ float bfhi(unsigned w) { return __uint_as_float(w & 0xffff0000u); }
__device__ __forceinline__ float bf1(bf16 h) { return __uint_as_float((unsigned)h << 16); }
__device__ __forceinline__ unsigned pk2(float lo, float hi) { unsigned r; asm volatile("v_cvt_pk_bf16_f32 %0, %1, %2" : "=v"(r) : "v"(lo), "v"(hi)); return r; }
__device__ __forceinline__ void unpack8(const v4u w, float (&x)[8]) {
    x[0] = bflo(w.x); x[1] = bfhi(w.x); x[2] = bflo(w.y); x[3] = bfhi(w.y); x[4] = bflo(w.z); x[5] = bfhi(w.z); x[6] = bflo(w.w); x[7] = bfhi(w.w);
}
__device__ __forceinline__ v4u pack8(const float (&x)[8]) { v4u w; w.x = pk2(x[0], x[1]); w.y = pk2(x[2], x[3]); w.z = pk2(x[4], x[5]); w.w = pk2(x[6], x[7]); return w; }
__device__ __forceinline__ float shx(float v, int mask, int lane) { return __int_as_float(__builtin_amdgcn_ds_bpermute((lane ^ mask) << 2, __float_as_int(v))); }
__device__ __forceinline__ float wave_sum(float v, int lane) {
#pragma unroll
    for (int o = 1; o < 64; o <<= 1) v += shx(v, o, lane);
    return v;
}
__device__ __forceinline__ float sigmoidf_(float x) { return __builtin_amdgcn_rcpf(1.0f + __expf(-x)); }
__device__ __forceinline__ float silu_(float x) { return x * __builtin_amdgcn_rcpf(1.0f + __expf(-x)); }
__device__ __forceinline__ float one_minus_exp_(float x) {
    const float s = -x * (1.0f + x * (0.5f + x * (1.0f / 6.0f + x * (1.0f / 24.0f + x * (1.0f / 120.0f + x * (1.0f / 720.0f + x * (1.0f / 5040.0f)))))));
    return x > -0.25f ? s : 1.0f - __expf(x);
}
__device__ __forceinline__ float gelu_tanh_(float x) {
    const float K = -2.3022081983f; const float p = __builtin_fmaf(x * x, 0.044715f * K, K);
    return x * __builtin_amdgcn_rcpf(1.0f + __builtin_amdgcn_exp2f(p * x));
}
__device__ __forceinline__ int row_bi(int m) { return m < M_LAT ? (m >> 12) : 8; }

struct Args { const void* in[24]; float* out; unsigned char* ws; int ph_lo, ph_hi; };
struct Ctx {
    LAS unsigned char* lds; char* lds_gen; int tid, lane, wave, vcu, G, gw, NGW;
    const float *x, *c, *ctx, *c_ctx, *w_mod, *b_mod, *g_mix, *g_ffn, *w_in, *g_q, *g_k, *lru_conv_w, *lru_conv_b, *lru_wa, *lru_ba, *lru_wi, *lru_bi, *lru_lam, *sc_conv_w, *w_out, *w_up, *ffn_conv_w, *w_down, *g_final;
    float* out; unsigned char* ws;
};
#define WSP(T, off) ((T*)(C.ws + (off)))

struct ProjEpi {
    bf16* Cout; int ldc; const float* stats; const float* bias; int ldb; int row_off;
    int tile0; bf16 *MIX, *KB, *VB; const float *ropeT, *gq, *gk;
};
struct ResEpi {
    const float *xi_lat, *xi_ctx; bf16* XR; const float* gate; const float* gn; const float* cn; bf16* AP; float* stats; bool has_ap; int pm_off; bool ap_perm;
    __device__ __forceinline__ const float* xi_row(int grow) const { return grow < M_LAT ? xi_lat + (size_t)grow * DM : xi_ctx + (size_t)(grow - M_LAT) * DM; }
};
struct GatesEpi {
    const bf16* RC; const float *ba, *bi_, *spl; unsigned* LAB; float *AGP, *AGB;
};

__host__ __device__ __forceinline__ int qk_pos(int n) { if (n >= 640) return n; const int d = n & 63; return (n & ~63) + 2 * (d & 31) + (d >> 5); }
__device__ __forceinline__ void transpose_item(const float* W, int K, int N, bf16* WT, LAS float* scr, int item, int lane, bool upperm = false, bool qkperm = false) {
    const int nblk = N / 32, kb = item / nblk, nb = item % nblk, k0 = 64 * kb, n0 = 32 * nb;
    int d0 = n0; if (upperm) { const int half = n0 / DFF, j = n0 - half * DFF; d0 = (j >> 7) * 256 + half * 128 + (j & 127); }
    { f32x4 v[8];
#pragma unroll
      for (int i = 0; i < 8; ++i) v[i] = *(const f32x4*)(W + (size_t)(k0 + 8 * i + (lane >> 3)) * N + n0 + 4 * (lane & 7));
#pragma unroll
      for (int i = 0; i < 8; ++i) { LAS float* d = scr + (8 * i + (lane >> 3)) * 33 + 4 * (lane & 7); d[0] = v[i].x; d[1] = v[i].y; d[2] = v[i].z; d[3] = v[i].w; } }
    asm volatile("s_waitcnt lgkmcnt(0)" ::: "memory");
    const int c = lane & 7;
#pragma unroll
    for (int j = 0; j < 4; ++j) { const int n = (lane >> 3) + 8 * j; const LAS float* s = scr + (8 * c) * 33 + n;
        v4u o; o.x = pk2(s[0 * 33], s[1 * 33]); o.y = pk2(s[2 * 33], s[3 * 33]); o.z = pk2(s[4 * 33], s[5 * 33]); o.w = pk2(s[6 * 33], s[7 * 33]);
        *(v4u*)(WT + (size_t)(qkperm ? qk_pos(n0 + n) : d0 + n) * K + k0 + 8 * c) = o; }
    asm volatile("s_waitcnt lgkmcnt(0)" ::: "memory");
}
__device__ __forceinline__ void gemv9_item(const Ctx& C, LAS float* vec, LAS float* red, const float* W, int ldw, int n0, const float* bias, float* out, int ostride, bool qkperm = false) {
    float acc[9];
#pragma unroll
    for (int b = 0; b < 9; ++b) acc[b] = 0.f;
    const int k0 = C.wave * 128; const float* wp = W + (size_t)k0 * ldw + n0 + C.lane;
#pragma unroll 1
    for (int kk = 0; kk < 128; kk += 16) {
        float w[16];
#pragma unroll
        for (int j = 0; j < 16; ++j) w[j] = wp[(size_t)(kk + j) * ldw];
#pragma unroll
        for (int j = 0; j < 16; j += 4)
#pragma unroll
            for (int b = 0; b < 9; ++b) { const f32x4 v = *(const LAS f32x4*)(vec + b * 1024 + k0 + kk + j); acc[b] += (v.x * w[j] + v.y * w[j + 1]) + (v.z * w[j + 2] + v.w * w[j + 3]); }
    }
#pragma unroll
    for (int b = 0; b < 9; ++b) red[(C.wave * 9 + b) * 64 + C.lane] = acc[b];
    __syncthreads();
    for (int idx = C.tid; idx < 576; idx += NTHREADS) { const int b = idx >> 6, j = idx & 63; float s = 0.f;
#pragma unroll
        for (int w = 0; w < 8; ++w) s += red[(w * 9 + b) * 64 + j];
        if (bias) s += bias[n0 + j];
        out[(size_t)b * ostride + (qkperm ? qk_pos(n0 + j) : n0 + j)] = s; }
    __syncthreads();
}
template <int WHICH> __device__ __forceinline__ void transpose_matrix(const Ctx& C, int l, int widx, int nw) {
    LAS float* scr = (LAS float*)(C.lds + C.wave * 16384);
    if (WHICH == 0) for (int it = widx; it < 16 * 64; it += nw) transpose_item(C.w_in + (size_t)l * DM * NPROJ, DM, NPROJ, WSP(bf16, WS_WIN + l * SZ_WIN), scr, it, C.lane, false, true);
    if (WHICH == 1) for (int it = widx; it < 16 * 32; it += nw) transpose_item(C.w_out + (size_t)l * DM * DM, DM, DM, WSP(bf16, WS_WOUT + l * SZ_WOUT), scr, it, C.lane);
    if (WHICH == 2) for (int it = widx; it < 16 * 176; it += nw) transpose_item(C.w_up + (size_t)l * DM * NUP, DM, NUP, WSP(bf16, WS_WUP + l * SZ_WUP), scr, it, C.lane, true);
    if (WHICH == 3) for (int it = widx; it < 44 * 32; it += nw) transpose_item(C.w_down + (size_t)l * DFF * DM, DFF, DM, WSP(bf16, WS_WDN + l * SZ_WDN), scr, it, C.lane);
}
__device__ __forceinline__ void bias_items(const Ctx& C, int l, bool up, int bidx, int nb) {
    LAS float* vec = (LAS float*)C.lds; LAS float* red = (LAS float*)(C.lds + 40960);
    const float* mod = WSP(float, WS_MOD) + (size_t)l * 9 * 6144 + (up ? 3 * 1024 : 0);
    const int nit = up ? 88 : 32;
    if (bidx < nit) {
        __syncthreads();
        { float t[18];
#pragma unroll
          for (int q = 0; q < 18; ++q) { const int idx = C.tid + q * NTHREADS; t[q] = mod[(size_t)(idx >> 10) * 6144 + (idx & 1023)]; }
#pragma unroll
          for (int q = 0; q < 18; ++q) vec[C.tid + q * NTHREADS] = t[q]; }
        __syncthreads();
        for (int it = bidx; it < nit; it += nb) {
            if (up) gemv9_item(C, vec, red, C.w_up + (size_t)l * DM * NUP, NUP, it * 64, nullptr, WSP(float, WS_BUP) + (size_t)l * 9 * NUP, NUP);
            else    gemv9_item(C, vec, red, C.w_in + (size_t)l * DM * NPROJ, NPROJ, it * 64, nullptr, WSP(float, WS_BIN) + (size_t)l * 9 * NPROJ, NPROJ, true); }
    }
}
__device__ __forceinline__ void phase_p0a(const Ctx& C) {
    transpose_matrix<0>(C, 0, C.gw, C.NGW);
    const int gt = C.gw * 64 + C.lane, NGT = C.NGW * 64;
    for (int idx0 = gt; idx0 < DEPTH * 1024 * 256; idx0 += 4 * NGT) {
        float va[4], vi[4];
#pragma unroll
        for (int q = 0; q < 4; ++q) { const int idx = (idx0 + q * NGT < DEPTH * 1024 * 256) ? idx0 + q * NGT : idx0; const int l = idx >> 18, n = (idx >> 8) & 1023, k = idx & 255;
            const int dir = n >> 9, half = (n >> 8) & 1, cl = n & 127, ch = half * 128 + cl, blk = ch >> 6, e = ch & 63;
            const size_t wi = ((((size_t)l * 2 + dir) * 4 + blk) * 64 + (k & 63)) * 64 + e; va[q] = C.lru_wa[wi]; vi[q] = C.lru_wi[wi]; }
#pragma unroll
        for (int q = 0; q < 4; ++q) { const int idx = idx0 + q * NGT; if (idx < DEPTH * 1024 * 256) { const int l = idx >> 18, n = (idx >> 8) & 1023, k = idx & 255;
            const int half = (n >> 8) & 1, gate = (n >> 7) & 1, cl = n & 127, blk = (half * 128 + cl) >> 6; const float v = ((k >> 6) == blk) ? (gate ? vi[q] : va[q]) : 0.f;
            WSP(bf16, WS_GW + l * SZ_GW)[(size_t)n * 256 + k] = (bf16)(pk2(v, 0.f) & 0xffffu); } }
    }
    if (gt < 1024) { const int pos = gt >> 4, f = gt & 15; const float inv = powf(10000.0f, -(float)f / 16.0f), ang = (float)pos * inv;
        WSP(float, WS_ROPE)[gt] = cosf(ang); WSP(float, WS_ROPE)[1024 + gt] = sinf(ang); }
    if (gt < DEPTH * 2 * 256) { const float lam = C.lru_lam[gt]; WSP(float, WS_SPL)[gt] = log1pf(expf(-lam)); }
    __syncthreads();
    LAS float* vec = (LAS float*)C.lds; LAS float* red = (LAS float*)(C.lds + 40960);
    if (C.vcu < DEPTH * 96) {
        { float t[18];
#pragma unroll
          for (int q = 0; q < 18; ++q) { const int idx = C.tid + q * NTHREADS, b = idx >> 10, k = idx & 1023; const float vc = C.c[(b < 8 ? b : 0) * 1024 + k], vx = C.c_ctx[k]; t[q] = b < 8 ? vc : vx; }
#pragma unroll
          for (int q = 0; q < 18; ++q) vec[C.tid + q * NTHREADS] = silu_(t[q]); }
        __syncthreads();
        for (int it = C.vcu; it < DEPTH * 96; it += C.G) { const int l = it / 96, n0 = (it % 96) * 64;
            gemv9_item(C, vec, red, C.w_mod + (size_t)l * DM * 6144, 6144, n0, C.b_mod + l * 6144, WSP(float, WS_MOD) + (size_t)l * 9 * 6144, 6144); }
    }
}
__device__ __forceinline__ void phase_p0b(const Ctx& C) {
    const int nbw = (C.G > 64) ? 32 : 0;
    bias_items(C, 0, false, C.vcu, C.G);
    if (C.vcu < nbw) return;
    const int gw2 = (C.vcu - nbw) * NWAVES + C.wave, NGW2 = (C.G - nbw) * NWAVES;
    bf16* __restrict__ AP = WSP(bf16, WS_AP); float* __restrict__ STA = WSP(float, WS_STA);
    f32x4 g[4];
#pragma unroll
    for (int j = 0; j < 4; ++j) g[j] = *(const f32x4*)(C.g_mix + (C.lane + 64 * j) * 4);
    for (int m0 = gw2; m0 < M_ALL; m0 += 2 * NGW2) {
        f32x4 v[2][4], cc[2][4]; int mm[2];
#pragma unroll
        for (int q = 0; q < 2; ++q) { const int m = (m0 + q * NGW2 < M_ALL) ? m0 + q * NGW2 : m0; mm[q] = m;
            const float* xr = m < M_LAT ? C.x + (size_t)m * DM : C.ctx + (size_t)(m - M_LAT) * DM; const float* ca = WSP(float, WS_MOD) + (size_t)row_bi(m) * 6144 + 1024;
#pragma unroll
            for (int j = 0; j < 4; ++j) { const int k = (C.lane + 64 * j) * 4; v[q][j] = *(const f32x4*)(xr + k); cc[q][j] = *(const f32x4*)(ca + k); } }
#pragma unroll
        for (int q = 0; q < 2; ++q) { float ss = 0.f;
#pragma unroll
            for (int j = 0; j < 4; ++j) { const int k = (C.lane + 64 * j) * 4; const f32x4 x = v[q][j];
                ss += (x.x * x.x + x.y * x.y) + (x.z * x.z + x.w * x.w); const f32x4 a = x * g[j] * (cc[q][j] + 1.0f);
                v2u w; w.x = pk2(a.x, a.y); w.y = pk2(a.z, a.w); *(v2u*)(AP + (size_t)mm[q] * DM + k) = w; }
            ss = wave_sum(ss, C.lane);
            if (C.lane < 16) STA[(size_t)mm[q] * 16 + C.lane] = C.lane == 0 ? ss : 0.f; }
    }
}
__device__ __forceinline__ void deferred_work(const Ctx& C, int window, int d, int nd) {
    const int widx = d * NWAVES + C.wave, nw = nd * NWAVES;
    if (window == 0) { transpose_matrix<1>(C, 0, widx, nw); transpose_matrix<2>(C, 0, widx, nw); transpose_matrix<0>(C, 1, widx, nw); transpose_matrix<1>(C, 1, widx, nw); bias_items(C, 0, true, d, nd); }
    if (window == 1) { transpose_matrix<3>(C, 0, widx, nw); transpose_matrix<3>(C, 1, widx, nw); }
    if (window == 2) { transpose_matrix<2>(C, 1, widx, nw); bias_items(C, 1, true, d, nd); bias_items(C, 1, false, d >= 88 ? d - 88 : d + nd - 88, nd); }
}

__device__ __forceinline__ void rope_tab(const float* ropeT, int t, int j, f32x4 (&cs)[2], f32x4 (&sn)[2]) {
    const int pos = ((j & 3) < 2) ? (t >> 6) : (t & 63), f0 = 8 * (j & 1); const float* c = ropeT + pos * 16 + f0; const float* s = ropeT + 1024 + pos * 16 + f0;
    cs[0] = *(const f32x4*)c; cs[1] = *(const f32x4*)(c + 4); sn[0] = *(const f32x4*)s; sn[1] = *(const f32x4*)(s + 4);
}
__device__ __forceinline__ void rope8(float (&y)[8], const float (&p)[8], const f32x4 (&cs)[2], const f32x4 (&sn)[2], int j) {
#pragma unroll
    for (int e = 0; e < 8; ++e) { const float c = cs[e >> 2][e & 3], s = sn[e >> 2][e & 3]; y[e] = (j < 4) ? (y[e] * c - p[e] * s) : (y[e] * c + p[e] * s); }
}
__device__ __forceinline__ void head_norm_rope(float (&x)[8], const float (&g)[8], bool rope, const f32x4 (&cs)[2], const f32x4 (&sn)[2], int j, int lane) {
    float ss = 0.f;
#pragma unroll
    for (int e = 0; e < 8; ++e) ss += x[e] * x[e];
    ss += shx(ss, 1, lane); ss += shx(ss, 2, lane); ss += shx(ss, 4, lane);
    const float rinv = rsqrtf(ss * (1.0f / 64.0f) + EPS); float p[8];
#pragma unroll
    for (int e = 0; e < 8; ++e) x[e] = x[e] * rinv * g[e];
#pragma unroll
    for (int e = 0; e < 8; ++e) p[e] = shx(x[e], 4, lane);
    if (rope) rope8(x, p, cs, sn, j);
}
__device__ __forceinline__ void phase_post(const Ctx& C, int l, int m_lo, int m_hi, int tasks, int gw, int NGW) {
    const bf16* __restrict__ PROJ = WSP(bf16, WS_PROJ); bf16* __restrict__ MIX = WSP(bf16, WS_MIX); bf16* __restrict__ KB = WSP(bf16, WS_KB); bf16* __restrict__ VB = WSP(bf16, WS_VB); bf16* __restrict__ RC = WSP(bf16, WS_RC);
    const float* __restrict__ ropeT = WSP(float, WS_ROPE);
    if (tasks & 1) { const int j = C.lane & 7; float gq[8];
#pragma unroll
      for (int e = 0; e < 8; ++e) gq[e] = C.g_q[l * 64 + 8 * j + e];
      for (int m0 = m_lo + gw; m0 < m_hi; m0 += 4 * NGW) {
        v4u xw[4]; f32x4 cs[4][2], sn[4][2]; int mm[4];
#pragma unroll
        for (int q = 0; q < 4; ++q) { const int m = m0 + q * NGW; mm[q] = m < m_hi ? m : m0; xw[q] = *(const v4u*)(PROJ + (size_t)mm[q] * NPROJ + C.lane * 8); rope_tab(ropeT, mm[q] & 4095, j, cs[q], sn[q]); }
#pragma unroll
        for (int q = 0; q < 4; ++q) { float x[8]; unpack8(xw[q], x); head_norm_rope(x, gq, mm[q] < M_LAT, cs[q], sn[q], j, C.lane);
#pragma unroll
            for (int e = 0; e < 8; ++e) x[e] *= C2;
            *(v4u*)(MIX + (size_t)mm[q] * DM + C.lane * 8) = pack8(x); }
      } }
    if (tasks & 2) { const int sub = C.lane & 31, j = sub & 7; const bool iskey = sub < 16; float gk[8];
#pragma unroll
      for (int e = 0; e < 8; ++e) gk[e] = C.g_k[l * 64 + 8 * j + e];
      for (int p0 = m_lo / 2 + gw; p0 < m_hi / 2; p0 += 4 * NGW) {
        v4u xw[4]; f32x4 cs[4][2], sn[4][2]; int mm[4];
#pragma unroll
        for (int q = 0; q < 4; ++q) { const int pi = p0 + q * NGW; mm[q] = 2 * (pi < m_hi / 2 ? pi : p0) + (C.lane >> 5); xw[q] = *(const v4u*)(PROJ + (size_t)mm[q] * NPROJ + 512 + sub * 8); rope_tab(ropeT, mm[q] & 4095, j, cs[q], sn[q]); }
#pragma unroll
        for (int q = 0; q < 4; ++q) { const int m = mm[q]; float x[8], y[8]; unpack8(xw[q], x);
#pragma unroll
            for (int e = 0; e < 8; ++e) y[e] = x[e];
            head_norm_rope(y, gk, m < M_LAT, cs[q], sn[q], j, C.lane);
            int b, pos; if (m < M_LAT) { b = m >> 12; pos = m & 4095; } else { const int mc = m - M_LAT; b = mc >> 8; pos = SEQ + (mc & 255); }
            bf16* dst = (iskey ? KB : VB) + ((size_t)b * KVROWS + pos) * KVP + (sub & 15) * 8;
            *(v4u*)dst = iskey ? pack8(y) : pack8(x); }
      } }
    if (tasks & 4) { const int sub = C.lane & 31, ch0 = sub * 8; float cw[4][8], cb[8];
#pragma unroll
      for (int e = 0; e < 8; ++e) { cb[e] = C.lru_conv_b[l * 256 + ch0 + e];
#pragma unroll
          for (int k = 0; k < 4; ++k) cw[k][e] = C.lru_conv_w[(l * 4 + k) * 256 + ch0 + e]; }
      for (int it = gw; it < (m_hi - m_lo) / 16; it += NGW) {
        const int m0 = m_lo + it * 16 + 8 * (C.lane >> 5); int t0, T; if (m0 < M_LAT) { t0 = m0 & 4095; T = SEQ; } else { t0 = (m0 - M_LAT) & 255; T = CTXL; }
        const bool head = t0 == 0, tail = t0 + 8 == T;
        v4u xw[11];
#pragma unroll
        for (int j = 0; j < 11; ++j) { const bool ok = !((j < 2 && head) || (j == 10 && tail)); xw[j] = *(const v4u*)(PROJ + (size_t)(ok ? m0 + j - 2 : m0) * NPROJ + 768 + ch0); }
        float xa[8], xb[8], xc[8], xd[8];
        unpack8(xw[0], xa); unpack8(xw[1], xb); unpack8(xw[2], xc);
        if (head) {
#pragma unroll
            for (int e = 0; e < 8; ++e) { xa[e] = 0.f; xb[e] = 0.f; } }
#pragma unroll
        for (int i = 0; i < 8; ++i) { unpack8(xw[i + 3], xd);
            if (i == 7 && tail) {
#pragma unroll
                for (int e = 0; e < 8; ++e) xd[e] = 0.f; }
            float acc[8];
#pragma unroll
            for (int e = 0; e < 8; ++e) acc[e] = cb[e] + cw[0][e] * xa[e] + cw[1][e] * xb[e] + cw[2][e] * xc[e] + cw[3][e] * xd[e];
            const int m = m0 + i, rrow = (m & ~63) + 16 * (m & 3) + ((m & 63) >> 2);
            *(v4u*)(RC + (size_t)rrow * 256 + ch0) = pack8(acc);
#pragma unroll
            for (int e = 0; e < 8; ++e) { xa[e] = xb[e]; xb[e] = xc[e]; xc[e] = xd[e]; } }
      } }
    if (tasks & 8) { const int sub = C.lane & 31, ch0 = sub * 8; float cw[3][8];
#pragma unroll
      for (int e = 0; e < 8; ++e)
#pragma unroll
          for (int k = 0; k < 3; ++k) cw[k][e] = C.sc_conv_w[(l * 3 + k) * 256 + ch0 + e];
      for (int it = gw; it < (m_hi - m_lo) / 16; it += NGW) {
        const int m0 = m_lo + it * 16 + 8 * (C.lane >> 5); int t0, T; if (m0 < M_LAT) { t0 = m0 & 4095; T = SEQ; } else { t0 = (m0 - M_LAT) & 255; T = CTXL; }
        const bool head = t0 == 0, tail = t0 + 8 == T;
        v4u bw[8], cw_[10], uw[10];
#pragma unroll
        for (int j = 0; j < 10; ++j) { const bool ok = !((j == 0 && head) || (j == 9 && tail)); const bf16* rp = PROJ + (size_t)(ok ? m0 + j - 1 : m0) * NPROJ + ch0;
            cw_[j] = *(const v4u*)(rp + 1536); uw[j] = *(const v4u*)(rp + 1792); if (j >= 1 && j <= 8) bw[j - 1] = *(const v4u*)(PROJ + (size_t)(m0 + j - 1) * NPROJ + 1280 + ch0); }
        float pa[8], pb[8], pc[8];
        { float cg[8], u[8]; unpack8(cw_[0], cg); unpack8(uw[0], u);
#pragma unroll
          for (int e = 0; e < 8; ++e) pa[e] = head ? 0.f : cg[e] * u[e];
          unpack8(cw_[1], cg); unpack8(uw[1], u);
#pragma unroll
          for (int e = 0; e < 8; ++e) pb[e] = cg[e] * u[e]; }
#pragma unroll
        for (int i = 0; i < 8; ++i) { float cg[8], u[8], bg[8], o[8]; unpack8(cw_[i + 2], cg); unpack8(uw[i + 2], u); unpack8(bw[i], bg);
#pragma unroll
            for (int e = 0; e < 8; ++e) pc[e] = (i == 7 && tail) ? 0.f : cg[e] * u[e];
#pragma unroll
            for (int e = 0; e < 8; ++e) o[e] = bg[e] * (cw[0][e] * pa[e] + cw[1][e] * pb[e] + cw[2][e] * pc[e]);
            *(v4u*)(MIX + (size_t)(m0 + i) * DM + 768 + ch0) = pack8(o);
#pragma unroll
            for (int e = 0; e < 8; ++e) { pa[e] = pb[e]; pb[e] = pc[e]; } }
      } }
}

__device__ __forceinline__ int chunk_row0(int b, int c) { return c < 4 ? M_LAT + b * CTXL + c * 64 : b * SEQ + (c - 4) * 64; }
__device__ __forceinline__ void phase_scan2(const Ctx& C, int l) {
    const unsigned* __restrict__ LAB = WSP(unsigned, WS_LA); const float* __restrict__ AGP = WSP(float, WS_AGP); const float* __restrict__ AGB = WSP(float, WS_AGB);
    const bf16* __restrict__ PROJ = WSP(bf16, WS_PROJ); bf16* __restrict__ MIX = WSP(bf16, WS_MIX);
    const bool lat_only = (l == DEPTH - 1);
    const int nitems = lat_only ? NB * 64 * 4 : NB * NCHUNK * 4;
    for (int it = C.gw; it < nitems; it += C.NGW) {
        const int chq = it & 3, bc = it >> 2, ch = chq * 64 + C.lane; int b, c; if (lat_only) { b = bc >> 6; c = 4 + (bc & 63); } else { c = bc % NCHUNK; b = bc / NCHUNK; }
        const float* gpF = AGP + ((size_t)(0 * NB + b) * NCHUNK) * 256 + ch; const float* gbF = AGB + ((size_t)(0 * NB + b) * NCHUNK) * 256 + ch;
        const float* gpB = AGP + ((size_t)(1 * NB + b) * NCHUNK) * 256 + ch; const float* gbB = AGB + ((size_t)(1 * NB + b) * NCHUNK) * 256 + ch;
        const int nf = c, nb = c >= 4 ? 71 - c : 3 - c, nt = nf + nb;
        float hf = 0.f, hb = 0.f;
        for (int k0 = 0; k0 < nt; k0 += 24) { float p[24], q[24];
#pragma unroll
            for (int j = 0; j < 24; ++j) { const int k = min(k0 + j, nt - 1); const bool fw = k < nf; const int kb = k - nf, cc = fw ? k : (kb < 4 ? 3 - kb : 71 - kb);
                const float* pp = fw ? gpF : gpB; const float* qq = fw ? gbF : gbB; p[j] = pp[cc * 256]; q[j] = qq[cc * 256]; }
#pragma unroll
            for (int j = 0; j < 24; ++j) { const int k = k0 + j; const bool v = k < nt, fw = k < nf;
                const float pj = v ? p[j] : 1.0f, qj = v ? q[j] : 0.0f;
                hf = fw ? pj * hf + qj : hf; hb = fw ? hb : pj * hb + qj; } }
        const int row0 = chunk_row0(b, c);
        LAS unsigned* TF = (LAS unsigned*)(C.lds + C.wave * 8192); LAS bf16* TG = (LAS bf16*)(C.lds + C.wave * 8192 + 4096); LAS bf16* TO = (LAS bf16*)(C.lds + C.wave * 8192 + 6144);
        const int l4t = C.lane >> 4, l4c = (C.lane & 15) * 4, l8t = C.lane >> 3, l8c = (C.lane & 7) * 8;
        const unsigned* pF = LAB + ((size_t)0 * M_ALL + row0) * 256 + chq * 64 + l4c; const unsigned* pB = LAB + ((size_t)1 * M_ALL + row0) * 256 + chq * 64 + l4c;
        const bf16* pg = PROJ + (size_t)row0 * NPROJ + 1024 + chq * 64 + l8c; bf16* po = MIX + (size_t)row0 * DM + 512 + chq * 64 + l8c;
        float hv[64];
        { v4u wf[16];
#pragma unroll
          for (int q = 0; q < 16; ++q) wf[q] = *(const v4u*)(pF + (size_t)(4 * q + l4t) * 256);
#pragma unroll
          for (int st = 0; st < 4; ++st) {
#pragma unroll
              for (int i = 0; i < 4; ++i) *(LAS v4u*)(TF + (4 * i + l4t) * 64 + l4c) = wf[st * 4 + i];
#pragma unroll
              for (int t = 0; t < 16; ++t) { const unsigned w = TF[t * 64 + C.lane]; hf = __builtin_amdgcn_exp2f(bflo(w)) * hf + bfhi(w); hv[st * 16 + t] = hf; } } }
        { v4u wb[16], wg[8];
#pragma unroll
          for (int q = 0; q < 16; ++q) wb[q] = *(const v4u*)(pB + (size_t)(4 * q + l4t) * 256);
#pragma unroll
          for (int q = 0; q < 8; ++q) wg[q] = *(const v4u*)(pg + (size_t)(8 * q + l8t) * NPROJ);
#pragma unroll
          for (int st = 3; st >= 0; --st) {
#pragma unroll
              for (int i = 0; i < 4; ++i) *(LAS v4u*)(TF + (4 * i + l4t) * 64 + l4c) = wb[st * 4 + i];
#pragma unroll
              for (int j = 0; j < 2; ++j) *(LAS v4u*)(TG + (8 * j + l8t) * 64 + l8c) = wg[st * 2 + j];
#pragma unroll
              for (int t = 15; t >= 0; --t) { const unsigned w = TF[t * 64 + C.lane]; const float g = bf1(TG[t * 64 + C.lane]); hb = __builtin_amdgcn_exp2f(bflo(w)) * hb + bfhi(w);
                  TO[t * 64 + C.lane] = (bf16)(pk2(gelu_tanh_(g) * (hv[st * 16 + t] + hb), 0.f) & 0xffffu); }
#pragma unroll
              for (int j = 0; j < 2; ++j) { const v4u o = *(const LAS v4u*)(TO + (8 * j + l8t) * 64 + l8c); *(v4u*)(po + (size_t)(st * 16 + 8 * j + l8t) * DM) = o; } } }
    }
}

namespace attn_body {
using abf16=__hip_bfloat16;
using bf16x8=__attribute__((ext_vector_type(8)))short;
using s16x4=__attribute__((ext_vector_type(4)))short;
using f32x16=__attribute__((ext_vector_type(16)))float;
using u32x4=__attribute__((ext_vector_type(4)))unsigned;
constexpr int D=64,DM=1024,KVPITCH=128;
constexpr int NW=8,QBLK=32,QB=QBLK*NW,KVBLK=64;
__device__ __forceinline__ int crow(int r,int hi){return (r&3)+8*(r>>2)+4*hi;}
#define SBAR() __builtin_amdgcn_sched_barrier(0)
constexpr int NSLOT=3, SLOTB=8192;
constexpr int LDS_K=0, LDS_V=NSLOT*SLOTB, LDS_WS=2*NSLOT*SLOTB, LDS_OST=LDS_WS+NW*64*4, LDS_BYTES=LDS_OST+NW*4096;
constexpr float C2=0.125f*1.4426950408889634f;
__device__ __forceinline__ void glds16(const void*gsrc,unsigned lds_dst){unsigned keep;
  asm volatile("s_mov_b32 %0, m0\n\ts_mov_b32 m0, %2\n\ts_nop 0\n\tglobal_load_lds_dwordx4 %1, off\n\ts_mov_b32 m0, %0":"=&s"(keep):"v"(gsrc),"s"(lds_dst):"memory");}
__device__ __forceinline__ float max3f(float a,float b,float c){float r;asm("v_max3_f32 %0, %1, %2, %3":"=v"(r):"v"(a),"v"(b),"v"(c));return r;}
__device__ __forceinline__ float max2f(float a,float b){float r;asm("v_max_f32_e32 %0, %1, %2":"=v"(r):"v"(a),"v"(b));return r;}
__device__ __forceinline__ float fadd_s(float a,float b){float r;asm("v_add_f32_e32 %0, %1, %2":"=v"(r):"v"(a),"v"(b));return r;}
__device__ __forceinline__ float fsub_s(float a,float b){float r;asm("v_sub_f32_e32 %0, %1, %2":"=v"(r):"v"(a),"v"(b));return r;}
typedef float f32x2_t __attribute__((ext_vector_type(2))); typedef __bf16 bf16x2_t __attribute__((ext_vector_type(2)));
__device__ __forceinline__ unsigned cvtpk_s(float lo,float hi){f32x2_t v={lo,hi};bf16x2_t b=__builtin_convertvector(v,bf16x2_t);return __builtin_bit_cast(unsigned,b);}
#define WAIT_BAR(N) asm volatile("s_waitcnt vmcnt(" #N ") lgkmcnt(0)\n\ts_barrier":::"memory")

__device__ __forceinline__ void qkt(f32x16&p0,f32x16&p1,const char*Kslot,const bf16x8*qr,const f32x16&negm,int r32,int hi){
  const char*kb=Kslot+hi*1024+r32*16;
  #pragma unroll
  for(int d0=0;d0<4;++d0){
    const bf16x8 b0=*reinterpret_cast<const bf16x8*>(kb+d0*2048);
    const bf16x8 b1=*reinterpret_cast<const bf16x8*>(kb+d0*2048+512);
    if(d0==0){p0=__builtin_amdgcn_mfma_f32_32x32x16_bf16(b0,qr[0],negm,0,0,0);p1=__builtin_amdgcn_mfma_f32_32x32x16_bf16(b1,qr[0],negm,0,0,0);}
    else{p0=__builtin_amdgcn_mfma_f32_32x32x16_bf16(b0,qr[d0],p0,0,0,0);p1=__builtin_amdgcn_mfma_f32_32x32x16_bf16(b1,qr[d0],p1,0,0,0);}}
}
typedef __attribute__((address_space(3))) const char* lds_cptr;
typedef short v4i16_t __attribute__((ext_vector_type(4)));
__device__ __forceinline__ void kload8(bf16x8*kf,lds_cptr kp){
  kf[0]=*(const __attribute__((address_space(3))) bf16x8*)(kp);      kf[1]=*(const __attribute__((address_space(3))) bf16x8*)(kp+512);
  kf[2]=*(const __attribute__((address_space(3))) bf16x8*)(kp+2048); kf[3]=*(const __attribute__((address_space(3))) bf16x8*)(kp+2560);
  kf[4]=*(const __attribute__((address_space(3))) bf16x8*)(kp+4096); kf[5]=*(const __attribute__((address_space(3))) bf16x8*)(kp+4608);
  kf[6]=*(const __attribute__((address_space(3))) bf16x8*)(kp+6144); kf[7]=*(const __attribute__((address_space(3))) bf16x8*)(kp+6656);
}
__device__ __forceinline__ void kload2(bf16x8*kf,lds_cptr kp,int j){ kf[2*j]=*(const __attribute__((address_space(3))) bf16x8*)(kp+j*2048); kf[2*j+1]=*(const __attribute__((address_space(3))) bf16x8*)(kp+j*2048+512); }
__device__ __forceinline__ s16x4 vtr(lds_cptr p){ return __builtin_bit_cast(s16x4,__builtin_amdgcn_ds_read_tr16_b64_v4i16((__attribute__((address_space(3))) v4i16_t*)p)); }
__device__ __forceinline__ void pv(f32x16*o,int vb,bf16x8 pa0,bf16x8 pa1,bf16x8 pa2,bf16x8 pa3){
  #pragma unroll
  for(int d0=0;d0<2;++d0){s16x4 lo[4],hi[4];
    #pragma unroll
    for(int ks=0;ks<4;++ks){
      asm volatile("ds_read_b64_tr_b16 %0,%1 offset:%c2":"=&v"(lo[ks]):"v"(vb),"i"(d0*4096+ks*1024):"memory");
      asm volatile("ds_read_b64_tr_b16 %0,%1 offset:%c2":"=&v"(hi[ks]):"v"(vb),"i"(d0*4096+ks*1024+512):"memory");}
    asm volatile("s_waitcnt lgkmcnt(0)":::"memory");SBAR();
    #define PK(k) (bf16x8){lo[k][0],lo[k][1],lo[k][2],lo[k][3],hi[k][0],hi[k][1],hi[k][2],hi[k][3]}
    o[d0]=__builtin_amdgcn_mfma_f32_32x32x16_bf16(pa0,PK(0),o[d0],0,0,0);
    o[d0]=__builtin_amdgcn_mfma_f32_32x32x16_bf16(pa1,PK(1),o[d0],0,0,0);
    o[d0]=__builtin_amdgcn_mfma_f32_32x32x16_bf16(pa2,PK(2),o[d0],0,0,0);
    o[d0]=__builtin_amdgcn_mfma_f32_32x32x16_bf16(pa3,PK(3),o[d0],0,0,0);
    #undef PK
  }
}

#ifndef ATTN_STORE16
#define ATTN_STORE16(p,v) (*(u32x4*)(p)=(v))
#endif
template<int THRL> __device__ __forceinline__ void attn_unit(abf16*Qb,abf16*Ob,const abf16*__restrict__ Kh,const abf16*__restrict__ Vh,const int NT,char*shm,const int tid,const float mref){
  const int lane=tid&63,r32=lane&31,hi=lane>>5; const int wid=__builtin_amdgcn_readfirstlane(tid>>6);
  const abf16*Qw=Qb+(long)(wid*QBLK)*DM;
  const unsigned lds0=(unsigned)(uintptr_t)shm;
  float*wsf=(float*)(shm+LDS_WS)+wid*64;
  const abf16*ksrc=Kh+(long)lane*KVPITCH+wid*8;
  const abf16*vsrc=Vh+(long)(16*(wid&3)+(lane>>2))*KVPITCH+(wid>>2)*32+(lane&3)*8;
  const unsigned kdst=lds0+LDS_K+wid*1024, vdst=lds0+LDS_V+wid*1024;
  #define DMA_K(t,slot) glds16(ksrc+(long)(t)*KVBLK*KVPITCH,(unsigned)__builtin_amdgcn_readfirstlane(kdst+(slot)))
  #define DMA_V(t,slot) glds16(vsrc+(long)(t)*KVBLK*KVPITCH,(unsigned)__builtin_amdgcn_readfirstlane(vdst+(slot)))
  const int vb0=(int)(lds0+LDS_V)+((lane>>4)&1)*32+(lane&3)*8+(4*hi+((lane&15)>>2))*64;
  const char*Kbase=shm+LDS_K; bf16x8 kf[8];
  const lds_cptr shm3=(lds_cptr)shm; const lds_cptr kp0=shm3+LDS_K+hi*1024+r32*16; const lds_cptr vp0=shm3+LDS_V+((lane>>4)&1)*32+(lane&3)*8+(4*hi+((lane&15)>>2))*64;
  DMA_K(0,0);DMA_V(0,0);DMA_K(1,SLOTB);
  bf16x8 qr[4];
  #pragma unroll
  for(int d0=0;d0<4;++d0)qr[d0]=*reinterpret_cast<const bf16x8*>(&Qw[(long)r32*DM+d0*16+hi*8]);
  float l_reg=0.f;f32x16 o[2];o[0]=f32x16{};o[1]=f32x16{};f32x16 negm;
  #pragma unroll
  for(int r=0;r<16;++r)negm[r]=-mref;
  asm volatile("":"+v"(negm));
  #define CMASK(P0,P1,t) do{}while(0)
  #define START(P0,P1) do{ _Pragma("unroll") for(int r=0;r<16;++r)P0[r]=__builtin_amdgcn_exp2f(P0[r]); }while(0)
  #define RESC() do{}while(0)
  f32x16 pA0,pA1,pB0,pB1;
  int sl_prev=0,sl_cur=0,sl_next=SLOTB;
  #define ROT() do{sl_prev=sl_cur;sl_cur=sl_next;sl_next=(sl_next==(NSLOT-1)*SLOTB)?0:sl_next+SLOTB;}while(0)
  DMA_K(2,2*SLOTB);
  WAIT_BAR(3);
  qkt(pA0,pA1,Kbase,qr,negm,r32,hi);asm volatile("s_nop 15\n\ts_nop 7":"+v"(pA0),"+v"(pA1));CMASK(pA0,pA1,0);
  START(pA0,pA1);
  _Pragma("unroll") for(int r=0;r<16;++r)pA1[r]=__builtin_amdgcn_exp2f(pA1[r]);
  WAIT_BAR(0);
  DMA_K(3,0);DMA_V(1,SLOTB);
  ROT();
  kload8(kf,kp0+sl_cur);
  WAIT_BAR(2);
  s16x4 vlo[8],vhi[8]; u32x4 pw0,pw1,pw2,pw3;
  #define PKW(P,B) cvtpk_s(P[B],P[B+1])
  #define PAF(k) __builtin_bit_cast(bf16x8,pw##k)
  #define VFR(i) (bf16x8){vlo[i][0],vlo[i][1],vlo[i][2],vlo[i][3],vhi[i][0],vhi[i][1],vhi[i][2],vhi[i][3]}
  #define PIN(x) asm volatile("":"+v"(x))
  #define MX3(a,b,c) __builtin_fmaxf(__builtin_fmaxf((a),(b)),(c))
  #define GAPA(MF,A0,A1,A2,A3,W0,W1,PW) do{ MF; sacc+=A0; sacc+=A1; sacc+=A2; sacc+=A3; PIN(sacc); W0; W1; PIN(PW); SBAR(); }while(0)
  #define EX(v) __builtin_amdgcn_exp2f(v)
  #define GAPB(MF,X,B) do{ MF; X[B]=EX(X[B]); X[B+1]=EX(X[B+1]); X[B+2]=EX(X[B+2]); X[B+3]=EX(X[B+3]); PIN(X); SBAR(); }while(0)
  #define VRD(i) do{ vlo[i]=vtr(vp_+(((i)>>2)*4096+((i)&3)*1024)); vhi[i]=vtr(vp_+(((i)>>2)*4096+((i)&3)*1024+512)); }while(0)
  #define KRD(G,j) do{ if(G){ kload2(kf,kp0+sl_next,j); SBAR(); } }while(0)
  #define STEP(C0,C1,P0,P1,t,GK,GV,GL) do{ SBAR(); \
    const lds_cptr vp_=vp0+sl_prev; \
    VRD(0); SBAR(); float sacc=(P0[0]+P0[1]); \
    GAPA(C0=__builtin_amdgcn_mfma_f32_32x32x16_bf16(kf[0],qr[0],negm,0,0,0), P0[2],P0[3],P0[4],P0[5],     pw0[0]=PKW(P0,0), pw0[1]=PKW(P0,2), pw0); \
    VRD(4); SBAR(); GAPA(C1=__builtin_amdgcn_mfma_f32_32x32x16_bf16(kf[1],qr[0],negm,0,0,0), P0[6],P0[7],P0[8],P0[9],     pw0[2]=PKW(P0,4), pw0[3]=PKW(P0,6), pw0); \
    VRD(1); SBAR(); GAPA(C0=__builtin_amdgcn_mfma_f32_32x32x16_bf16(kf[2],qr[1],C0,0,0,0),   P0[10],P0[11],P0[12],P0[13], pw1[0]=PKW(P0,8), pw1[1]=PKW(P0,10), pw1); \
    VRD(5); SBAR(); GAPA(C1=__builtin_amdgcn_mfma_f32_32x32x16_bf16(kf[3],qr[1],C1,0,0,0),   P0[14],P0[15],P1[0],P1[1],   pw1[2]=PKW(P0,12),pw1[3]=PKW(P0,14), pw1); \
    VRD(2); SBAR(); GAPA(C0=__builtin_amdgcn_mfma_f32_32x32x16_bf16(kf[4],qr[2],C0,0,0,0),   P1[2],P1[3],P1[4],P1[5],     pw2[0]=PKW(P1,0), pw2[1]=PKW(P1,2), pw2); \
    VRD(6); SBAR(); GAPA(C1=__builtin_amdgcn_mfma_f32_32x32x16_bf16(kf[5],qr[2],C1,0,0,0),   P1[6],P1[7],P1[8],P1[9],     pw2[2]=PKW(P1,4), pw2[3]=PKW(P1,6), pw2); \
    VRD(3); SBAR(); GAPA(C0=__builtin_amdgcn_mfma_f32_32x32x16_bf16(kf[6],qr[3],C0,0,0,0),   P1[10],P1[11],P1[12],P1[13], pw3[0]=PKW(P1,8), pw3[1]=PKW(P1,10), pw3); \
    VRD(7); SBAR(); GAPA(C1=__builtin_amdgcn_mfma_f32_32x32x16_bf16(kf[7],qr[3],C1,0,0,0),   P1[14],P1[15],0.f,0.f,       pw3[2]=PKW(P1,12),pw3[3]=PKW(P1,14), pw3); \
    l_reg+=sacc; \
    if(GK){DMA_K((t)+3,sl_cur);} if(GV){DMA_V((t)+1,sl_next);} \
    CMASK(C0,C1,t); \
    SBAR(); \
    GAPB(o[0]=__builtin_amdgcn_mfma_f32_32x32x16_bf16(PAF(0),VFR(0),o[0],0,0,0), C0,0); \
    GAPB(o[1]=__builtin_amdgcn_mfma_f32_32x32x16_bf16(PAF(0),VFR(4),o[1],0,0,0), C0,4); \
    KRD(GL,0); GAPB(o[0]=__builtin_amdgcn_mfma_f32_32x32x16_bf16(PAF(1),VFR(1),o[0],0,0,0), C0,8); \
    KRD(GL,1); GAPB(o[1]=__builtin_amdgcn_mfma_f32_32x32x16_bf16(PAF(1),VFR(5),o[1],0,0,0), C0,12); \
    KRD(GL,2); GAPB(o[0]=__builtin_amdgcn_mfma_f32_32x32x16_bf16(PAF(2),VFR(2),o[0],0,0,0), C1,0); \
    KRD(GL,3); GAPB(o[1]=__builtin_amdgcn_mfma_f32_32x32x16_bf16(PAF(2),VFR(6),o[1],0,0,0), C1,4); \
    GAPB(o[0]=__builtin_amdgcn_mfma_f32_32x32x16_bf16(PAF(3),VFR(3),o[0],0,0,0), C1,8); \
    GAPB(o[1]=__builtin_amdgcn_mfma_f32_32x32x16_bf16(PAF(3),VFR(7),o[1],0,0,0), C1,12); \
    }while(0)
  int t=1;
  #undef CMASK
  #define CMASK(P0,P1,t) do{}while(0)
  for(;t+5<NT;t+=2){
    STEP(pB0,pB1,pA0,pA1,t,true,true,true);     WAIT_BAR(2); RESC(); ROT();
    STEP(pA0,pA1,pB0,pB1,t+1,true,true,true);   WAIT_BAR(2); RESC(); ROT();
  }
  #undef CMASK
  #define CMASK(P0,P1,t) do{}while(0)
  #define ENDW(tt) do{ if((tt)+3<NT){WAIT_BAR(2);} else if((tt)+2<NT){WAIT_BAR(1);} else {WAIT_BAR(0);} }while(0)
  for(;t+1<NT;t+=2){
    STEP(pB0,pB1,pA0,pA1,t,(t+3<NT),(t+1<NT),(t+1<NT));       ENDW(t);   RESC(); ROT();
    STEP(pA0,pA1,pB0,pB1,t+1,(t+4<NT),(t+2<NT),(t+2<NT));     ENDW(t+1); RESC(); ROT();
  }
  STEP(pB0,pB1,pA0,pA1,NT-1,false,false,false); RESC();
  { float sacc=pB0[0]+pB0[1]; _Pragma("unroll") for(int r=2;r<16;++r)sacc+=pB0[r]; _Pragma("unroll") for(int r=0;r<16;++r)sacc+=pB1[r]; l_reg+=sacc;
    pw0=(u32x4){PKW(pB0,0),PKW(pB0,2),PKW(pB0,4),PKW(pB0,6)};pw1=(u32x4){PKW(pB0,8),PKW(pB0,10),PKW(pB0,12),PKW(pB0,14)};pw2=(u32x4){PKW(pB1,0),PKW(pB1,2),PKW(pB1,4),PKW(pB1,6)};pw3=(u32x4){PKW(pB1,8),PKW(pB1,10),PKW(pB1,12),PKW(pB1,14)};
    SBAR(); pv(o,vb0+sl_cur,PAF(0),PAF(1),PAF(2),PAF(3)); }
  #undef PKW
  #undef PAF
  #undef VFR
  #undef PIN
  #undef MX3
  #undef GAPA
  #undef GAPB
  #undef EX
  #undef VRD
  #undef KRD
  #undef STEP
  #undef ENDW
  {auto rr=__builtin_amdgcn_permlane32_swap(__float_as_uint(l_reg),__float_as_uint(l_reg),false,false);l_reg=__uint_as_float(rr[0])+__uint_as_float(rr[1]);}
  if(hi==0)wsf[32+r32]=l_reg;asm volatile("s_waitcnt lgkmcnt(0)":::"memory");
  float rli[16];
  #pragma unroll
  for(int r=0;r<16;++r)rli[r]=__builtin_amdgcn_rcpf(wsf[32+crow(r,hi)]);
  abf16*Ow=Ob+(long)(wid*QBLK)*DM;
  { abf16*stg=(abf16*)(shm+LDS_OST)+wid*2048;
    #pragma unroll
    for(int r=0;r<16;++r){const int orow=crow(r,hi);
      #pragma unroll
      for(int d0=0;d0<2;++d0)stg[orow*64+d0*32+r32]=__float2bfloat16(o[d0][r]*rli[r]);}
    asm volatile("s_waitcnt lgkmcnt(0)":::"memory");
    #pragma unroll
    for(int i=0;i<4;++i){const int row=i*8+(lane>>3),ch=lane&7; const u32x4 v=*(const u32x4*)(stg+row*64+ch*8); ATTN_STORE16(Ow+(long)row*DM+ch*8,v);} }
  asm volatile("s_waitcnt lgkmcnt(0)\n\ts_barrier":::"memory");
  #undef DMA_K
  #undef DMA_V
  #undef CMASK
  #undef START
  #undef RESC
  #undef ROT
}
constexpr int ATTN_LDS_BYTES=LDS_BYTES;
#undef SBAR
#undef WAIT_BAR
}

__device__ __forceinline__ void phase_attn_fast(const Ctx& C, int l, bool dummy_out = false) {
    using attn_body::abf16;
    abf16* MIX = (abf16*)(C.ws + WS_MIX); const abf16* KB = (const abf16*)(C.ws + WS_KB); const abf16* VB = (const abf16*)(C.ws + WS_VB);
    const int nctx = (l == 0) ? 64 : 0;
    float mq = fabsf(C.g_q[l * 64 + C.lane]), mk = fabsf(C.g_k[l * 64 + C.lane]);
#pragma unroll
    for (int o = 1; o < 64; o <<= 1) { mq = fmaxf(mq, shx(mq, o, C.lane)); mk = fmaxf(mk, shx(mk, o, C.lane)); }
    const float mref = fminf(64.0f * C2 * mq * mk * 1.02f + 0.5f, 96.0f);
    for (int i = 0;; ++i) {
        int U;
        if (C.G == 256) {
            if (i < 4) U = (C.vcu >> 5) * 128 + i * 32 + (C.vcu & 31);
            else if (i == 4 && nctx && (C.vcu & 3) == 0) U = 1024 + (C.vcu >> 2);
            else break;
        } else { U = i * C.G + C.vcu; if (U >= 1024 + nctx) break; }
        int b, h, qrow, key0, NT;
        if (U < 1024) { const int g = U >> 6, r = U & 63; b = g >> 1; h = (g & 1) * 4 + (r >> 4); qrow = b * SEQ + (r & 15) * 256; key0 = 0; NT = KVROWS / 64; }
        else { const int id = U - 1024; b = id >> 3; h = id & 7; qrow = M_LAT + b * CTXL; key0 = SEQ; NT = CTXL / 64; }
        const size_t kvoff = ((size_t)b * KVROWS + key0) * KVP + (h >> 2) * 64;
        abf16* Obase = dummy_out ? (abf16*)(C.ws + WS_AP) : MIX;
        attn_body::attn_unit<8>(MIX + (size_t)qrow * DM + h * 64, Obase + (size_t)qrow * DM + h * 64, KB + kvoff, VB + kvoff, NT, C.lds_gen, C.tid, mref);
    }
}

__device__ __forceinline__ void ffn_fix_panel(const Ctx& C, int l, int pm) {
    const bf16* EDGE = WSP(bf16, WS_EDGE); bf16* ACT = WSP(bf16, WS_ACT);
    for (int idx = C.tid; idx < 2 * 352; idx += NTHREADS) {
        const int side = idx >= 352 ? 1 : 0, j0 = (idx - side * 352) * 8, R = pm * 256;
        bool first, last; if (pm < 128) { first = (R & 4095) == 0; last = ((R + 255) & 4095) == 4095; } else { first = true; last = true; }
        const bf16 *pu, *px, *pd; bool hu, hd; int row;
        if (side == 0) { row = R; hu = !first; hd = true; pu = EDGE + (size_t)((pm - 1) * 4 + 3) * NUP; px = EDGE + (size_t)(pm * 4 + 0) * NUP; pd = EDGE + (size_t)(pm * 4 + 1) * NUP; }
        else { row = R + 255; hu = true; hd = !last; pu = EDGE + (size_t)(pm * 4 + 2) * NUP; px = EDGE + (size_t)(pm * 4 + 3) * NUP; pd = EDGE + (size_t)((pm + 1) * 4 + 0) * NUP; }
        float au[8], ag[8];
#pragma unroll
        for (int e = 0; e < 8; ++e) { au[e] = 0.f; ag[e] = 0.f; }
#pragma unroll
        for (int k = 0; k < 3; ++k) { const bool has = (k == 0) ? hu : (k == 2) ? hd : true; const bf16* rp = ((k == 0) ? pu : (k == 2) ? pd : px) + j0;
            if (has) { float u[8], g[8]; unpack8(*(const v4u*)rp, u); unpack8(*(const v4u*)(rp + DFF), g);
                const float* wu = C.ffn_conv_w + (size_t)(l * 3 + k) * NUP + j0; const f32x4 wu0 = *(const f32x4*)wu, wu1 = *(const f32x4*)(wu + 4), wg0 = *(const f32x4*)(wu + DFF), wg1 = *(const f32x4*)(wu + DFF + 4);
#pragma unroll
                for (int e = 0; e < 4; ++e) { au[e] += wu0[e] * u[e]; au[4 + e] += wu1[e] * u[4 + e]; ag[e] += wg0[e] * g[e]; ag[4 + e] += wg1[e] * g[4 + e]; } } }
        float o[8];
#pragma unroll
        for (int e = 0; e < 8; ++e) o[e] = silu_(ag[e]) * au[e];
        *(v4u*)(ACT + (size_t)row * DFF + j0) = pack8(o);
    }
}
__device__ __forceinline__ void phase_final(const Ctx& C) {
    const float* __restrict__ STA = WSP(float, WS_STA); const bf16* __restrict__ XR = WSP(bf16, WS_XR);
    f32x4 g[2][2];
#pragma unroll
    for (int j = 0; j < 2; ++j) { g[j][0] = *(const f32x4*)(C.g_final + C.lane * 8 + 512 * j); g[j][1] = *(const f32x4*)(C.g_final + C.lane * 8 + 512 * j + 4); }
    for (int m = C.gw; m < M_LAT; m += C.NGW) {
        float s = STA[(size_t)m * 16 + (C.lane & 15)];
        v4u w[2];
#pragma unroll
        for (int j = 0; j < 2; ++j) w[j] = *(const v4u*)(XR + (size_t)m * DM + C.lane * 8 + 512 * j);
        s += shx(s, 1, C.lane); s += shx(s, 2, C.lane); s += shx(s, 4, C.lane); s += shx(s, 8, C.lane);
        const float r = rsqrtf(s * (1.0f / DM) + EPS);
#pragma unroll
        for (int j = 0; j < 2; ++j) { float x[8]; unpack8(w[j], x); float* o = C.out + (size_t)m * DM + C.lane * 8 + 512 * j;
            *(f32x4*)o = (f32x4){x[0], x[1], x[2], x[3]} * r * g[j][0]; *(f32x4*)(o + 4) = (f32x4){x[4], x[5], x[6], x[7]} * r * g[j][1]; }
    }
}

namespace pg8 {
#define PG8_LAS __attribute__((address_space(3)))
typedef unsigned short bf16_t;
typedef short bf16x8 __attribute__((ext_vector_type(8)));
typedef float f32x4 __attribute__((ext_vector_type(4)));
typedef unsigned u32x4 __attribute__((ext_vector_type(4)));
constexpr int BM = 256, BK = 64, HALF = 128, HTB = HALF * BK * 2  , STAGE_BYTES = 8 * HTB, NXCD = 8, WGM = 8;

__host__ __device__ __forceinline__ int lds_byte(int r, int c) { const int st = (r >> 4) * 2 + (c >> 5), rr = r & 15, cc = c & 31, ob = rr * 64 + cc * 2; return st * 1024 + (ob ^ (((ob >> 9) & 1) << 5)); }
__host__ __device__ __forceinline__ void stage_rc(int b, int& R, int& C) { const int st = b / 1024, sb = b % 1024, swz = sb ^ (((sb >> 9) & 1) << 5); R = (st >> 1) * 16 + swz / 64; C = (st & 1) * 32 + (swz % 64) / 2; }
__host__ __device__ __forceinline__ int perm32(int rho) { const int n = rho >> 4, i = rho & 15; return 8 * (i >> 2) + 4 * n + (i & 3); }

struct Unit { int pm, pn; };
struct Gemm { const bf16_t* A; const bf16_t* Bt; int M, N, K; int ksub = 0; };

struct StaticOrder {
    int nM, nN, nwg, G, c;
    __host__ __device__ void init(int M, int N, int G_, int c_) { nM = M / BM; nN = N / BM; nwg = nM * nN; G = G_; c = c_; }
    __host__ __device__ bool next(int i, Unit& u) const {
        const long L = (long)i * G + c; if (L >= nwg) return false;
        int wgid = (int)L; { const int q = nwg / NXCD, r = nwg % NXCD, xcd = wgid % NXCD, off = wgid / NXCD; wgid = (xcd < r ? xcd * (q + 1) : r * (q + 1) + (xcd - r) * q) + off; }
        const int nig = WGM * nN, gid = wgid / nig, fm = gid * WGM, gsz = (nM - fm) < WGM ? (nM - fm) : WGM;
        u.pm = fm + ((wgid % nig) % gsz); u.pn = (wgid % nig) / gsz; return true;
    }
    __device__ __forceinline__ void a_ready(const Unit&) const {}
    __device__ __forceinline__ void done(const Unit&) const {}
};


template <class Epi, class Sched, bool ALIGN_EPI = false, bool SP2 = false>
__device__ __forceinline__ void gemm_phase(PG8_LAS unsigned char* lds, const Gemm g, const Sched& S, const Epi& E, const int tid) {
    const int wid = __builtin_amdgcn_readfirstlane(tid >> 6), lane = tid & 63, wr = wid >> 2, wc = wid & 3, fr = lane & 15, fq = lane >> 4;
    const int K = g.K, nt = (g.ksub ? g.ksub : K) / BK;
#define PG8_KOF(u) (g.ksub ? (size_t)((u).pn & 1) * (size_t)g.ksub * 2 : (size_t)0)
    unsigned voffA[2], voffB[2];
#pragma unroll
    for (int i = 0; i < 2; ++i) { int R, C; stage_rc(tid * 16 + i * 8192, R, C); const int Rb = Epi::PERM ? ((R & ~31) + perm32(R & 31)) : R;
        voffA[i] = (unsigned)(R * K + C) * 2u; voffB[i] = (unsigned)(Rb * K + C) * 2u; }
    const size_t kstep = (size_t)(BK * 2);
    const size_t hstep = (size_t)HALF * K * 2;
    const size_t tstep = 2 * hstep;
    const unsigned ldsw = (unsigned)wid * 1024u;
    const int aoff = lds_byte(wr * 64 + fr, fq * 8), boff = lds_byte(wc * 32 + fr, fq * 8);
#define PG8_SA(b, h) (((b) * 2 + (h)) * HTB)
#define PG8_SB(b, h) ((4 + (b) * 2 + (h)) * HTB)
#define PG8_STAGE(bufoff, gbase, voff) do { _Pragma("unroll") for (int _i = 0; _i < 2; ++_i) \
        __builtin_amdgcn_global_load_lds((const unsigned*)((const char*)(gbase) + (voff)[_i]), (PG8_LAS unsigned*)(lds + (bufoff) + ldsw + _i * 8192), 16, 0, 0); } while (0)
#define PG8_LDA(dst, b, h) do { _Pragma("unroll") for (int m = 0; m < 4; ++m) _Pragma("unroll") for (int k = 0; k < 2; ++k) dst[m][k] = *(const PG8_LAS bf16x8*)(lds + PG8_SA(b, h) + aoff + m * 2048 + k * 1024); } while (0)
#define PG8_LDB(dst, b, h) do { _Pragma("unroll") for (int n = 0; n < 2; ++n) _Pragma("unroll") for (int k = 0; k < 2; ++k) dst[n][k] = *(const PG8_LAS bf16x8*)(lds + PG8_SB(b, h) + boff + n * 2048 + k * 1024); } while (0)
#define PG8_MMA(ai, bj, At, Bt) do { __builtin_amdgcn_s_setprio(1); _Pragma("unroll") for (int m = 0; m < 4; ++m) _Pragma("unroll") for (int n = 0; n < 2; ++n) _Pragma("unroll") for (int k = 0; k < 2; ++k) \
        acc[ai][bj][m][n] = __builtin_amdgcn_mfma_f32_16x16x32_bf16(Bt[n][k], At[m][k], acc[ai][bj][m][n], 0, 0, 0); __builtin_amdgcn_s_setprio(0); } while (0)
#define PG8_WAIT_V(n) asm volatile("s_waitcnt vmcnt(" #n ")" ::: "memory")
#define PG8_WAIT_L(n) asm volatile("s_waitcnt lgkmcnt(" #n ")" ::: "memory")
#define PG8_BAR __builtin_amdgcn_s_barrier()
#define PG8_SCHED __builtin_amdgcn_sched_barrier(0)
    Unit cur, nxt; int ui = 0;
    if (!S.next(0, cur)) return;
    f32x4 acc[2][2][4][2];
#pragma unroll
    for (int a = 0; a < 2; ++a)
#pragma unroll
        for (int b = 0; b < 2; ++b)
#pragma unroll
            for (int m = 0; m < 4; ++m)
#pragma unroll
                for (int n = 0; n < 2; ++n) acc[a][b][m][n] = (f32x4){0.f, 0.f, 0.f, 0.f};
    bf16x8 At[4][2], B0[2][2], B1[2][2];
    const char* cA = (const char*)g.A + (size_t)cur.pm * tstep + PG8_KOF(cur); const char* cB = (const char*)g.Bt + (size_t)cur.pn * tstep + PG8_KOF(cur);
    S.a_ready(cur);
    if constexpr (SP2) {
        PG8_STAGE(PG8_SB(0, 0), cB, voffB); PG8_STAGE(PG8_SB(0, 1), cB + hstep, voffB); PG8_STAGE(PG8_SA(0, 0), cA, voffA); PG8_STAGE(PG8_SA(0, 1), cA + hstep, voffA);
        if (wr == 1) PG8_BAR;
        PG8_WAIT_V(2); PG8_BAR;
        PG8_STAGE(PG8_SB(1, 0), cB + kstep, voffB); PG8_STAGE(PG8_SA(1, 0), cA + kstep, voffA); PG8_STAGE(PG8_SB(1, 1), cB + hstep + kstep, voffB);
        PG8_WAIT_V(6); PG8_BAR;
    } else {
        PG8_STAGE(PG8_SB(0, 0), cB, voffB); PG8_STAGE(PG8_SA(0, 0), cA, voffA); PG8_STAGE(PG8_SB(0, 1), cB + hstep, voffB); PG8_STAGE(PG8_SA(0, 1), cA + hstep, voffA);
        if (wr == 1) PG8_BAR;
        PG8_WAIT_V(4); PG8_BAR;
        PG8_STAGE(PG8_SB(1, 0), cB + kstep, voffB); PG8_STAGE(PG8_SA(1, 0), cA + kstep, voffA); PG8_STAGE(PG8_SB(1, 1), cB + hstep + kstep, voffB);
        PG8_WAIT_V(6); PG8_BAR;
    }
    for (;;) {
        const bool has_next = S.next(ui + 1, nxt);
        const char* nA = has_next ? (const char*)g.A + (size_t)nxt.pm * tstep + PG8_KOF(nxt) : cA; const char* nB = has_next ? (const char*)g.Bt + (size_t)nxt.pn * tstep + PG8_KOF(nxt) : cB;
        for (int t = 0; t < nt; t += 2) {
            const bool last = (t == nt - 2);
            const char* a1 = cA + (size_t)(t + 1) * kstep;
            const char* a2 = last ? nA : cA + (size_t)(t + 2) * kstep; const char* b2 = last ? nB : cB + (size_t)(t + 2) * kstep;
            const char* a3 = a2 + kstep; const char* b3 = b2 + kstep;
            if (last && has_next) S.a_ready(nxt);
            if constexpr (SP2) {
            PG8_LDB(B0, 0, 0); PG8_LDB(B1, 0, 1); PG8_SCHED; PG8_LDA(At, 0, 0); PG8_STAGE(PG8_SA(1, 1), a1 + hstep, voffA);
            PG8_WAIT_V(8); PG8_WAIT_L(0); PG8_BAR; PG8_MMA(0, 0, At, B0); PG8_MMA(0, 1, At, B1); PG8_BAR; PG8_SCHED;
            PG8_LDA(At, 0, 1); PG8_STAGE(PG8_SB(0, 0), b2, voffB); PG8_STAGE(PG8_SB(0, 1), b2 + hstep, voffB); PG8_STAGE(PG8_SA(0, 0), a2, voffA);
            PG8_WAIT_V(8); PG8_WAIT_L(0); PG8_BAR; PG8_MMA(1, 0, At, B0); PG8_MMA(1, 1, At, B1); PG8_BAR; PG8_SCHED;
            PG8_LDB(B0, 1, 0); PG8_LDB(B1, 1, 1); PG8_SCHED; PG8_LDA(At, 1, 0); PG8_STAGE(PG8_SA(0, 1), a2 + hstep, voffA);
            PG8_WAIT_V(8); PG8_WAIT_L(0); PG8_BAR; PG8_MMA(0, 0, At, B0); PG8_MMA(0, 1, At, B1); PG8_BAR; PG8_SCHED;
            PG8_LDA(At, 1, 1); PG8_STAGE(PG8_SB(1, 0), b3, voffB); PG8_STAGE(PG8_SB(1, 1), b3 + hstep, voffB); PG8_STAGE(PG8_SA(1, 0), a3, voffA);
            PG8_WAIT_V(8); PG8_WAIT_L(0); PG8_BAR; PG8_MMA(1, 0, At, B0); PG8_MMA(1, 1, At, B1); PG8_BAR; PG8_SCHED;
            } else {
            PG8_LDB(B0, 0, 0); PG8_SCHED; PG8_LDA(At, 0, 0); PG8_STAGE(PG8_SA(1, 1), a1 + hstep, voffA);
            PG8_WAIT_L(8); PG8_BAR; PG8_WAIT_L(0); PG8_MMA(0, 0, At, B0); PG8_BAR; PG8_SCHED;
            PG8_LDB(B1, 0, 1); PG8_STAGE(PG8_SB(0, 0), b2, voffB);
            PG8_BAR; PG8_WAIT_L(0); PG8_MMA(0, 1, At, B1); PG8_BAR;
            PG8_LDA(At, 0, 1); PG8_STAGE(PG8_SA(0, 0), a2, voffA);
            PG8_BAR; PG8_WAIT_L(0); PG8_MMA(1, 0, At, B0); PG8_BAR; PG8_SCHED;
            PG8_STAGE(PG8_SB(0, 1), b2 + hstep, voffB);
            PG8_WAIT_V(6); PG8_BAR; PG8_MMA(1, 1, At, B1); PG8_BAR;
            PG8_LDB(B0, 1, 0); PG8_SCHED; PG8_LDA(At, 1, 0); PG8_STAGE(PG8_SA(0, 1), a2 + hstep, voffA);
            PG8_WAIT_L(8); PG8_BAR; PG8_WAIT_L(0); PG8_MMA(0, 0, At, B0); PG8_BAR; PG8_SCHED;
            PG8_LDB(B1, 1, 1); PG8_STAGE(PG8_SB(1, 0), b3, voffB);
            PG8_BAR; PG8_WAIT_L(0); PG8_MMA(0, 1, At, B1); PG8_BAR;
            PG8_LDA(At, 1, 1); PG8_STAGE(PG8_SA(1, 0), a3, voffA);
            PG8_BAR; PG8_WAIT_L(0); PG8_MMA(1, 0, At, B0); PG8_BAR; PG8_SCHED;
            PG8_STAGE(PG8_SB(1, 1), b3 + hstep, voffB);
            PG8_WAIT_V(6); PG8_BAR; PG8_MMA(1, 1, At, B1); PG8_BAR;
            }
        }
        if constexpr (ALIGN_EPI) { if (wr == 0) PG8_BAR; }
        if constexpr (!Epi::AFTER_DRAIN) { E(acc, cur, wr, wc, fr, fq); S.done(cur); }
        if (!has_next) break;
#pragma unroll
        for (int a = 0; a < 2; ++a)
#pragma unroll
            for (int b = 0; b < 2; ++b)
#pragma unroll
                for (int m = 0; m < 4; ++m)
#pragma unroll
                    for (int n = 0; n < 2; ++n) acc[a][b][m][n] = (f32x4){0.f, 0.f, 0.f, 0.f};
        cur = nxt; cA = nA; cB = nB; ++ui;
        if constexpr (ALIGN_EPI) { if (wr == 1) PG8_BAR; }
    }
    PG8_WAIT_V(0);
    if constexpr (!ALIGN_EPI) { if (wr == 0) PG8_BAR; }
    PG8_BAR;
    if constexpr (Epi::AFTER_DRAIN) { E.fused(acc, cur, wr, wc, fr, fq, lds, wid, lane); S.done(cur); }
#undef PG8_KOF
#undef PG8_SA
#undef PG8_SB
#undef PG8_STAGE
#undef PG8_LDA
#undef PG8_LDB
#undef PG8_MMA
#undef PG8_WAIT_V
#undef PG8_WAIT_L
#undef PG8_BAR
#undef PG8_SCHED
}
}


struct FastProj {
    static constexpr bool PERM = true, AFTER_DRAIN = false; ProjEpi e; LAS unsigned char* xl;
    __device__ __forceinline__ void operator()(const f32x4 (&acc)[2][2][4][2], const pg8::Unit& u, int wr, int wc, int fr, int fq) const {
        asm volatile("" : "+v"(fr), "+v"(fq));
        LAS float* HS = (LAS float*)xl;
        LAS float* GL = (LAS float*)(xl + 8192);
        const int lrow0 = u.pm * 256 + wr * 64 + fr, grow0 = e.row_off + lrow0, bi = row_bi(e.row_off + u.pm * 256), col0 = u.pn * 256 + wc * 32 + 8 * fq, lane = fq * 16 + fr;
        const int gtile = e.tile0 + u.pn, hsub = wc >> 1, half = wc & 1, tid = (wr * 4 + wc) * 64 + lane;
        const bool qkv = gtile < 3, isq = gtile < 2;
        float rsv[2][4];
        { f32x4 sv[2][4];
#pragma unroll
          for (int ai = 0; ai < 2; ++ai)
#pragma unroll
              for (int m = 0; m < 4; ++m) sv[ai][m] = *(const f32x4*)(e.stats + (size_t)(grow0 + ai * 128 + m * 16) * 16 + fq * 4);
          if (tid < 128) GL[tid] = tid < 64 ? e.gq[tid] : e.gk[tid - 64];
#pragma unroll
          for (int ai = 0; ai < 2; ++ai)
#pragma unroll
              for (int m = 0; m < 4; ++m) { float s = (sv[ai][m].x + sv[ai][m].y) + (sv[ai][m].z + sv[ai][m].w); s += shx(s, 16, lane); s += shx(s, 32, lane); rsv[ai][m] = rsqrtf(s * (1.0f / DM) + EPS); } }
        f32x4 bv[2][2];
#pragma unroll
        for (int bj = 0; bj < 2; ++bj)
#pragma unroll
            for (int n = 0; n < 2; ++n) bv[bj][n] = *(const f32x4*)(e.bias + (size_t)bi * e.ldb + col0 + bj * 128 + 4 * n);
        if (qkv) {
#pragma unroll
            for (int ai = 0; ai < 2; ++ai)
#pragma unroll
                for (int m = 0; m < 4; ++m)
#pragma unroll
                    for (int bj = 0; bj < 2; ++bj) { const f32x4 v0 = acc[ai][bj][m][0] * rsv[ai][m] + bv[bj][0], v1 = acc[ai][bj][m][1] * rsv[ai][m] + bv[bj][1];
                        float q = ((v0.x * v0.x + v0.y * v0.y) + (v0.z * v0.z + v0.w * v0.w)) + ((v1.x * v1.x + v1.y * v1.y) + (v1.z * v1.z + v1.w * v1.w));
                        q += shx(q, 16, lane); q += shx(q, 32, lane);
                        if (fq == 0) HS[((ai * 128 + wr * 64 + m * 16 + fr) * 4 + 2 * bj + hsub) * 2 + half] = q; }
        }
        asm volatile("s_waitcnt lgkmcnt(0)" ::: "memory"); __builtin_amdgcn_s_barrier(); asm volatile("" ::: "memory");
        const int ib = 16 * half + 4 * fq;
#pragma unroll
        for (int ai = 0; ai < 2; ++ai)
#pragma unroll
            for (int m = 0; m < 4; ++m) { int grow = grow0 + ai * 128 + m * 16, hrow = ai * 128 + wr * 64 + m * 16 + fr, lrow = lrow0 + ai * 128 + m * 16;
                asm volatile("" : "+v"(grow), "+v"(hrow), "+v"(lrow));
                const float rs = rsv[ai][m];
                if (!qkv) {
                    bf16* rowp = e.Cout + (size_t)lrow * e.ldc + col0;
#pragma unroll
                    for (int bj = 0; bj < 2; ++bj) { const f32x4 v0 = acc[ai][bj][m][0] * rs + bv[bj][0], v1 = acc[ai][bj][m][1] * rs + bv[bj][1];
                        v4u w; w.x = pk2(v0.x, v0.y); w.y = pk2(v0.z, v0.w); w.z = pk2(v1.x, v1.y); w.w = pk2(v1.z, v1.w); *(v4u*)(rowp + bj * 128) = w; }
                } else {
                    const bool lat = grow < M_LAT; const int t = grow & 4095, pos = half ? (t & 63) : (t >> 6);
                    const f32x4 cs = *(const f32x4*)(e.ropeT + pos * 16 + 4 * fq), sn = *(const f32x4*)(e.ropeT + 1024 + pos * 16 + 4 * fq);
                    int b, kpos; if (lat) { b = grow >> 12; kpos = t; } else { const int mc = grow - M_LAT; b = mc >> 8; kpos = SEQ + (mc & 255); }
#pragma unroll
                    for (int bj = 0; bj < 2; ++bj) { const bool isv = (!isq) && (bj == 1);
                        const f32x2 hp = *(const LAS f32x2*)(HS + (hrow * 4 + 2 * bj + hsub) * 2); const float rinv = rsqrtf((hp.x + hp.y) * (1.0f / 64.0f) + EPS);
                        const int gsel = (isq ? 0 : 64);
                        const f32x4 ga = *(const LAS f32x4*)(GL + gsel + ib), gb = *(const LAS f32x4*)(GL + gsel + 32 + ib);
                        float o[8];
#pragma unroll
                        for (int n = 0; n < 2; ++n) { const f32x4 v = acc[ai][bj][m][n] * rs + bv[bj][n];
                            float a1 = v.x * rinv * ga[2 * n], a2 = v.y * rinv * gb[2 * n], b1 = v.z * rinv * ga[2 * n + 1], b2 = v.w * rinv * gb[2 * n + 1];
                            if (lat) { const float c0 = cs[2 * n], s0 = sn[2 * n], c1 = cs[2 * n + 1], s1 = sn[2 * n + 1];
                                const float ta = a1 * c0 - a2 * s0, tb = a1 * s0 + a2 * c0, tc = b1 * c1 - b2 * s1, td = b1 * s1 + b2 * c1; a1 = ta; a2 = tb; b1 = tc; b2 = td; }
                            const float sc = isq ? C2 : 1.0f;
                            o[4 * n] = isv ? v.x : a1 * sc; o[4 * n + 1] = isv ? v.y : a2 * sc; o[4 * n + 2] = isv ? v.z : b1 * sc; o[4 * n + 3] = isv ? v.w : b2 * sc; }
                        v4u w; w.x = pk2(o[0], o[1]); w.y = pk2(o[2], o[3]); w.z = pk2(o[4], o[5]); w.w = pk2(o[6], o[7]);
                        bf16* dq = e.MIX + (size_t)grow * DM + (gtile * 4 + 2 * bj + hsub) * 64 + 32 * half + 8 * fq;
                        bf16* dkv = (isv ? e.VB : e.KB) + ((size_t)b * KVROWS + kpos) * KVP + hsub * 64 + 32 * half + 8 * fq;
                        *(v4u*)(isq ? dq : dkv) = w; }
                }
                asm volatile("" ::: "memory"); __builtin_amdgcn_sched_barrier(0);
            }
    }
};
template <bool XIN_F32> struct FastRes {
    static constexpr bool PERM = true, AFTER_DRAIN = false; ResEpi e;
    __device__ __forceinline__ void operator()(const f32x4 (&acc)[2][2][4][2], const pg8::Unit& u, int wr, int wc, int fr, int fq) const {
        asm volatile("" : "+v"(fr), "+v"(fq));
        const int pmg = e.pm_off + u.pm, grow0 = pmg * 256 + wr * 64 + fr, bi = row_bi(pmg * 256), col8 = u.pn * 256 + wc * 32 + 8 * fq, lane = fq * 16 + fr;
        f32x4 gt[2][2], gg[2][2], gc[2][2], xf[2][2][2]; v4u xb[2][2];
#pragma unroll
        for (int bj = 0; bj < 2; ++bj) {
#pragma unroll
            for (int n = 0; n < 2; ++n) { const int c = col8 + bj * 128 + 4 * n; gt[bj][n] = *(const f32x4*)(e.gate + (size_t)bi * 6144 + c);
                gg[bj][n] = *(const f32x4*)(e.gn + c); gc[bj][n] = *(const f32x4*)(e.cn + (size_t)bi * 6144 + c);
                if (XIN_F32) xf[0][bj][n] = *(const f32x4*)(e.xi_row(grow0) + c); }
            if (!XIN_F32) xb[0][bj] = *(const v4u*)(e.XR + (size_t)grow0 * DM + col8 + bj * 128); }
#pragma unroll
        for (int bj = 0; bj < 2; ++bj)
#pragma unroll
            for (int n = 0; n < 2; ++n) gg[bj][n] = gg[bj][n] * (gc[bj][n] + 1.0f);
#pragma unroll
        for (int g = 0; g < 8; ++g) { const int ai = g >> 2, m = g & 3, grow = grow0 + ai * 128 + m * 16; float ss = 0.f;
            const int aprow = e.ap_perm ? (grow & ~63) + 16 * (grow & 3) + ((grow & 63) >> 2) : grow;
            if (g < 7) { const int grow1 = grow0 + ((g + 1) >> 2) * 128 + ((g + 1) & 3) * 16;
#pragma unroll
                for (int bj = 0; bj < 2; ++bj) {
                    if (XIN_F32) {
#pragma unroll
                        for (int n = 0; n < 2; ++n) xf[(g + 1) & 1][bj][n] = *(const f32x4*)(e.xi_row(grow1) + col8 + bj * 128 + 4 * n); }
                    else xb[(g + 1) & 1][bj] = *(const v4u*)(e.XR + (size_t)grow1 * DM + col8 + bj * 128); } }
#pragma unroll
            for (int bj = 0; bj < 2; ++bj) { f32x4 x0, x1;
                if (XIN_F32) { x0 = xf[g & 1][bj][0]; x1 = xf[g & 1][bj][1]; }
                else { const v4u w = xb[g & 1][bj]; x0 = (f32x4){bflo(w.x), bfhi(w.x), bflo(w.y), bfhi(w.y)}; x1 = (f32x4){bflo(w.z), bfhi(w.z), bflo(w.w), bfhi(w.w)}; }
                const f32x4 v0 = x0 + gt[bj][0] * acc[ai][bj][m][0], v1 = x1 + gt[bj][1] * acc[ai][bj][m][1];
                ss += ((v0.x * v0.x + v0.y * v0.y) + (v0.z * v0.z + v0.w * v0.w)) + ((v1.x * v1.x + v1.y * v1.y) + (v1.z * v1.z + v1.w * v1.w));
                v4u xo; xo.x = pk2(v0.x, v0.y); xo.y = pk2(v0.z, v0.w); xo.z = pk2(v1.x, v1.y); xo.w = pk2(v1.z, v1.w);
                *(v4u*)(e.XR + (size_t)grow * DM + col8 + bj * 128) = xo;
                if (e.has_ap) { const f32x4 a0 = v0 * gg[bj][0], a1 = v1 * gg[bj][1]; v4u w; w.x = pk2(a0.x, a0.y); w.y = pk2(a0.z, a0.w); w.z = pk2(a1.x, a1.y); w.w = pk2(a1.z, a1.w);
                    *(v4u*)(e.AP + (size_t)aprow * DM + col8 + bj * 128) = w; } }
            ss += shx(ss, 16, lane); ss += shx(ss, 32, lane);
            if (fq == 0) e.stats[(size_t)grow * 16 + u.pn * 4 + wc] = ss;
            asm volatile("" ::: "memory");
        }
    }
};

constexpr int CW_FIN = 8192;
struct FastResFinal {
    static constexpr bool PERM = true, AFTER_DRAIN = false; ResEpi e; const float* gfin; float* outp; float* XB; unsigned* ctl; LAS unsigned char* xl;
    __device__ __forceinline__ void operator()(f32x4 (&acc)[2][2][4][2], const pg8::Unit& u, int wr, int wc, int fr, int fq) const {
        asm volatile("" : "+v"(fr), "+v"(fq));
        LAS float* PL = (LAS float*)xl; LAS float* RS = (LAS float*)(xl + 4096);
        const int grow0 = u.pm * 256 + wr * 64 + fr, bi = row_bi(u.pm * 256), col8 = u.pn * 256 + wc * 32 + 8 * fq, tid = (wr * 4 + wc) * 64 + fq * 16 + fr, lane = fq * 16 + fr;
        f32x4 gt[2][2]; v4u xb[2][2];
#pragma unroll
        for (int bj = 0; bj < 2; ++bj) {
#pragma unroll
            for (int n = 0; n < 2; ++n) gt[bj][n] = *(const f32x4*)(e.gate + (size_t)bi * 6144 + col8 + bj * 128 + 4 * n);
            xb[0][bj] = *(const v4u*)(e.XR + (size_t)grow0 * DM + col8 + bj * 128); }
#pragma unroll
        for (int g = 0; g < 8; ++g) { const int ai = g >> 2, m = g & 3; float ss = 0.f;
            if (g < 7) { const int grow1 = grow0 + ((g + 1) >> 2) * 128 + ((g + 1) & 3) * 16;
#pragma unroll
                for (int bj = 0; bj < 2; ++bj) xb[(g + 1) & 1][bj] = *(const v4u*)(e.XR + (size_t)grow1 * DM + col8 + bj * 128); }
#pragma unroll
            for (int bj = 0; bj < 2; ++bj) { const v4u w = xb[g & 1][bj];
                const f32x4 x0 = (f32x4){bflo(w.x), bfhi(w.x), bflo(w.y), bfhi(w.y)}, x1 = (f32x4){bflo(w.z), bfhi(w.z), bflo(w.w), bfhi(w.w)};
                const f32x4 v0 = x0 + gt[bj][0] * acc[ai][bj][m][0], v1 = x1 + gt[bj][1] * acc[ai][bj][m][1]; acc[ai][bj][m][0] = v0; acc[ai][bj][m][1] = v1;
                ss += ((v0.x * v0.x + v0.y * v0.y) + (v0.z * v0.z + v0.w * v0.w)) + ((v1.x * v1.x + v1.y * v1.y) + (v1.z * v1.z + v1.w * v1.w)); }
            ss += shx(ss, 16, lane); ss += shx(ss, 32, lane);
            if (fq == 0) PL[(ai * 128 + wr * 64 + m * 16 + fr) * 4 + wc] = ss;
            asm volatile("" ::: "memory"); }
        asm volatile("s_waitcnt lgkmcnt(0)" ::: "memory"); __builtin_amdgcn_s_barrier(); asm volatile("" ::: "memory");
        if (tid < 256) { const f32x4 p = *(const LAS f32x4*)(PL + tid * 4); const float s = (p.x + p.y) + (p.z + p.w);
            __hip_atomic_store(XB + (size_t)(u.pm * 256 + tid) * 4 + u.pn, s, __ATOMIC_RELAXED, __HIP_MEMORY_SCOPE_AGENT); }
        asm volatile("s_waitcnt vmcnt(0)" ::: "memory"); __builtin_amdgcn_s_barrier(); asm volatile("" ::: "memory");
        if (tid == 0) __hip_atomic_fetch_add(ctl + CW_FIN + 64 * u.pm, 1u, __ATOMIC_RELAXED, __HIP_MEMORY_SCOPE_AGENT);
        if (tid < 64) { unsigned sp = 0;
            while ((unsigned)__builtin_amdgcn_readfirstlane((int)__hip_atomic_load(ctl + CW_FIN + 64 * u.pm, __ATOMIC_RELAXED, __HIP_MEMORY_SCOPE_AGENT)) < 4u) { __builtin_amdgcn_s_sleep(2); if (++sp > (1u << 22)) break; }
            __builtin_amdgcn_fence(__ATOMIC_ACQUIRE, "agent"); asm volatile("s_waitcnt vmcnt(0)" ::: "memory"); }
        asm volatile("" ::: "memory"); __builtin_amdgcn_s_barrier(); asm volatile("" ::: "memory");
        if (tid < 256) { const float* xbp = XB + (size_t)(u.pm * 256 + tid) * 4; float t = 0.f;
#pragma unroll
            for (int p = 0; p < 4; ++p) t += __hip_atomic_load(xbp + p, __ATOMIC_RELAXED, __HIP_MEMORY_SCOPE_AGENT);
            RS[tid] = rsqrtf(t * (1.0f / DM) + EPS); }
        asm volatile("s_waitcnt lgkmcnt(0)" ::: "memory"); __builtin_amdgcn_s_barrier(); asm volatile("" ::: "memory");
        f32x4 gf[2][2];
#pragma unroll
        for (int bj = 0; bj < 2; ++bj)
#pragma unroll
            for (int n = 0; n < 2; ++n) gf[bj][n] = *(const f32x4*)(gfin + col8 + bj * 128 + 4 * n);
#pragma unroll
        for (int g = 0; g < 8; ++g) { const int ai = g >> 2, m = g & 3, grow = grow0 + ai * 128 + m * 16; const float rs = RS[ai * 128 + wr * 64 + m * 16 + fr]; float* xn = outp + (size_t)grow * DM + col8;
#pragma unroll
            for (int bj = 0; bj < 2; ++bj)
#pragma unroll
                for (int n = 0; n < 2; ++n) *(f32x4*)(xn + bj * 128 + 4 * n) = acc[ai][bj][m][n] * rs * gf[bj][n]; }
    }
};

__device__ __forceinline__ unsigned dpp_ror1(unsigned v) { return (unsigned)__builtin_amdgcn_update_dpp(0, (int)v, 0x121, 0xf, 0xf, false); }
__device__ __forceinline__ unsigned dpp_ror15(unsigned v) { return (unsigned)__builtin_amdgcn_update_dpp(0, (int)v, 0x12F, 0xf, 0xf, false); }
struct FastUpConv {
    static constexpr bool PERM = true, AFTER_DRAIN = false;
    bf16* ACT; bf16* EDGE; const float* stats; const float* bias; const float* cw; LAS unsigned char* xl;
    static __device__ __forceinline__ float ror1f(float v) { return __int_as_float(__builtin_amdgcn_mov_dpp(__float_as_int(v), 0x121, 0xf, 0xf, false)); }
    static __device__ __forceinline__ float shr1_old(float old, float v) { return __int_as_float(__builtin_amdgcn_update_dpp(__float_as_int(old), __float_as_int(v), 0x111, 0xf, 0xf, false)); }
    static __device__ __forceinline__ float shl1_old(float old, float v) { return __int_as_float(__builtin_amdgcn_update_dpp(__float_as_int(old), __float_as_int(v), 0x101, 0xf, 0xf, false)); }
    static __device__ __forceinline__ float sg_(float g2, float u2) { return g2 * u2 * __builtin_amdgcn_rcpf(1.0f + __builtin_amdgcn_exp2f(g2)); }
    static __device__ __forceinline__ float ror15f(float v) { return __int_as_float(__builtin_amdgcn_mov_dpp(__float_as_int(v), 0x12F, 0xf, 0xf, false)); }
    __device__ __forceinline__ void operator()(f32x4 (&acc)[2][2][4][2], const pg8::Unit& u, int wr, int wc, int fr, int fq) const {
        asm volatile("" : "+v"(fr), "+v"(fq));
        LAS float* EX = (LAS float*)xl; LAS float* RS = (LAS float*)(xl + 8192); LAS float* CT = (LAS float*)(xl + 9216);
        const int trow0 = wr * 64 + 4 * fr;
        const int bi = row_bi(u.pm * 256), j0 = u.pn * 128 + wc * 32 + 8 * fq, tid = (wr * 4 + wc) * 64 + fq * 16 + fr;
        const int ct0 = wc * 32 + 8 * fq;
        { const int which = (wr * 4 + wc) >> 1  , c = (tid * 2) & 255, col = (c >> 7) * DFF + u.pn * 128 + (c & 127);
          const f32x2 vb = *(const f32x2*)(bias + (size_t)bi * NUP + col), vw = *(const f32x2*)(cw + (size_t)(which > 0 ? which - 1 : 0) * NUP + col);
          const float csc = (c >> 7) ? -1.4426950408889634f : -0.6931471805599453f;
          const f32x2 v = which == 0 ? vb : vw * csc;
          if (tid < 256) { const f32x4* sp = (const f32x4*)(stats + (size_t)(u.pm * 256 + tid) * 16); const f32x4 a = sp[0], b = sp[1], c4 = sp[2], d = sp[3];
              const float s = ((a.x + a.y) + (a.z + a.w)) + ((b.x + b.y) + (b.z + b.w)) + ((c4.x + c4.y) + (c4.z + c4.w)) + ((d.x + d.y) + (d.z + d.w));
              RS[tid] = rsqrtf(s * (1.0f / DM) + EPS); }
          *(LAS f32x2*)(CT + which * 256 + c) = v; }
        asm volatile("s_waitcnt lgkmcnt(0)" ::: "memory"); __builtin_amdgcn_s_barrier(); asm volatile("" ::: "memory");
        { f32x4 bv[2][2];
#pragma unroll
          for (int bj = 0; bj < 2; ++bj)
#pragma unroll
              for (int n = 0; n < 2; ++n) bv[bj][n] = *(const LAS f32x4*)(CT + bj * 128 + ct0 + 4 * n);
#pragma unroll
          for (int ai = 0; ai < 2; ++ai) { const f32x4 rs4 = *(const LAS f32x4*)(RS + ai * 128 + trow0);
#pragma unroll
              for (int m = 0; m < 4; ++m)
#pragma unroll
                  for (int bj = 0; bj < 2; ++bj)
#pragma unroll
                      for (int n = 0; n < 2; ++n) acc[ai][bj][m][n] = acc[ai][bj][m][n] * rs4[m] + bv[bj][n]; } }
#pragma unroll
        for (int ai = 0; ai < 2; ++ai) { const int s = 2 * ai + wr;
#pragma unroll
            for (int bj = 0; bj < 2; ++bj)
#pragma unroll
                for (int n = 0; n < 2; ++n) {
                    if (fr == 0) *(LAS f32x4*)(EX + ((s * 2 + 0) * 4 + wc) * 64 + (bj * 2 + n) * 16 + fq * 4) = acc[ai][bj][0][n];
                    if (fr == 15) *(LAS f32x4*)(EX + ((s * 2 + 1) * 4 + wc) * 64 + (bj * 2 + n) * 16 + fq * 4) = acc[ai][bj][3][n]; } }
        if (wr == 0 && fr == 0) {
#pragma unroll
            for (int m = 0; m < 2; ++m)
#pragma unroll
                for (int bj = 0; bj < 2; ++bj)
#pragma unroll
                    for (int n = 0; n < 2; ++n) { const f32x4 v = acc[0][bj][m][n]; v2u w; w.x = pk2(v.x, v.y); w.y = pk2(v.z, v.w); *(v2u*)(EDGE + (size_t)(u.pm * 4 + m) * NUP + bj * DFF + j0 + 4 * n) = w; } }
        if (wr == 1 && fr == 15) {
#pragma unroll
            for (int m = 2; m < 4; ++m)
#pragma unroll
                for (int bj = 0; bj < 2; ++bj)
#pragma unroll
                    for (int n = 0; n < 2; ++n) { const f32x4 v = acc[1][bj][m][n]; v2u w; w.x = pk2(v.x, v.y); w.y = pk2(v.z, v.w); *(v2u*)(EDGE + (size_t)(u.pm * 4 + m) * NUP + bj * DFF + j0 + 4 * n) = w; } }
        asm volatile("s_waitcnt lgkmcnt(0)" ::: "memory"); __builtin_amdgcn_s_barrier(); asm volatile("" ::: "memory");
#pragma unroll
        for (int ai = 0; ai < 2; ++ai) { const int s = 2 * ai + wr; v2u keep[4];
#pragma unroll
            for (int n = 0; n < 2; ++n) { f32x4 cv[2][4];
#pragma unroll
                for (int bj = 0; bj < 2; ++bj) {
                    const f32x4 top = *(const LAS f32x4*)(EX + (((ai == 0 ? 0 : s - 1) * 2 + 1) * 4 + wc) * 64 + (bj * 2 + n) * 16 + fq * 4);
                    const f32x4 bot = *(const LAS f32x4*)(EX + (((ai == 1 ? 3 : s + 1) * 2 + 0) * 4 + wc) * 64 + (bj * 2 + n) * 16 + fq * 4);
                    const f32x4 w0 = *(const LAS f32x4*)(CT + 1 * 256 + bj * 128 + ct0 + 4 * n), w1 = *(const LAS f32x4*)(CT + 2 * 256 + bj * 128 + ct0 + 4 * n), w2 = *(const LAS f32x4*)(CT + 3 * 256 + bj * 128 + ct0 + 4 * n);
                    f32x4 up0, dn3;
#pragma unroll
                    for (int k = 0; k < 4; ++k) { up0[k] = shr1_old(top[k], acc[ai][bj][3][n][k]); dn3[k] = shl1_old(bot[k], acc[ai][bj][0][n][k]); }
#pragma unroll
                    for (int m = 0; m < 4; ++m) { const f32x4 up = (m > 0) ? acc[ai][bj][m - 1][n] : up0, dn = (m < 3) ? acc[ai][bj][m + 1][n] : dn3;
                        cv[bj][m] = w0 * up + w1 * acc[ai][bj][m][n] + w2 * dn; } }
#pragma unroll
                for (int m = 0; m < 4; ++m) { v2u o; o.x = pk2(sg_(cv[1][m].x, cv[0][m].x), sg_(cv[1][m].y, cv[0][m].y)); o.y = pk2(sg_(cv[1][m].z, cv[0][m].z), sg_(cv[1][m].w, cv[0][m].w));
                    if (n == 0) keep[m] = o;
                    else { v4u w4; w4.x = keep[m].x; w4.y = keep[m].y; w4.z = o.x; w4.w = o.y; *(v4u*)(ACT + (size_t)(u.pm * 256 + ai * 128 + trow0 + m) * DFF + j0) = w4; } }
            } }
    }
};

template <int DSH> __device__ __forceinline__ float dpp_up(float v) { return __int_as_float(__builtin_amdgcn_mov_dpp(__float_as_int(v), 0x120 + (16 - DSH), 0xf, 0xf, false)); }
template <int DIR> __device__ __forceinline__ void aff_step(float& P, float& B, const float Ps, const float Bs) {
    if (DIR == 0) { B = Ps * B + Bs; P = P * Ps; } else { B = P * Bs + B; P = P * Ps; }
}
struct FastGates {
    static constexpr bool PERM = false, AFTER_DRAIN = false; GatesEpi e; LAS unsigned char* xl;
    __device__ __forceinline__ void operator()(const f32x4 (&acc)[2][2][4][2], const pg8::Unit& u, int wr, int wc, int fr, int fq) const {
        asm volatile("" : "+v"(fr), "+v"(fq));
        LAS float* PR = (LAS float*)xl;
        const int srow0 = u.pm * 256 + wr * 64 + fr;
        const int trow0 = u.pm * 256 + wr * 64 + 4 * fr;
        const int dir = u.pn >> 1, chb = (u.pn & 1) * 128, cl0 = wc * 32 + 4 * fq, ch0 = chb + cl0, tid = (wr * 4 + wc) * 64 + fq * 16 + fr;
        { const int which = (wr * 4 + wc) >> 1  , c = tid & 127;
          if (which < 3) { const int i = dir * 256 + chb + c; const float v0 = e.ba[i], v1 = e.bi_[i], v2 = e.spl[i] * (-8.0f * 1.4426950408889634f);
              PR[which * 128 + c] = which == 0 ? v0 * -1.4426950408889634f : which == 1 ? v1 * -1.4426950408889634f : v2; } }
        asm volatile("s_waitcnt lgkmcnt(0)" ::: "memory"); __builtin_amdgcn_s_barrier(); asm volatile("" ::: "memory");
#pragma unroll
        for (int ai = 0; ai < 2; ++ai) {
            v2u xr[4][2];
#pragma unroll
            for (int m = 0; m < 4; ++m)
#pragma unroll
                for (int n = 0; n < 2; ++n) xr[m][n] = *(const v2u*)(e.RC + (size_t)(srow0 + ai * 128 + m * 16) * 256 + ch0 + 16 * n);
#pragma unroll
            for (int n = 0; n < 2; ++n) {
                const f32x4 vba = *(const LAS f32x4*)(PR + cl0 + 16 * n), vbi = *(const LAS f32x4*)(PR + 128 + cl0 + 16 * n), vsp = *(const LAS f32x4*)(PR + 256 + cl0 + 16 * n);
                float Pa[4], Ba[4];
#pragma unroll
                for (int m = 0; m < 4; ++m) {
                    const v2u xw = xr[m][n]; const float xf[4] = {bflo(xw.x), bfhi(xw.x), bflo(xw.y), bfhi(xw.y)};
                    const f32x4 ya = acc[ai][0][m][n], yi = acc[ai][1][m][n];
                    v4u pw;
#pragma unroll
                    for (int k = 0; k < 4; ++k) { const float rg = __builtin_amdgcn_rcpf(1.0f + __builtin_amdgcn_exp2f(__builtin_fmaf(ya[k], -1.4426950408889634f, vba[k]))), ig = __builtin_amdgcn_rcpf(1.0f + __builtin_amdgcn_exp2f(__builtin_fmaf(yi[k], -1.4426950408889634f, vbi[k])));
                        const float la2 = bflo(pk2(rg * vsp[k], 0.f));
                        const float P = __builtin_amdgcn_exp2f(la2);
                        const float bb = __builtin_amdgcn_sqrtf(__builtin_fminf(__builtin_fmaxf(1.0f - P * P, 0.f), 1.0f)) * (ig * xf[k]);
                        const unsigned w = pk2(la2, bb); pw[k] = w; const float B = bfhi(w);
                        if (m == 0) { Pa[k] = P; Ba[k] = B; } else if (dir == 0) aff_step<0>(Pa[k], Ba[k], P, B); else aff_step<1>(Pa[k], Ba[k], P, B); }
                    *(v4u*)(e.LAB + ((size_t)dir * M_ALL + trow0 + ai * 128 + m) * 256 + ch0 + 16 * n) = pw;
                }
                if (dir == 0) {
#pragma unroll
                    for (int k = 0; k < 4; ++k) { aff_step<0>(Pa[k], Ba[k], dpp_up<1>(Pa[k]), dpp_up<1>(Ba[k])); aff_step<0>(Pa[k], Ba[k], dpp_up<2>(Pa[k]), dpp_up<2>(Ba[k]));
                        aff_step<0>(Pa[k], Ba[k], dpp_up<4>(Pa[k]), dpp_up<4>(Ba[k])); aff_step<0>(Pa[k], Ba[k], dpp_up<8>(Pa[k]), dpp_up<8>(Ba[k])); }
                } else {
#pragma unroll
                    for (int k = 0; k < 4; ++k) { aff_step<1>(Pa[k], Ba[k], dpp_up<1>(Pa[k]), dpp_up<1>(Ba[k])); aff_step<1>(Pa[k], Ba[k], dpp_up<2>(Pa[k]), dpp_up<2>(Ba[k]));
                        aff_step<1>(Pa[k], Ba[k], dpp_up<4>(Pa[k]), dpp_up<4>(Ba[k])); aff_step<1>(Pa[k], Ba[k], dpp_up<8>(Pa[k]), dpp_up<8>(Ba[k])); }
                }
                if (fr == 0) { const int s = 2 * ai + wr; int b, c; if (u.pm < 128) { b = u.pm >> 4; c = 4 + (u.pm & 15) * 4 + s; } else { b = u.pm - 128; c = s; }
                    const size_t o = ((size_t)(dir * NB + b) * NCHUNK + c) * 256 + ch0 + 16 * n;
                    *(f32x4*)(e.AGP + o) = (f32x4){Pa[0], Pa[1], Pa[2], Pa[3]}; *(f32x4*)(e.AGB + o) = (f32x4){Ba[0], Ba[1], Ba[2], Ba[3]}; }
                asm volatile("" ::: "memory"); __builtin_amdgcn_sched_barrier(0);
            }
        }
    }
};

struct GenOrder {
    pg8::StaticOrder map; int b1, s1, n1, b2, s2, n2;
    __device__ __forceinline__ void strided(int M, int N, int first, int stride) { map.init(M, N, 1, 0); b1 = first; s1 = stride; n1 = 1 << 20; b2 = 0; s2 = 0; n2 = 0; }
    __device__ __forceinline__ bool next(int i, pg8::Unit& u) const { int L; if (i < n1) L = b1 + i * s1; else if (i < n1 + n2) L = b2 + (i - n1) * s2; else return false; return map.next(L, u); }
    __device__ __forceinline__ void a_ready(const pg8::Unit&) const {}
    __device__ __forceinline__ void done(const pg8::Unit&) const {}
};
__device__ __forceinline__ void gemm_proj(const Ctx& C, const bf16* A, const bf16* Bt, int Mrows, int N, int K, const GenOrder& S, const ProjEpi& E) {
    pg8::Gemm g{A, Bt, Mrows, N, K}; FastProj F{E, C.lds + EXCH_OFF};
    pg8::gemm_phase<FastProj, GenOrder, true, true>(C.lds, g, S, F, C.tid);
}
template <bool XIN_F32> __device__ __forceinline__ void gemm_res(const Ctx& C, const bf16* A, const bf16* Bt, int Mrows, int K, const GenOrder& S, const ResEpi& E) {
    pg8::Gemm g{A, Bt, Mrows, DM, K}; FastRes<XIN_F32> F{E};
    pg8::gemm_phase<FastRes<XIN_F32>, GenOrder, true, true>(C.lds, g, S, F, C.tid);
}
__device__ __forceinline__ void gemm_res_final(const Ctx& C, const bf16* A, const bf16* Bt, int Mrows, int K, const GenOrder& S, const ResEpi& E) {
    pg8::Gemm g{A, Bt, Mrows, DM, K}; FastResFinal F{E, C.g_final, C.out, (float*)(C.ws + WS_AGP), (unsigned*)(C.ws + WS_CTL), C.lds + EXCH_OFF};
    pg8::gemm_phase<FastResFinal, GenOrder, true, true>(C.lds, g, S, F, C.tid);
}
__device__ __forceinline__ void gemm_gates(const Ctx& C, const bf16* A, const bf16* Bt, const GatesEpi& E) {
    pg8::Gemm g{A, Bt, M_ALL, 1024, 256, 128}; GenOrder S; S.strided(M_ALL, 1024, (int)blockIdx.x, C.G); FastGates F{E, C.lds + EXCH_OFF};
    pg8::gemm_phase<FastGates, GenOrder, true, true>(C.lds, g, S, F, C.tid);
}
__device__ __forceinline__ void gemm_upconv(const Ctx& C, int l, int Mrows) {
    pg8::Gemm g{(const bf16*)(C.ws + WS_AP), (const bf16*)(C.ws + WS_WUP + l * SZ_WUP), Mrows, NUP, DM}; GenOrder S; S.strided(Mrows, NUP, (int)blockIdx.x, C.G);
    FastUpConv F{(bf16*)(C.ws + WS_ACT), (bf16*)(C.ws + WS_EDGE), (const float*)(C.ws + WS_STB), (const float*)(C.ws + WS_BUP) + (size_t)l * 9 * NUP, C.ffn_conv_w + (size_t)l * 3 * NUP, C.lds + EXCH_OFF};
    pg8::gemm_phase<FastUpConv, GenOrder, true, true>(C.lds, g, S, F, C.tid);
}


typedef GAS unsigned gu32;
#define RLX_AGENT __ATOMIC_RELAXED, __HIP_MEMORY_SCOPE_AGENT
#define XB_TMO      128
#define XB_XCNT(j)  (256  + 64 * (j))
#define XB_XSUB(j)  (1280 + 64 * (j))
#define XB_XGEN(j)  (2304 + 64 * (j))
#define XB_TOP      3328
#define XB_TOPGEN   3392
#define XCD_BAR_WORDS 3456
#define XB_SPIN_CAP (1u << 18)

__device__ __forceinline__ unsigned xb_ld(unsigned* p)              { return __hip_atomic_load(p, __ATOMIC_RELAXED, __HIP_MEMORY_SCOPE_AGENT); }
__device__ __forceinline__ unsigned xb_add(unsigned* p, unsigned v) { return __hip_atomic_fetch_add(p, v, __ATOMIC_RELAXED, __HIP_MEMORY_SCOPE_AGENT); }
__device__ __forceinline__ unsigned xb_xcc_id() { return (unsigned)__builtin_amdgcn_s_getreg((3 << 11) | 20) & 0xFu; }
#define XB_SPIN(cond, bar) do { unsigned _sp = 0; while (cond) { __builtin_amdgcn_s_sleep(1); \
    if ((++_sp & 255u) == 0u) { if (xb_ld(&(bar)[XB_TMO])) break; if (_sp > XB_SPIN_CAP) { atomicAdd(&(bar)[XB_TMO], 1u); break; } } } } while (0)

struct XcdBarrier {
    int wave;
    unsigned* bar; unsigned x;
    volatile LAS unsigned* st;
};

__device__ __forceinline__ bool xb_leader(int wave) { return wave == 0 && __builtin_amdgcn_mbcnt_hi(~0u, __builtin_amdgcn_mbcnt_lo(~0u, 0u)) == 0u; }
__device__ __forceinline__ XcdBarrier xcd_barrier_post(unsigned* bar, volatile LAS unsigned* st, int wave) {
    XcdBarrier b; b.wave = wave; b.bar = bar; b.x = xb_xcc_id(); b.st = st;
    if (xb_leader(wave)) (void)xb_add(&bar[XB_XCNT(b.x)], 1u);
    return b;
}
__device__ __forceinline__ void xcd_barrier_complete(unsigned* bar, unsigned x, unsigned& nloc, unsigned& nx) {
    const unsigned G = gridDim.x * gridDim.y * gridDim.z;
    unsigned sum, cnt, mine, sp = 0u;
    for (;;) {
        sum = 0u; cnt = 0u; mine = 0u;
#pragma unroll
        for (unsigned j = 0; j < 16; ++j) { const unsigned c = xb_ld(&bar[XB_XCNT(j)]); sum += c; cnt += (c > 0u) ? 1u : 0u; mine = (j == x) ? c : mine; }
        if (sum == G) break;
        __builtin_amdgcn_s_sleep(1);
        if ((++sp & 255u) == 0u) { if (xb_ld(&bar[XB_TMO])) break; if (sp > XB_SPIN_CAP) { atomicAdd(&bar[XB_TMO], 1u); break; } }
    }
    nloc = mine > 0u ? mine : 1u; nx = cnt > 0u ? cnt : 1u;
}

__device__ __forceinline__ void xcd_barrier(const XcdBarrier& b) {
    asm volatile("s_waitcnt vmcnt(0)" ::: "memory");
    __syncthreads();
    if (xb_leader(b.wave)) {
        unsigned* bar = b.bar;
        __builtin_amdgcn_s_waitcnt(0);
        unsigned nloc = b.st[0], nx = b.st[1];
        if (nloc == 0u) { xcd_barrier_complete(bar, b.x, nloc, nx); b.st[0] = nloc; b.st[1] = nx; }
        const unsigned old = xb_add(&bar[XB_XSUB(b.x)], 1u);
        const unsigned gen = old / nloc;
        if (old + 1u == (gen + 1u) * nloc) {
            __builtin_amdgcn_fence(__ATOMIC_RELEASE, "agent");
            asm volatile("s_waitcnt vmcnt(0)" ::: "memory");
            const unsigned og = xb_add(&bar[XB_TOP], 1u);
            const unsigned tg = og / nx;
            if (og + 1u == (tg + 1u) * nx) xb_add(&bar[XB_TOPGEN], 1u);
            else XB_SPIN(xb_ld(&bar[XB_TOPGEN]) == tg, bar);
            __builtin_amdgcn_fence(__ATOMIC_ACQUIRE, "agent");
            xb_add(&bar[XB_XGEN(b.x)], 1u);
            asm volatile("s_waitcnt vmcnt(0)" ::: "memory");
        } else {
            XB_SPIN(xb_ld(&bar[XB_XGEN(b.x)]) == gen, bar);
            __builtin_amdgcn_fence(__ATOMIC_ACQUIRE, "agent");
            asm volatile("s_waitcnt vmcnt(0)" ::: "memory");
        }
    }
    __syncthreads();
}

constexpr int CW_GSYNC = 3840;
__device__ __forceinline__ void grid_arrive(unsigned* word, int wave) {
    asm volatile("s_waitcnt vmcnt(0)" ::: "memory"); __syncthreads();
    if (xb_leader(wave)) { __builtin_amdgcn_fence(__ATOMIC_RELEASE, "agent"); asm volatile("s_waitcnt vmcnt(0)" ::: "memory"); (void)xb_add(word, 1u); }
}
__device__ __forceinline__ void grid_wait(unsigned* word, unsigned target, int wave) {
    if (xb_leader(wave)) { unsigned sp = 0; while (xb_ld(word) < target) { __builtin_amdgcn_s_sleep(2); if (++sp > (1u << 22)) break; }
        __builtin_amdgcn_fence(__ATOMIC_ACQUIRE, "agent"); asm volatile("s_waitcnt vmcnt(0)" ::: "memory"); }
    __syncthreads();
}

constexpr int PH_PER_LAYER = 7, PH_FINAL = 2 + DEPTH * PH_PER_LAYER, N_PHASES = PH_FINAL + 1;
__global__ void __launch_bounds__(NTHREADS, 2) fwd_kernel(Args args) {
    extern __shared__ __attribute__((aligned(16))) unsigned char lds_raw[];
    Ctx C;
    C.lds = (LAS unsigned char*)lds_raw; C.lds_gen = (char*)lds_raw; C.wave = __builtin_amdgcn_readfirstlane((int)threadIdx.x >> 6); C.lane = (int)__builtin_amdgcn_mbcnt_hi(~0u, __builtin_amdgcn_mbcnt_lo(~0u, 0u)); C.tid = C.wave * 64 + C.lane;
    C.G = gridDim.x; { const int bx = blockIdx.x; C.vcu = (C.G % 8 == 0) ? (bx % 8) * (C.G / 8) + bx / 8 : bx; }
    C.gw = C.vcu * NWAVES + C.wave; C.NGW = C.G * NWAVES;
    const int lo = args.ph_lo, hi = args.ph_hi;
    for (int u = C.tid; u < (LDS_BYTES - LDSCTL_OFF) / 4; u += NTHREADS) ((LAS unsigned*)(C.lds + LDSCTL_OFF))[u] = 0u;
    __syncthreads();
    XcdBarrier bar; bar.wave = C.wave; bar.bar = (unsigned*)(args.ws + WS_CTL) + CW_BAR; bar.x = 0; bar.st = nullptr;
    if (hi - lo > 1) bar = xcd_barrier_post((unsigned*)(args.ws + WS_CTL) + CW_BAR, (volatile LAS unsigned*)(C.lds + MISC_OFF) + 8, C.wave);
#define IN(k) (lo <= (k) && (k) < hi)
#define PCTX Ctx L = C; asm volatile("v_mbcnt_lo_u32_b32 %0, -1, 0\n\tv_mbcnt_hi_u32_b32 %0, -1, %0" : "=v"(L.lane)); L.tid = L.wave * 64 + L.lane; asm volatile("" : "+s"(L.vcu), "+s"(L.gw)); { const __attribute__((address_space(4))) Args* ka_ = (const __attribute__((address_space(4))) Args*)__builtin_amdgcn_kernarg_segment_ptr(); asm volatile("" : "+s"(ka_)); L.x = (const float*)ka_->in[0]; L.c = (const float*)ka_->in[1]; L.ctx = (const float*)ka_->in[2]; L.c_ctx = (const float*)ka_->in[3]; L.w_mod = (const float*)ka_->in[4]; L.b_mod = (const float*)ka_->in[5]; L.g_mix = (const float*)ka_->in[6]; L.g_ffn = (const float*)ka_->in[7]; L.w_in = (const float*)ka_->in[8]; L.g_q = (const float*)ka_->in[9]; L.g_k = (const float*)ka_->in[10]; L.lru_conv_w = (const float*)ka_->in[11]; L.lru_conv_b = (const float*)ka_->in[12]; L.lru_wa = (const float*)ka_->in[13]; L.lru_ba = (const float*)ka_->in[14]; L.lru_wi = (const float*)ka_->in[15]; L.lru_bi = (const float*)ka_->in[16]; L.lru_lam = (const float*)ka_->in[17]; L.sc_conv_w = (const float*)ka_->in[18]; L.w_out = (const float*)ka_->in[19]; L.w_up = (const float*)ka_->in[20]; L.ffn_conv_w = (const float*)ka_->in[21]; L.w_down = (const float*)ka_->in[22]; L.g_final = (const float*)ka_->in[23]; L.out = ka_->out; { GAS unsigned char* wsg_ = (GAS unsigned char*)ka_->ws; asm volatile("" : "+s"(wsg_)); L.ws = (unsigned char*)wsg_; } }
#define SEAM(k) do { if (IN(k) && IN((k) + 1)) { xcd_barrier(bar); } } while (0)
    if (IN(0)) REP(0) { PCTX; phase_p0a(L); } SEAM(0);
    if (IN(1)) REP(1) { PCTX; phase_p0b(L); } SEAM(1);
    for (int l = 0; l < DEPTH; ++l) {
        const int P = 2 + l * PH_PER_LAYER;
        const int Mff = (l == 0) ? M_ALL : M_LAT;
        if (IN(P + 0)) REP(2) {
            PCTX; int bx = (int)blockIdx.x; asm volatile("" : "+s"(bx));
            if (l == 0) {
                ProjEpi E{(bf16*)(L.ws + WS_PROJ), NPROJ, (const float*)(L.ws + WS_STA), (const float*)(L.ws + WS_BIN), NPROJ, 0, 0, (bf16*)(L.ws + WS_MIX), (bf16*)(L.ws + WS_KB), (bf16*)(L.ws + WS_VB), (const float*)(L.ws + WS_ROPE), L.g_q + (0) * 64, L.g_k + (0) * 64};
                GenOrder S; S.strided(M_ALL, NPROJ, bx, L.G);
                gemm_proj(L, (const bf16*)(L.ws + WS_AP), (const bf16*)(L.ws + WS_WIN), M_ALL, NPROJ, DM, S, E);
                { const int rem = (L.G == 256) ? ((M_ALL / 256) * (NPROJ / 256)) & 255 : 0; if (bx >= rem) { __syncthreads(); deferred_work(L, 0, bx - rem, L.G - rem); } }
            } else {
                { const float* mod = (const float*)(L.ws + WS_MOD) + (size_t)(l - 1) * 9 * 6144;
                  ResEpi E{L.x, L.ctx, (bf16*)(L.ws + WS_XR), mod + 5 * 1024, L.g_mix + l * DM, mod + 9 * 6144 + 1 * 1024, (bf16*)(L.ws + WS_AP), (float*)(L.ws + WS_STA), true, M_LAT / 256, false};
                  GenOrder S; S.strided(M_CTX, DM, bx, L.G);
                  { pg8::Unit fu; int prev = -1; for (int i = 0; S.next(i, fu); ++i) { if (fu.pm != prev) ffn_fix_panel(L, l - 1, M_LAT / 256 + fu.pm); prev = fu.pm; } asm volatile("s_waitcnt vmcnt(0)" ::: "memory"); __syncthreads(); }
                  gemm_res<false>(L, (const bf16*)(L.ws + WS_ACT) + (size_t)M_LAT * DFF, (const bf16*)(L.ws + WS_WDN + (l - 1) * SZ_WDN), M_CTX, DFF, S, E); }
                { ProjEpi E{(bf16*)(L.ws + WS_PROJ), NPROJ, (const float*)(L.ws + WS_STA), (const float*)(L.ws + WS_BIN) + (size_t)l * 9 * NPROJ, NPROJ, 0, 0, (bf16*)(L.ws + WS_MIX), (bf16*)(L.ws + WS_KB), (bf16*)(L.ws + WS_VB), (const float*)(L.ws + WS_ROPE), L.g_q + (l) * 64, L.g_k + (l) * 64};
                  GenOrder S; S.strided(M_LAT, NPROJ, bx, L.G);
                  if (L.G == 256) {
                      if (bx < 32) { S.b1 = 896 + bx; S.s1 = 32; S.n1 = 2; }
                      else { const int j = bx - 32; S.b1 = j; S.s1 = 224; S.n1 = 4; S.b2 = 960 + j; S.s2 = 0; S.n2 = j < 64 ? 1 : 0; } }
                  gemm_proj(L, (const bf16*)(L.ws + WS_AP), (const bf16*)(L.ws + WS_WIN + l * SZ_WIN), M_LAT, NPROJ, DM, S, E); }
            }
        } SEAM(P + 0);
        if (IN(P + 1)) {
            if ((PROBE_REP_MASK >> 3) & 1) { PCTX; if (l == 0) phase_post(L, l, 0, M_ALL, 12, L.gw, L.NGW); }
            PCTX;
            if (l == 0) phase_post(L, l, 0, M_ALL, 12, L.gw, L.NGW);
            else {
                const int gs = L.G >> 3; const bool split = gs >= 2; int q = 0, below = 0, role = 0;
#pragma unroll
                for (int p = 0; p < 8; ++p) { if (L.vcu == p * gs) { role = 1; q = p; } if (split && L.vcu == p * gs + 1) { role = 2; q = p; } if (p * gs < L.vcu) ++below; if (split && p * gs + 1 < L.vcu) ++below; }
                if (role != 0) {
                    const int r0 = M_LAT + 256 * q, c0 = (role == 2 || !split) ? 512 : 768, ncol = split ? 256 : 512;
                    ProjEpi E{(bf16*)(L.ws + WS_PROJ) + (size_t)r0 * NPROJ + c0, NPROJ, (const float*)(L.ws + WS_STA), (const float*)(L.ws + WS_BIN) + (size_t)l * 9 * NPROJ + c0, NPROJ, r0, c0 >> 8, (bf16*)(L.ws + WS_MIX), (bf16*)(L.ws + WS_KB), (bf16*)(L.ws + WS_VB), (const float*)(L.ws + WS_ROPE), L.g_q + l * 64, L.g_k + l * 64};
                    GenOrder S; S.strided(256, ncol, 0, 1);
                    gemm_proj(L, (const bf16*)(L.ws + WS_AP) + (size_t)r0 * DM, (const bf16*)(L.ws + WS_WIN + l * SZ_WIN) + (size_t)c0 * DM, 256, ncol, DM, S, E);
                    if (role == 1) { asm volatile("s_waitcnt vmcnt(0)" ::: "memory"); __syncthreads(); phase_post(L, l, r0, r0 + 256, 4, L.wave, NWAVES); }
                } else {
                    const int j = L.vcu - below, nl = L.G - (split ? 16 : 8);
                    phase_post(L, l, 0, M_LAT, 12, j * NWAVES + L.wave, nl * NWAVES);
                }
            }
        } SEAM(P + 1);
        const bool fuse23 = IN(P + 2) && IN(P + 3);
        if (IN(P + 2)) REP(4) {
            PCTX;
            GatesEpi E{(const bf16*)(L.ws + WS_RC), L.lru_ba + l * 512, L.lru_bi + l * 512, (const float*)(L.ws + WS_SPL) + l * 512, (unsigned*)(L.ws + WS_LA), (float*)(L.ws + WS_AGP), (float*)(L.ws + WS_AGB)};
            gemm_gates(L, (const bf16*)(L.ws + WS_RC), (const bf16*)(L.ws + WS_GW + l * SZ_GW), E);
            if (l == 0) { const int bx = (int)blockIdx.x, rem = (L.G == 256) ? ((M_ALL / 256) * 4) & 255 : 0; if (bx >= rem) { __syncthreads(); deferred_work(L, 1, bx - rem, L.G - rem); } }
            if (fuse23) grid_arrive((unsigned*)(L.ws + WS_CTL) + CW_GSYNC + 64 * l, L.wave);
        } if (!fuse23) SEAM(P + 2);
        if (IN(P + 3)) { { PCTX;
            REP(6) phase_attn_fast(L, l, rep_ == 0 && ((PROBE_REP_MASK >> 6) & 1));
            } REP(7) { PCTX; if (fuse23) grid_wait((unsigned*)(L.ws + WS_CTL) + CW_GSYNC + 64 * l, (unsigned)L.G, L.wave); phase_scan2(L, l); } } SEAM(P + 3);
        if (IN(P + 4)) for (int rep_ = 0; rep_ < ((((PROBE_REP_MASK) >> 8) & 1) && l == 0 ? 2 : 1); ++rep_) {
            PCTX; const float* mod = (const float*)(L.ws + WS_MOD) + (size_t)l * 9 * 6144;
            ResEpi E{L.x, L.ctx, (bf16*)(L.ws + WS_XR), mod + 2 * 1024, L.g_ffn + l * DM, mod + 4 * 1024, (bf16*)(L.ws + WS_AP), (float*)(L.ws + WS_STB), true, 0, true};
            GenOrder S; S.strided(Mff, DM, (int)blockIdx.x, L.G);
            if (l == 0) gemm_res<true>(L, (const bf16*)(L.ws + WS_MIX), (const bf16*)(L.ws + WS_WOUT + l * SZ_WOUT), Mff, DM, S, E);
            else gemm_res<false>(L, (const bf16*)(L.ws + WS_MIX), (const bf16*)(L.ws + WS_WOUT + l * SZ_WOUT), Mff, DM, S, E);
            if (l == 0) { const int bx = (int)blockIdx.x, rem = (L.G == 256) ? ((M_ALL / 256) * 4) & 255 : 0; if (bx >= rem) { __syncthreads(); deferred_work(L, 2, bx - rem, L.G - rem); } }
        } SEAM(P + 4);
        if (IN(P + 5)) REP(9) { PCTX; gemm_upconv(L, l, Mff); } SEAM(P + 5);
        if (IN(P + 6)) {
            PCTX; const float* mod = (const float*)(L.ws + WS_MOD) + (size_t)l * 9 * 6144;
            const bool last = (l == DEPTH - 1);
            ResEpi E{L.x, L.ctx, (bf16*)(L.ws + WS_XR), mod + 5 * 1024, last ? L.g_final : L.g_mix + (l + 1) * DM, last ? mod : mod + 9 * 6144 + 1 * 1024, (bf16*)(L.ws + WS_AP), (float*)(L.ws + WS_STA), !last, 0, false};
            GenOrder S; S.strided(M_LAT, DM, (int)blockIdx.x, L.G);
            { pg8::Unit fu; int prev = -1; for (int i = 0; S.next(i, fu); ++i) { if (fu.pm != prev) ffn_fix_panel(L, l, fu.pm); prev = fu.pm; } asm volatile("s_waitcnt vmcnt(0)" ::: "memory"); __syncthreads(); }
            if (last && L.G == 256) gemm_res_final(L, (const bf16*)(L.ws + WS_ACT), (const bf16*)(L.ws + WS_WDN + l * SZ_WDN), M_LAT, DFF, S, E);
            else gemm_res<false>(L, (const bf16*)(L.ws + WS_ACT), (const bf16*)(L.ws + WS_WDN + l * SZ_WDN), M_LAT, DFF, S, E);
        } if (!(l == DEPTH - 1 && C.G == 256)) SEAM(P + 6);
    }
    if (IN(PH_FINAL) && C.G != 256) { PCTX; phase_final(L); }
#undef IN
#undef SEAM
}

extern "C" void kernel_launch(void* const* d_in, const int* in_sizes, int n_in, void* d_out, int out_size, void* d_ws, size_t ws_size, hipStream_t stream) {
    static int grid = 0;
    if (grid == 0) {
        if (n_in != 24 || out_size != M_LAT * DM || ws_size < WS_END) { fprintf(stderr, "kernel_launch: unexpected problem (n_in %d, out %d, ws %zu)\n", n_in, out_size, ws_size); grid = -1; return; }
        int dev = 0, cus = 0, per_cu = 0;
        if (hipGetDevice(&dev) != hipSuccess || hipDeviceGetAttribute(&cus, hipDeviceAttributeMultiprocessorCount, dev) != hipSuccess) { grid = -1; return; }
        if (hipFuncSetAttribute((const void*)fwd_kernel, hipFuncAttributeMaxDynamicSharedMemorySize, LDS_BYTES) != hipSuccess) { fprintf(stderr, "kernel_launch: hipFuncSetAttribute failed\n"); grid = -1; return; }
        if (hipOccupancyMaxActiveBlocksPerMultiprocessor(&per_cu, (const void*)fwd_kernel, NTHREADS, LDS_BYTES) != hipSuccess || per_cu < 1) { fprintf(stderr, "kernel_launch: occupancy query says %d blocks per CU\n", per_cu); }
        (void)hipGetLastError();
        grid = cus;
    }
    if (grid < 0) return;
    (void)hipMemsetAsync((char*)d_ws + WS_CTL, 0, CTL_ZERO_BYTES, stream);
    Args a{};
    for (int i = 0; i < 24; ++i) a.in[i] = d_in[i];
    a.out = (float*)d_out; a.ws = (unsigned char*)d_ws;
#if MK_N_LAUNCHES == 1
    a.ph_lo = 0; a.ph_hi = N_PHASES;
    void* kargs[] = {&a};
    hipError_t e = hipLaunchCooperativeKernel((const void*)fwd_kernel, dim3(grid), dim3(NTHREADS), kargs, LDS_BYTES, stream);
    if (e != hipSuccess) fprintf(stderr, "kernel_launch: cooperative launch failed: %s (grid %d)\n", hipGetErrorString(e), grid);
#else
    for (int p = 0; p < N_PHASES; ++p) {
        a.ph_lo = p; a.ph_hi = p + 1;
        hipLaunchKernelGGL(fwd_kernel, dim3(grid), dim3(NTHREADS), LDS_BYTES, stream, a);
    }
#endif
}
```

```cpp
#include <hip/hip_runtime.h>
#include <cstdio>
#include <cstdint>
#include <cmath>
#include <hip/hip_bf16.h>

#ifndef MK_N_LAUNCHES
#define MK_N_LAUNCHES 1
#endif
#ifndef PROBE_REP_MASK
#define PROBE_REP_MASK 0
#endif
#define REP(kind) for (int rep_ = 0; rep_ < (((PROBE_REP_MASK) >> (kind)) & 1) + 1; ++rep_)

#define LAS __attribute__((address_space(3)))
#define GAS __attribute__((address_space(1)))
typedef unsigned short bf16;
typedef unsigned v4u __attribute__((ext_vector_type(4)));
typedef unsigned v2u __attribute__((ext_vector_type(2)));
typedef float f32x4 __attribute__((ext_vector_type(4)));
typedef float f32x2 __attribute__((ext_vector_type(2)));

constexpr int NB = 8, SEQ = 4096, CTXL = 256, DM = 1024, DEPTH = 2;
constexpr int M_LAT = NB * SEQ, M_CTX = NB * CTXL, M_ALL = M_LAT + M_CTX;
constexpr int NPROJ = 2048, DFF = 2816, NUP = 2 * DFF, KVROWS = SEQ + CTXL, KVP = 128;
constexpr int NCHUNK = 68;
constexpr float EPS = 1e-6f;
constexpr float C2 = 0.125f * 1.4426950408889634f;
constexpr int NWAVES = 8, NTHREADS = 512;

constexpr size_t MiB = 1u << 20;
constexpr size_t WS_CTL = 0, CTL_ZERO_BYTES = 1 * MiB;
constexpr size_t WS_WIN = 1 * MiB, WS_WOUT = 9 * MiB, WS_WUP = 13 * MiB, WS_WDN = 35 * MiB, WS_GW = 46 * MiB;
constexpr size_t SZ_WIN = 4 * MiB, SZ_WOUT = 2 * MiB, SZ_WUP = 11 * MiB, SZ_WDN = 11 * MiB / 2, SZ_GW = MiB / 2;
constexpr size_t WS_MOD = 47 * MiB, WS_BIN = 47 * MiB + 512 * 1024, WS_BUP = 48 * MiB, WS_ROPE = 48 * MiB + 512 * 1024, WS_SPL = WS_ROPE + 16384;
constexpr size_t WS_STA = 49 * MiB, WS_STB = 51 * MiB + 512 * 1024, WS_AGP = 54 * MiB, WS_AGB = 55 * MiB + 512 * 1024;
constexpr size_t WS_XC = 57 * MiB, WS_AP = 65 * MiB, WS_BIG = 133 * MiB;
constexpr size_t WS_PROJ = WS_BIG, WS_MIX = WS_BIG + 136 * MiB, WS_KB = WS_MIX + 68 * MiB, WS_VB = WS_KB + 17 * MiB / 2, WS_RC = WS_VB + 17 * MiB / 2;
constexpr size_t WS_LA = WS_RC + 17 * MiB, WS_XR = WS_LA + 68 * MiB, WS_END1 = WS_XR + 68 * MiB;
constexpr size_t WS_ACT = WS_BIG, WS_EDGE = WS_BIG + 187 * MiB, WS_END2 = WS_EDGE + 8 * MiB;
constexpr size_t WS_END = 512 * MiB;
static_assert(WS_END1 <= WS_END && WS_END2 <= WS_XR, "d_ws map");
static_assert((size_t)M_ALL * NPROJ * 2 == 136 * MiB && (size_t)M_ALL * DM * 2 == 68 * MiB && (size_t)M_ALL * 256 * 2 == 17 * MiB && (size_t)M_ALL * DFF * 2 == 187 * MiB, "sizes");
static_assert((size_t)136 * 4 * NUP * 2 <= 8 * MiB && (size_t)NB * KVROWS * KVP * 2 * 2 == 17 * MiB && (size_t)M_ALL * 256 * 4 * 2 == 68 * MiB, "sizes2");
constexpr int CW_BAR = 4096;

constexpr int RING_BYTES = 131072, LDSCTL_OFF = RING_BYTES, MISC_OFF = LDSCTL_OFF + 320, EXCH_OFF = RING_BYTES + 1024  , LDS_BYTES = 147456;

__device__ __forceinline__ float bflo(unsigned w) { return __uint_as_float(w << 16); }
__device__ __forceinline__ float bfhi(unsigned w) { return __uint_as_float(w & 0xffff0000u); }
__device__ __forceinline__ float bf1(bf16 h) { return __uint_as_float((unsigned)h << 16); }
__device__ __forceinline__ unsigned pk2(float lo, float hi) { unsigned r; asm volatile("v_cvt_pk_bf16_f32 %0, %1, %2" : "=v"(r) : "v"(lo), "v"(hi)); return r; }
__device__ __forceinline__ void unpack8(const v4u w, float (&x)[8]) {
    x[0] = bflo(w.x); x[1] = bfhi(w.x); x[2] = bflo(w.y); x[3] = bfhi(w.y); x[4] = bflo(w.z); x[5] = bfhi(w.z); x[6] = bflo(w.w); x[7] = bfhi(w.w);
}
__device__ __forceinline__ v4u pack8(const float (&x)[8]) { v4u w; w.x = pk2(x[0], x[1]); w.y = pk2(x[2], x[3]); w.z = pk2(x[4], x[5]); w.w = pk2(x[6], x[7]); return w; }
__device__ __forceinline__ float shx(float v, int mask, int lane) { return __int_as_float(__builtin_amdgcn_ds_bpermute((lane ^ mask) << 2, __float_as_int(v))); }
__device__ __forceinline__ float wave_sum(float v, int lane) {
#pragma unroll
    for (int o = 1; o < 64; o <<= 1) v += shx(v, o, lane);
    return v;
}
__device__ __forceinline__ float sigmoidf_(float x) { return __builtin_amdgcn_rcpf(1.0f + __expf(-x)); }
__device__ __forceinline__ float silu_(float x) { return x * __builtin_amdgcn_rcpf(1.0f + __expf(-x)); }
__device__ __forceinline__ float one_minus_exp_(float x) {
    const float s = -x * (1.0f + x * (0.5f + x * (1.0f / 6.0f + x * (1.0f / 24.0f + x * (1.0f / 120.0f + x * (1.0f / 720.0f + x * (1.0f / 5040.0f)))))));
    return x > -0.25f ? s : 1.0f - __expf(x);
}
__device__ __forceinline__ float gelu_tanh_(float x) {
    const float K = -2.3022081983f; const float p = __builtin_fmaf(x * x, 0.044715f * K, K);
    return x * __builtin_amdgcn_rcpf(1.0f + __builtin_amdgcn_exp2f(p * x));
}
__device__ __forceinline__ int row_bi(int m) { return m < M_LAT ? (m >> 12) : 8; }

struct Args { const void* in[24]; float* out; unsigned char* ws; int ph_lo, ph_hi; };
struct Ctx {
    LAS unsigned char* lds; char* lds_gen; int tid, lane, wave, vcu, G, gw, NGW;
    const float *x, *c, *ctx, *c_ctx, *w_mod, *b_mod, *g_mix, *g_ffn, *w_in, *g_q, *g_k, *lru_conv_w, *lru_conv_b, *lru_wa, *lru_ba, *lru_wi, *lru_bi, *lru_lam, *sc_conv_w, *w_out, *w_up, *ffn_conv_w, *w_down, *g_final;
    float* out; unsigned char* ws;
};
#define WSP(T, off) ((T*)(C.ws + (off)))

struct ProjEpi {
    bf16* Cout; int ldc; const float* stats; const float* bias; int ldb; int row_off;
    int tile0; bf16 *MIX, *KB, *VB; const float *ropeT, *gq, *gk;
};
struct ResEpi {
    const float *xi_lat, *xi_ctx; bf16* XR; const float* gate; const float* gn; const float* cn; bf16* AP; float* stats; bool has_ap; int pm_off; bool ap_perm;
    __device__ __forceinline__ const float* xi_row(int grow) const { return grow < M_LAT ? xi_lat + (size_t)grow * DM : xi_ctx + (size_t)(grow - M_LAT) * DM; }
};
struct GatesEpi {
    const bf16* RC; const float *ba, *bi_, *spl; unsigned* LAB; float *AGP, *AGB;
};

__host__ __device__ __forceinline__ int qk_pos(int n) { if (n >= 640) return n; const int d = n & 63; return (n & ~63) + 2 * (d & 31) + (d >> 5); }
__device__ __forceinline__ void transpose_item(const float* W, int K, int N, bf16* WT, LAS float* scr, int item, int lane, bool upperm = false, bool qkperm = false) {
    const int nblk = N / 32, kb = item / nblk, nb = item % nblk, k0 = 64 * kb, n0 = 32 * nb;
    int d0 = n0; if (upperm) { const int half = n0 / DFF, j = n0 - half * DFF; d0 = (j >> 7) * 256 + half * 128 + (j & 127); }
    { f32x4 v[8];
#pragma unroll
      for (int i = 0; i < 8; ++i) v[i] = *(const f32x4*)(W + (size_t)(k0 + 8 * i + (lane >> 3)) * N + n0 + 4 * (lane & 7));
#pragma unroll
      for (int i = 0; i < 8; ++i) { LAS float* d = scr + (8 * i + (lane >> 3)) * 33 + 4 * (lane & 7); d[0] = v[i].x; d[1] = v[i].y; d[2] = v[i].z; d[3] = v[i].w; } }
    asm volatile("s_waitcnt lgkmcnt(0)" ::: "memory");
    const int c = lane & 7;
#pragma unroll
    for (int j = 0; j < 4; ++j) { const int n = (lane >> 3) + 8 * j; const LAS float* s = scr + (8 * c) * 33 + n;
        v4u o; o.x = pk2(s[0 * 33], s[1 * 33]); o.y = pk2(s[2 * 33], s[3 * 33]); o.z = pk2(s[4 * 33], s[5 * 33]); o.w = pk2(s[6 * 33], s[7 * 33]);
        *(v4u*)(WT + (size_t)(qkperm ? qk_pos(n0 + n) : d0 + n) * K + k0 + 8 * c) = o; }
    asm volatile("s_waitcnt lgkmcnt(0)" ::: "memory");
}
__device__ __forceinline__ void gemv9_item(const Ctx& C, LAS float* vec, LAS float* red, const float* W, int ldw, int n0, const float* bias, float* out, int ostride, bool qkperm = false) {
    float acc[9];
#pragma unroll
    for (int b = 0; b < 9; ++b) acc[b] = 0.f;
    const int k0 = C.wave * 128; const float* wp = W + (size_t)k0 * ldw + n0 + C.lane;
#pragma unroll 1
    for (int kk = 0; kk < 128; kk += 16) {
        float w[16];
#pragma unroll
        for (int j = 0; j < 16; ++j) w[j] = wp[(size_t)(kk + j) * ldw];
#pragma unroll
        for (int j = 0; j < 16; j += 4)
#pragma unroll
            for (int b = 0; b < 9; ++b) { const f32x4 v = *(const LAS f32x4*)(vec + b * 1024 + k0 + kk + j); acc[b] += (v.x * w[j] + v.y * w[j + 1]) + (v.z * w[j + 2] + v.w * w[j + 3]); }
    }
#pragma unroll
    for (int b = 0; b < 9; ++b) red[(C.wave * 9 + b) * 64 + C.lane] = acc[b];
    __syncthreads();
    for (int idx = C.tid; idx < 576; idx += NTHREADS) { const int b = idx >> 6, j = idx & 63; float s = 0.f;
#pragma unroll
        for (int w = 0; w < 8; ++w) s += red[(w * 9 + b) * 64 + j];
        if (bias) s += bias[n0 + j];
        out[(size_t)b * ostride + (qkperm ? qk_pos(n0 + j) : n0 + j)] = s; }
    __syncthreads();
}
template <int WHICH> __device__ __forceinline__ void transpose_matrix(const Ctx& C, int l, int widx, int nw) {
    LAS float* scr = (LAS float*)(C.lds + C.wave * 16384);
    if (WHICH == 0) for (int it = widx; it < 16 * 64; it += nw) transpose_item(C.w_in + (size_t)l * DM * NPROJ, DM, NPROJ, WSP(bf16, WS_WIN + l * SZ_WIN), scr, it, C.lane, false, true);
    if (WHICH == 1) for (int it = widx; it < 16 * 32; it += nw) transpose_item(C.w_out + (size_t)l * DM * DM, DM, DM, WSP(bf16, WS_WOUT + l * SZ_WOUT), scr, it, C.lane);
    if (WHICH == 2) for (int it = widx; it < 16 * 176; it += nw) transpose_item(C.w_up + (size_t)l * DM * NUP, DM, NUP, WSP(bf16, WS_WUP + l * SZ_WUP), scr, it, C.lane, true);
    if (WHICH == 3) for (int it = widx; it < 44 * 32; it += nw) transpose_item(C.w_down + (size_t)l * DFF * DM, DFF, DM, WSP(bf16, WS_WDN + l * SZ_WDN), scr, it, C.lane);
}
__device__ __forceinline__ void bias_items(const Ctx& C, int l, bool up, int bidx, int nb) {
    LAS float* vec = (LAS float*)C.lds; LAS float* red = (LAS float*)(C.lds + 40960);
    const float* mod = WSP(float, WS_MOD) + (size_t)l * 9 * 6144 + (up ? 3 * 1024 : 0);
    const int nit = up ? 88 : 32;
    if (bidx < nit) {
        __syncthreads();
        { float t[18];
#pragma unroll
          for (int q = 0; q < 18; ++q) { const int idx = C.tid + q * NTHREADS; t[q] = mod[(size_t)(idx >> 10) * 6144 + (idx & 1023)]; }
#pragma unroll
          for (int q = 0; q < 18; ++q) vec[C.tid + q * NTHREADS] = t[q]; }
        __syncthreads();
        for (int it = bidx; it < nit; it += nb) {
            if (up) gemv9_item(C, vec, red, C.w_up + (size_t)l * DM * NUP, NUP, it * 64, nullptr, WSP(float, WS_BUP) + (size_t)l * 9 * NUP, NUP);
            else    gemv9_item(C, vec, red, C.w_in + (size_t)l * DM * NPROJ, NPROJ, it * 64, nullptr, WSP(float, WS_BIN) + (size_t)l * 9 * NPROJ, NPROJ, true); }
    }
}
__device__ __forceinline__ void phase_p0a(const Ctx& C) {
    transpose_matrix<0>(C, 0, C.gw, C.NGW);
    const int gt = C.gw * 64 + C.lane, NGT = C.NGW * 64;
    for (int idx0 = gt; idx0 < DEPTH * 1024 * 256; idx0 += 4 * NGT) {
        float va[4], vi[4];
#pragma unroll
        for (int q = 0; q < 4; ++q) { const int idx = (idx0 + q * NGT < DEPTH * 1024 * 256) ? idx0 + q * NGT : idx0; const int l = idx >> 18, n = (idx >> 8) & 1023, k = idx & 255;
            const int dir = n >> 9, half = (n >> 8) & 1, cl = n & 127, ch = half * 128 + cl, blk = ch >> 6, e = ch & 63;
            const size_t wi = ((((size_t)l * 2 + dir) * 4 + blk) * 64 + (k & 63)) * 64 + e; va[q] = C.lru_wa[wi]; vi[q] = C.lru_wi[wi]; }
#pragma unroll
        for (int q = 0; q < 4; ++q) { const int idx = idx0 + q * NGT; if (idx < DEPTH * 1024 * 256) { const int l = idx >> 18, n = (idx >> 8) & 1023, k = idx & 255;
            const int half = (n >> 8) & 1, gate = (n >> 7) & 1, cl = n & 127, blk = (half * 128 + cl) >> 6; const float v = ((k >> 6) == blk) ? (gate ? vi[q] : va[q]) : 0.f;
            WSP(bf16, WS_GW + l * SZ_GW)[(size_t)n * 256 + k] = (bf16)(pk2(v, 0.f) & 0xffffu); } }
    }
    if (gt < 1024) { const int pos = gt >> 4, f = gt & 15; const float inv = powf(10000.0f, -(float)f / 16.0f), ang = (float)pos * inv;
        WSP(float, WS_ROPE)[gt] = cosf(ang); WSP(float, WS_ROPE)[1024 + gt] = sinf(ang); }
    if (gt < DEPTH * 2 * 256) { const float lam = C.lru_lam[gt]; WSP(float, WS_SPL)[gt] = log1pf(expf(-lam)); }
    __syncthreads();
    LAS float* vec = (LAS float*)C.lds; LAS float* red = (LAS float*)(C.lds + 40960);
    if (C.vcu < DEPTH * 96) {
        { float t[18];
#pragma unroll
          for (int q = 0; q < 18; ++q) { const int idx = C.tid + q * NTHREADS, b = idx >> 10, k = idx & 1023; const float vc = C.c[(b < 8 ? b : 0) * 1024 + k], vx = C.c_ctx[k]; t[q] = b < 8 ? vc : vx; }
#pragma unroll
          for (int q = 0; q < 18; ++q) vec[C.tid + q * NTHREADS] = silu_(t[q]); }
        __syncthreads();
        for (int it = C.vcu; it < DEPTH * 96; it += C.G) { const int l = it / 96, n0 = (it % 96) * 64;
            gemv9_item(C, vec, red, C.w_mod + (size_t)l * DM * 6144, 6144, n0, C.b_mod + l * 6144, WSP(float, WS_MOD) + (size_t)l * 9 * 6144, 6144); }
    }
}
__device__ __forceinline__ void phase_p0b(const Ctx& C) {
    const int nbw = (C.G > 64) ? 32 : 0;
    bias_items(C, 0, false, C.vcu, C.G);
    if (C.vcu < nbw) return;
    const int gw2 = (C.vcu - nbw) * NWAVES + C.wave, NGW2 = (C.G - nbw) * NWAVES;
    bf16* __restrict__ AP = WSP(bf16, WS_AP); float* __restrict__ STA = WSP(float, WS_STA);
    f32x4 g[4];
#pragma unroll
    for (int j = 0; j < 4; ++j) g[j] = *(const f32x4*)(C.g_mix + (C.lane + 64 * j) * 4);
    for (int m0 = gw2; m0 < M_ALL; m0 += 2 * NGW2) {
        f32x4 v[2][4], cc[2][4]; int mm[2];
#pragma unroll
        for (int q = 0; q < 2; ++q) { const int m = (m0 + q * NGW2 < M_ALL) ? m0 + q * NGW2 : m0; mm[q] = m;
            const float* xr = m < M_LAT ? C.x + (size_t)m * DM : C.ctx + (size_t)(m - M_LAT) * DM; const float* ca = WSP(float, WS_MOD) + (size_t)row_bi(m) * 6144 + 1024;
#pragma unroll
            for (int j = 0; j < 4; ++j) { const int k = (C.lane + 64 * j) * 4; v[q][j] = *(const f32x4*)(xr + k); cc[q][j] = *(const f32x4*)(ca + k); } }
#pragma unroll
        for (int q = 0; q < 2; ++q) { float ss = 0.f;
#pragma unroll
            for (int j = 0; j < 4; ++j) { const int k = (C.lane + 64 * j) * 4; const f32x4 x = v[q][j];
                ss += (x.x * x.x + x.y * x.y) + (x.z * x.z + x.w * x.w); const f32x4 a = x * g[j] * (cc[q][j] + 1.0f);
                v2u w; w.x = pk2(a.x, a.y); w.y = pk2(a.z, a.w); *(v2u*)(AP + (size_t)mm[q] * DM + k) = w; }
            ss = wave_sum(ss, C.lane);
            if (C.lane < 16) STA[(size_t)mm[q] * 16 + C.lane] = C.lane == 0 ? ss : 0.f; }
    }
}
__device__ __forceinline__ void deferred_work(const Ctx& C, int window, int d, int nd) {
    const int widx = d * NWAVES + C.wave, nw = nd * NWAVES;
    if (window == 0) { transpose_matrix<1>(C, 0, widx, nw); transpose_matrix<2>(C, 0, widx, nw); transpose_matrix<0>(C, 1, widx, nw); transpose_matrix<1>(C, 1, widx, nw); bias_items(C, 0, true, d, nd); }
    if (window == 1) { transpose_matrix<3>(C, 0, widx, nw); transpose_matrix<3>(C, 1, widx, nw); }
    if (window == 2) { transpose_matrix<2>(C, 1, widx, nw); bias_items(C, 1, true, d, nd); bias_items(C, 1, false, d >= 88 ? d - 88 : d + nd - 88, nd); }
}

__device__ __forceinline__ void rope_tab(const float* ropeT, int t, int j, f32x4 (&cs)[2], f32x4 (&sn)[2]) {
    const int pos = ((j & 3) < 2) ? (t >> 6) : (t & 63), f0 = 8 * (j & 1); const float* c = ropeT + pos * 16 + f0; const float* s = ropeT + 1024 + pos * 16 + f0;
    cs[0] = *(const f32x4*)c; cs[1] = *(const f32x4*)(c + 4); sn[0] = *(const f32x4*)s; sn[1] = *(const f32x4*)(s + 4);
}
__device__ __forceinline__ void rope8(float (&y)[8], const float (&p)[8], const f32x4 (&cs)[2], const f32x4 (&sn)[2], int j) {
#pragma unroll
    for (int e = 0; e < 8; ++e) { const float c = cs[e >> 2][e & 3], s = sn[e >> 2][e & 3]; y[e] = (j < 4) ? (y[e] * c - p[e] * s) : (y[e] * c + p[e] * s); }
}
__device__ __forceinline__ void head_norm_rope(float (&x)[8], const float (&g)[8], bool rope, const f32x4 (&cs)[2], const f32x4 (&sn)[2], int j, int lane) {
    float ss = 0.f;
#pragma unroll
    for (int e = 0; e < 8; ++e) ss += x[e] * x[e];
    ss += shx(ss, 1, lane); ss += shx(ss, 2, lane); ss += shx(ss, 4, lane);
    const float rinv = rsqrtf(ss * (1.0f / 64.0f) + EPS); float p[8];
#pragma unroll
    for (int e = 0; e < 8; ++e) x[e] = x[e] * rinv * g[e];
#pragma unroll
    for (int e = 0; e < 8; ++e) p[e] = shx(x[e], 4, lane);
    if (rope) rope8(x, p, cs, sn, j);
}
__device__ __forceinline__ void phase_post(const Ctx& C, int l, int m_lo, int m_hi, int tasks, int gw, int NGW) {
    const bf16* __restrict__ PROJ = WSP(bf16, WS_PROJ); bf16* __restrict__ MIX = WSP(bf16, WS_MIX); bf16* __restrict__ KB = WSP(bf16, WS_KB); bf16* __restrict__ VB = WSP(bf16, WS_VB); bf16* __restrict__ RC = WSP(bf16, WS_RC);
    const float* __restrict__ ropeT = WSP(float, WS_ROPE);
    if (tasks & 1) { const int j = C.lane & 7; float gq[8];
#pragma unroll
      for (int e = 0; e < 8; ++e) gq[e] = C.g_q[l * 64 + 8 * j + e];
      for (int m0 = m_lo + gw; m0 < m_hi; m0 += 4 * NGW) {
        v4u xw[4]; f32x4 cs[4][2], sn[4][2]; int mm[4];
#pragma unroll
        for (int q = 0; q < 4; ++q) { const int m = m0 + q * NGW; mm[q] = m < m_hi ? m : m0; xw[q] = *(const v4u*)(PROJ + (size_t)mm[q] * NPROJ + C.lane * 8); rope_tab(ropeT, mm[q] & 4095, j, cs[q], sn[q]); }
#pragma unroll
        for (int q = 0; q < 4; ++q) { float x[8]; unpack8(xw[q], x); head_norm_rope(x, gq, mm[q] < M_LAT, cs[q], sn[q], j, C.lane);
#pragma unroll
            for (int e = 0; e < 8; ++e) x[e] *= C2;
            *(v4u*)(MIX + (size_t)mm[q] * DM + C.lane * 8) = pack8(x); }
      } }
    if (tasks & 2) { const int sub = C.lane & 31, j = sub & 7; const bool iskey = sub < 16; float gk[8];
#pragma unroll
      for (int e = 0; e < 8; ++e) gk[e] = C.g_k[l * 64 + 8 * j + e];
      for (int p0 = m_lo / 2 + gw; p0 < m_hi / 2; p0 += 4 * NGW) {
        v4u xw[4]; f32x4 cs[4][2], sn[4][2]; int mm[4];
#pragma unroll
        for (int q = 0; q < 4; ++q) { const int pi = p0 + q * NGW; mm[q] = 2 * (pi < m_hi / 2 ? pi : p0) + (C.lane >> 5); xw[q] = *(const v4u*)(PROJ + (size_t)mm[q] * NPROJ + 512 + sub * 8); rope_tab(ropeT, mm[q] & 4095, j, cs[q], sn[q]); }
#pragma unroll
        for (int q = 0; q < 4; ++q) { const int m = mm[q]; float x[8], y[8]; unpack8(xw[q], x);
#pragma unroll
            for (int e = 0; e < 8; ++e) y[e] = x[e];
            head_norm_rope(y, gk, m < M_LAT, cs[q], sn[q], j, C.lane);
            int b, pos; if (m < M_LAT) { b = m >> 12; pos = m & 4095; } else { const int mc = m - M_LAT; b = mc >> 8; pos = SEQ + (mc & 255); }
            bf16* dst = (iskey ? KB : VB) + ((size_t)b * KVROWS + pos) * KVP + (sub & 15) * 8;
            *(v4u*)dst = iskey ? pack8(y) : pack8(x); }
      } }
    if (tasks & 4) { const int sub = C.lane & 31, ch0 = sub * 8; float cw[4][8], cb[8];
#pragma unroll
      for (int e = 0; e < 8; ++e) { cb[e] = C.lru_conv_b[l * 256 + ch0 + e];
#pragma unroll
          for (int k = 0; k < 4; ++k) cw[k][e] = C.lru_conv_w[(l * 4 + k) * 256 + ch0 + e]; }
      for (int it = gw; it < (m_hi - m_lo) / 16; it += NGW) {
        const int m0 = m_lo + it * 16 + 8 * (C.lane >> 5); int t0, T; if (m0 < M_LAT) { t0 = m0 & 4095; T = SEQ; } else { t0 = (m0 - M_LAT) & 255; T = CTXL; }
        const bool head = t0 == 0, tail = t0 + 8 == T;
        v4u xw[11];
#pragma unroll
        for (int j = 0; j < 11; ++j) { const bool ok = !((j < 2 && head) || (j == 10 && tail)); xw[j] = *(const v4u*)(PROJ + (size_t)(ok ? m0 + j - 2 : m0) * NPROJ + 768 + ch0); }
        float xa[8], xb[8], xc[8], xd[8];
        unpack8(xw[0], xa); unpack8(xw[1], xb); unpack8(xw[2], xc);
        if (head) {
#pragma unroll
            for (int e = 0; e < 8; ++e) { xa[e] = 0.f; xb[e] = 0.f; } }
#pragma unroll
        for (int i = 0; i < 8; ++i) { unpack8(xw[i + 3], xd);
            if (i == 7 && tail) {
#pragma unroll
                for (int e = 0; e < 8; ++e) xd[e] = 0.f; }
            float acc[8];
#pragma unroll
            for (int e = 0; e < 8; ++e) acc[e] = cb[e] + cw[0][e] * xa[e] + cw[1][e] * xb[e] + cw[2][e] * xc[e] + cw[3][e] * xd[e];
            const int m = m0 + i, rrow = (m & ~63) + 16 * (m & 3) + ((m & 63) >> 2);
            *(v4u*)(RC + (size_t)rrow * 256 + ch0) = pack8(acc);
#pragma unroll
            for (int e = 0; e < 8; ++e) { xa[e] = xb[e]; xb[e] = xc[e]; xc[e] = xd[e]; } }
      } }
    if (tasks & 8) { const int sub = C.lane & 31, ch0 = sub * 8; float cw[3][8];
#pragma unroll
      for (int e = 0; e < 8; ++e)
#pragma unroll
          for (int k = 0; k < 3; ++k) cw[k][e] = C.sc_conv_w[(l * 3 + k) * 256 + ch0 + e];
      for (int it = gw; it < (m_hi - m_lo) / 16; it += NGW) {
        const int m0 = m_lo + it * 16 + 8 * (C.lane >> 5); int t0, T; if (m0 < M_LAT) { t0 = m0 & 4095; T = SEQ; } else { t0 = (m0 - M_LAT) & 255; T = CTXL; }
        const bool head = t0 == 0, tail = t0 + 8 == T;
        v4u bw[8], cw_[10], uw[10];
#pragma unroll
        for (int j = 0; j < 10; ++j) { const bool ok = !((j == 0 && head) || (j == 9 && tail)); const bf16* rp = PROJ + (size_t)(ok ? m0 + j - 1 : m0) * NPROJ + ch0;
            cw_[j] = *(const v4u*)(rp + 1536); uw[j] = *(const v4u*)(rp + 1792); if (j >= 1 && j <= 8) bw[j - 1] = *(const v4u*)(PROJ + (size_t)(m0 + j - 1) * NPROJ + 1280 + ch0); }
        float pa[8], pb[8], pc[8];
        { float cg[8], u[8]; unpack8(cw_[0], cg); unpack8(uw[0], u);
#pragma unroll
          for (int e = 0; e < 8; ++e) pa[e] = head ? 0.f : cg[e] * u[e];
          unpack8(cw_[1], cg); unpack8(uw[1], u);
#pragma unroll
          for (int e = 0; e < 8; ++e) pb[e] = cg[e] * u[e]; }
#pragma unroll
        for (int i = 0; i < 8; ++i) { float cg[8], u[8], bg[8], o[8]; unpack8(cw_[i + 2], cg); unpack8(uw[i + 2], u); unpack8(bw[i], bg);
#pragma unroll
            for (int e = 0; e < 8; ++e) pc[e] = (i == 7 && tail) ? 0.f : cg[e] * u[e];
#pragma unroll
            for (int e = 0; e < 8; ++e) o[e] = bg[e] * (cw[0][e] * pa[e] + cw[1][e] * pb[e] + cw[2][e] * pc[e]);
            *(v4u*)(MIX + (size_t)(m0 + i) * DM + 768 + ch0) = pack8(o);
#pragma unroll
            for (int e = 0; e < 8; ++e) { pa[e] = pb[e]; pb[e] = pc[e]; } }
      } }
}

__device__ __forceinline__ int chunk_row0(int b, int c) { return c < 4 ? M_LAT + b * CTXL + c * 64 : b * SEQ + (c - 4) * 64; }
__device__ __forceinline__ void phase_scan2(const Ctx& C, int l) {
    const unsigned* __restrict__ LAB = WSP(unsigned, WS_LA); const float* __restrict__ AGP = WSP(float, WS_AGP); const float* __restrict__ AGB = WSP(float, WS_AGB);
    const bf16* __restrict__ PROJ = WSP(bf16, WS_PROJ); bf16* __restrict__ MIX = WSP(bf16, WS_MIX);
    const bool lat_only = (l == DEPTH - 1);
    const int nitems = lat_only ? NB * 64 * 4 : NB * NCHUNK * 4;
    for (int it = C.gw; it < nitems; it += C.NGW) {
        const int chq = it & 3, bc = it >> 2, ch = chq * 64 + C.lane; int b, c; if (lat_only) { b = bc >> 6; c = 4 + (bc & 63); } else { c = bc % NCHUNK; b = bc / NCHUNK; }
        const float* gpF = AGP + ((size_t)(0 * NB + b) * NCHUNK) * 256 + ch; const float* gbF = AGB + ((size_t)(0 * NB + b) * NCHUNK) * 256 + ch;
        const float* gpB = AGP + ((size_t)(1 * NB + b) * NCHUNK) * 256 + ch; const float* gbB = AGB + ((size_t)(1 * NB + b) * NCHUNK) * 256 + ch;
        const int nf = c, nb = c >= 4 ? 71 - c : 3 - c, nt = nf + nb;
        const int row0 = chunk_row0(b, c);
        LAS unsigned* TF = (LAS unsigned*)(C.lds + C.wave * 8192); LAS bf16* TG = (LAS bf16*)(C.lds + C.wave * 8192 + 4096); LAS bf16* TO = (LAS bf16*)(C.lds + C.wave * 8192 + 6144);
        const int l4t = C.lane >> 4, l4c = (C.lane & 15) * 4, l8t = C.lane >> 3, l8c = (C.lane & 7) * 8;
        const unsigned* pF = LAB + ((size_t)0 * M_ALL + row0) * 256 + chq * 64 + l4c; const unsigned* pB = LAB + ((size_t)1 * M_ALL + row0) * 256 + chq * 64 + l4c;
        const bf16* pg = PROJ + (size_t)row0 * NPROJ + 1024 + chq * 64 + l8c; bf16* po = MIX + (size_t)row0 * DM + 512 + chq * 64 + l8c;
        v4u wf[16];
#pragma unroll
        for (int q = 0; q < 16; ++q) wf[q] = *(const v4u*)(pF + (size_t)(4 * q + l4t) * 256);
        float hf = 0.f, hb = 0.f;
        for (int k0 = 0; k0 < nt; k0 += 36) { float p[36], q[36];
#pragma unroll
            for (int j = 0; j < 36; ++j) { const int k = min(k0 + j, nt - 1); const bool fw = k < nf; const int kb = k - nf, cc = fw ? k : (kb < 4 ? 3 - kb : 71 - kb);
                const float* pp = fw ? gpF : gpB; const float* qq = fw ? gbF : gbB; p[j] = pp[cc * 256]; q[j] = qq[cc * 256]; }
#pragma unroll
            for (int j = 0; j < 36; ++j) { const int k = k0 + j; const bool v = k < nt, fw = k < nf;
                const float pj = v ? p[j] : 1.0f, qj = v ? q[j] : 0.0f;
                hf = fw ? pj * hf + qj : hf; hb = fw ? hb : pj * hb + qj; } }
        float hv[64];
        {
#pragma unroll
          for (int st = 0; st < 4; ++st) {
#pragma unroll
              for (int i = 0; i < 4; ++i) *(LAS v4u*)(TF + (4 * i + l4t) * 64 + l4c) = wf[st * 4 + i];
#pragma unroll
              for (int t = 0; t < 16; ++t) { const unsigned w = TF[t * 64 + C.lane]; hf = __builtin_amdgcn_exp2f(bflo(w)) * hf + bfhi(w); hv[st * 16 + t] = hf; } } }
        { v4u wb[16], wg[8];
#pragma unroll
          for (int q = 0; q < 16; ++q) wb[q] = *(const v4u*)(pB + (size_t)(4 * q + l4t) * 256);
#pragma unroll
          for (int q = 0; q < 8; ++q) wg[q] = *(const v4u*)(pg + (size_t)(8 * q + l8t) * NPROJ);
#pragma unroll
          for (int st = 3; st >= 0; --st) {
#pragma unroll
              for (int i = 0; i < 4; ++i) *(LAS v4u*)(TF + (4 * i + l4t) * 64 + l4c) = wb[st * 4 + i];
#pragma unroll
              for (int j = 0; j < 2; ++j) *(LAS v4u*)(TG + (8 * j + l8t) * 64 + l8c) = wg[st * 2 + j];
#pragma unroll
              for (int t = 15; t >= 0; --t) { const unsigned w = TF[t * 64 + C.lane]; const float g = bf1(TG[t * 64 + C.lane]); hb = __builtin_amdgcn_exp2f(bflo(w)) * hb + bfhi(w);
                  TO[t * 64 + C.lane] = (bf16)(pk2(gelu_tanh_(g) * (hv[st * 16 + t] + hb), 0.f) & 0xffffu); }
#pragma unroll
              for (int j = 0; j < 2; ++j) { const v4u o = *(const LAS v4u*)(TO + (8 * j + l8t) * 64 + l8c); *(v4u*)(po + (size_t)(st * 16 + 8 * j + l8t) * DM) = o; } } }
    }
}

namespace attn_body {
using abf16=__hip_bfloat16;
using bf16x8=__attribute__((ext_vector_type(8)))short;
using s16x4=__attribute__((ext_vector_type(4)))short;
using f32x16=__attribute__((ext_vector_type(16)))float;
using u32x4=__attribute__((ext_vector_type(4)))unsigned;
constexpr int D=64,DM=1024,KVPITCH=128;
constexpr int NW=8,QBLK=32,QB=QBLK*NW,KVBLK=64;
__device__ __forceinline__ int crow(int r,int hi){return (r&3)+8*(r>>2)+4*hi;}
#define SBAR() __builtin_amdgcn_sched_barrier(0)
constexpr int NSLOT=3, SLOTB=8192;
constexpr int LDS_K=0, LDS_V=NSLOT*SLOTB, LDS_WS=2*NSLOT*SLOTB, LDS_OST=LDS_WS+NW*64*4, LDS_BYTES=LDS_OST+NW*4096;
constexpr float C2=0.125f*1.4426950408889634f;
__device__ __forceinline__ void glds16(const void*gsrc,unsigned lds_dst){unsigned keep;
  asm volatile("s_mov_b32 %0, m0\n\ts_mov_b32 m0, %2\n\ts_nop 0\n\tglobal_load_lds_dwordx4 %1, off\n\ts_mov_b32 m0, %0":"=&s"(keep):"v"(gsrc),"s"(lds_dst):"memory");}
__device__ __forceinline__ float max3f(float a,float b,float c){float r;asm("v_max3_f32 %0, %1, %2, %3":"=v"(r):"v"(a),"v"(b),"v"(c));return r;}
__device__ __forceinline__ float max2f(float a,float b){float r;asm("v_max_f32_e32 %0, %1, %2":"=v"(r):"v"(a),"v"(b));return r;}
__device__ __forceinline__ float fadd_s(float a,float b){float r;asm("v_add_f32_e32 %0, %1, %2":"=v"(r):"v"(a),"v"(b));return r;}
__device__ __forceinline__ float fsub_s(float a,float b){float r;asm("v_sub_f32_e32 %0, %1, %2":"=v"(r):"v"(a),"v"(b));return r;}
typedef float f32x2_t __attribute__((ext_vector_type(2))); typedef __bf16 bf16x2_t __attribute__((ext_vector_type(2)));
__device__ __forceinline__ unsigned cvtpk_s(float lo,float hi){f32x2_t v={lo,hi};bf16x2_t b=__builtin_convertvector(v,bf16x2_t);return __builtin_bit_cast(unsigned,b);}
#define WAIT_BAR(N) asm volatile("s_waitcnt vmcnt(" #N ") lgkmcnt(0)\n\ts_barrier":::"memory")

__device__ __forceinline__ void qkt(f32x16&p0,f32x16&p1,const char*Kslot,const bf16x8*qr,const f32x16&negm,int r32,int hi){
  const char*kb=Kslot+hi*1024+r32*16;
  #pragma unroll
  for(int d0=0;d0<4;++d0){
    const bf16x8 b0=*reinterpret_cast<const bf16x8*>(kb+d0*2048);
    const bf16x8 b1=*reinterpret_cast<const bf16x8*>(kb+d0*2048+512);
    if(d0==0){p0=__builtin_amdgcn_mfma_f32_32x32x16_bf16(b0,qr[0],negm,0,0,0);p1=__builtin_amdgcn_mfma_f32_32x32x16_bf16(b1,qr[0],negm,0,0,0);}
    else{p0=__builtin_amdgcn_mfma_f32_32x32x16_bf16(b0,qr[d0],p0,0,0,0);p1=__builtin_amdgcn_mfma_f32_32x32x16_bf16(b1,qr[d0],p1,0,0,0);}}
}
typedef __attribute__((address_space(3))) const char* lds_cptr;
typedef short v4i16_t __attribute__((ext_vector_type(4)));
__device__ __forceinline__ void kload8(bf16x8*kf,lds_cptr kp){
  kf[0]=*(const __attribute__((address_space(3))) bf16x8*)(kp);      kf[1]=*(const __attribute__((address_space(3))) bf16x8*)(kp+512);
  kf[2]=*(const __attribute__((address_space(3))) bf16x8*)(kp+2048); kf[3]=*(const __attribute__((address_space(3))) bf16x8*)(kp+2560);
  kf[4]=*(const __attribute__((address_space(3))) bf16x8*)(kp+4096); kf[5]=*(const __attribute__((address_space(3))) bf16x8*)(kp+4608);
  kf[6]=*(const __attribute__((address_space(3))) bf16x8*)(kp+6144); kf[7]=*(const __attribute__((address_space(3))) bf16x8*)(kp+6656);
}
__device__ __forceinline__ void kload2(bf16x8*kf,lds_cptr kp,int j){ kf[2*j]=*(const __attribute__((address_space(3))) bf16x8*)(kp+j*2048); kf[2*j+1]=*(const __attribute__((address_space(3))) bf16x8*)(kp+j*2048+512); }
__device__ __forceinline__ s16x4 vtr(lds_cptr p){ return __builtin_bit_cast(s16x4,__builtin_amdgcn_ds_read_tr16_b64_v4i16((__attribute__((address_space(3))) v4i16_t*)p)); }
__device__ __forceinline__ void pv(f32x16*o,int vb,bf16x8 pa0,bf16x8 pa1,bf16x8 pa2,bf16x8 pa3){
  #pragma unroll
  for(int d0=0;d0<2;++d0){s16x4 lo[4],hi[4];
    #pragma unroll
    for(int ks=0;ks<4;++ks){
      asm volatile("ds_read_b64_tr_b16 %0,%1 offset:%c2":"=&v"(lo[ks]):"v"(vb),"i"(d0*4096+ks*1024):"memory");
      asm volatile("ds_read_b64_tr_b16 %0,%1 offset:%c2":"=&v"(hi[ks]):"v"(vb),"i"(d0*4096+ks*1024+512):"memory");}
    asm volatile("s_waitcnt lgkmcnt(0)":::"memory");SBAR();
    #define PK(k) (bf16x8){lo[k][0],lo[k][1],lo[k][2],lo[k][3],hi[k][0],hi[k][1],hi[k][2],hi[k][3]}
    o[d0]=__builtin_amdgcn_mfma_f32_32x32x16_bf16(pa0,PK(0),o[d0],0,0,0);
    o[d0]=__builtin_amdgcn_mfma_f32_32x32x16_bf16(pa1,PK(1),o[d0],0,0,0);
    o[d0]=__builtin_amdgcn_mfma_f32_32x32x16_bf16(pa2,PK(2),o[d0],0,0,0);
    o[d0]=__builtin_amdgcn_mfma_f32_32x32x16_bf16(pa3,PK(3),o[d0],0,0,0);
    #undef PK
  }
}

#ifndef ATTN_STORE16
#define ATTN_STORE16(p,v) (*(u32x4*)(p)=(v))
#endif
template<int THRL> __device__ __forceinline__ void attn_unit(abf16*Qb,abf16*Ob,const abf16*__restrict__ Kh,const abf16*__restrict__ Vh,const int NT,char*shm,const int tid,const float mref){
  const int lane=tid&63,r32=lane&31,hi=lane>>5; const int wid=__builtin_amdgcn_readfirstlane(tid>>6);
  const abf16*Qw=Qb+(long)(wid*QBLK)*DM;
  const unsigned lds0=(unsigned)(uintptr_t)shm;
  float*wsf=(float*)(shm+LDS_WS)+wid*64;
  const abf16*ksrc=Kh+(long)lane*KVPITCH+wid*8;
  const abf16*vsrc=Vh+(long)(16*(wid&3)+(lane>>2))*KVPITCH+(wid>>2)*32+(lane&3)*8;
  const unsigned kdst=lds0+LDS_K+wid*1024, vdst=lds0+LDS_V+wid*1024;
  #define DMA_K(t,slot) glds16(ksrc+(long)(t)*KVBLK*KVPITCH,(unsigned)__builtin_amdgcn_readfirstlane(kdst+(slot)))
  #define DMA_V(t,slot) glds16(vsrc+(long)(t)*KVBLK*KVPITCH,(unsigned)__builtin_amdgcn_readfirstlane(vdst+(slot)))
  const int vb0=(int)(lds0+LDS_V)+((lane>>4)&1)*32+(lane&3)*8+(4*hi+((lane&15)>>2))*64;
  const char*Kbase=shm+LDS_K; bf16x8 kf[8];
  const lds_cptr shm3=(lds_cptr)shm; const lds_cptr kp0=shm3+LDS_K+hi*1024+r32*16; const lds_cptr vp0=shm3+LDS_V+((lane>>4)&1)*32+(lane&3)*8+(4*hi+((lane&15)>>2))*64;
  DMA_K(0,0);DMA_V(0,0);DMA_K(1,SLOTB);
  bf16x8 qr[4];
  #pragma unroll
  for(int d0=0;d0<4;++d0)qr[d0]=*reinterpret_cast<const bf16x8*>(&Qw[(long)r32*DM+d0*16+hi*8]);
  float l_reg=0.f;f32x16 o[2];o[0]=f32x16{};o[1]=f32x16{};f32x16 negm;
  #pragma unroll
  for(int r=0;r<16;++r)negm[r]=-mref;
  asm volatile("":"+v"(negm));
  #define CMASK(P0,P1,t) do{}while(0)
  #define START(P0,P1) do{ _Pragma("unroll") for(int r=0;r<16;++r)P0[r]=__builtin_amdgcn_exp2f(P0[r]); }while(0)
  #define RESC() do{}while(0)
  f32x16 pA0,pA1,pB0,pB1;
  int sl_prev=0,sl_cur=0,sl_next=SLOTB;
  #define ROT() do{sl_prev=sl_cur;sl_cur=sl_next;sl_next=(sl_next==(NSLOT-1)*SLOTB)?0:sl_next+SLOTB;}while(0)
  DMA_K(2,2*SLOTB);
  WAIT_BAR(3);
  qkt(pA0,pA1,Kbase,qr,negm,r32,hi);asm volatile("s_nop 15\n\ts_nop 7":"+v"(pA0),"+v"(pA1));CMASK(pA0,pA1,0);
  START(pA0,pA1);
  _Pragma("unroll") for(int r=0;r<16;++r)pA1[r]=__builtin_amdgcn_exp2f(pA1[r]);
  WAIT_BAR(0);
  DMA_K(3,0);DMA_V(1,SLOTB);
  ROT();
  kload8(kf,kp0+sl_cur);
  WAIT_BAR(2);
  s16x4 vlo[8],vhi[8]; u32x4 pw0,pw1,pw2,pw3;
  #define PKW(P,B) cvtpk_s(P[B],P[B+1])
  #define PAF(k) __builtin_bit_cast(bf16x8,pw##k)
  #define VFR(i) (bf16x8){vlo[i][0],vlo[i][1],vlo[i][2],vlo[i][3],vhi[i][0],vhi[i][1],vhi[i][2],vhi[i][3]}
  #define PIN(x) asm volatile("":"+v"(x))
  #define MX3(a,b,c) __builtin_fmaxf(__builtin_fmaxf((a),(b)),(c))
  #define GAPA(MF,A0,A1,A2,A3,W0,W1,PW) do{ MF; sacc+=A0; sacc+=A1; sacc+=A2; sacc+=A3; PIN(sacc); W0; W1; PIN(PW); SBAR(); }while(0)
  #define EX(v) __builtin_amdgcn_exp2f(v)
  #define GAPB(MF,X,B) do{ MF; X[B]=EX(X[B]); X[B+1]=EX(X[B+1]); X[B+2]=EX(X[B+2]); X[B+3]=EX(X[B+3]); PIN(X); SBAR(); }while(0)
  #define VRD(i) do{ vlo[i]=vtr(vp_+(((i)>>2)*4096+((i)&3)*1024)); vhi[i]=vtr(vp_+(((i)>>2)*4096+((i)&3)*1024+512)); }while(0)
  #define KRD(G,j) do{ if(G){ kload2(kf,kp0+sl_next,j); SBAR(); } }while(0)
  #define STEP(C0,C1,P0,P1,t,GK,GV,GL) do{ SBAR(); \
    const lds_cptr vp_=vp0+sl_prev; \
    VRD(0); SBAR(); float sacc=(P0[0]+P0[1]); \
    GAPA(C0=__builtin_amdgcn_mfma_f32_32x32x16_bf16(kf[0],qr[0],negm,0,0,0), P0[2],P0[3],P0[4],P0[5],     pw0[0]=PKW(P0,0), pw0[1]=PKW(P0,2), pw0); \
    VRD(4); SBAR(); GAPA(C1=__builtin_amdgcn_mfma_f32_32x32x16_bf16(kf[1],qr[0],negm,0,0,0), P0[6],P0[7],P0[8],P0[9],     pw0[2]=PKW(P0,4), pw0[3]=PKW(P0,6), pw0); \
    VRD(1); SBAR(); GAPA(C0=__builtin_amdgcn_mfma_f32_32x32x16_bf16(kf[2],qr[1],C0,0,0,0),   P0[10],P0[11],P0[12],P0[13], pw1[0]=PKW(P0,8), pw1[1]=PKW(P0,10), pw1); \
    VRD(5); SBAR(); GAPA(C1=__builtin_amdgcn_mfma_f32_32x32x16_bf16(kf[3],qr[1],C1,0,0,0),   P0[14],P0[15],P1[0],P1[1],   pw1[2]=PKW(P0,12),pw1[3]=PKW(P0,14), pw1); \
    VRD(2); SBAR(); GAPA(C0=__builtin_amdgcn_mfma_f32_32x32x16_bf16(kf[4],qr[2],C0,0,0,0),   P1[2],P1[3],P1[4],P1[5],     pw2[0]=PKW(P1,0), pw2[1]=PKW(P1,2), pw2); \
    VRD(6); SBAR(); GAPA(C1=__builtin_amdgcn_mfma_f32_32x32x16_bf16(kf[5],qr[2],C1,0,0,0),   P1[6],P1[7],P1[8],P1[9],     pw2[2]=PKW(P1,4), pw2[3]=PKW(P1,6), pw2); \
    VRD(3); SBAR(); GAPA(C0=__builtin_amdgcn_mfma_f32_32x32x16_bf16(kf[6],qr[3],C0,0,0,0),   P1[10],P1[11],P1[12],P1[13], pw3[0]=PKW(P1,8), pw3[1]=PKW(P1,10), pw3); \
    VRD(7); SBAR(); GAPA(C1=__builtin_amdgcn_mfma_f32_32x32x16_bf16(kf[7],qr[3],C1,0,0,0),   P1[14],P1[15],0.f,0.f,       pw3[2]=PKW(P1,12),pw3[3]=PKW(P1,14), pw3); \
    l_reg+=sacc; \
    if(GK){DMA_K((t)+3,sl_cur);} if(GV){DMA_V((t)+1,sl_next);} \
    CMASK(C0,C1,t); \
    SBAR(); \
    GAPB(o[0]=__builtin_amdgcn_mfma_f32_32x32x16_bf16(PAF(0),VFR(0),o[0],0,0,0), C0,0); \
    GAPB(o[1]=__builtin_amdgcn_mfma_f32_32x32x16_bf16(PAF(0),VFR(4),o[1],0,0,0), C0,4); \
    KRD(GL,0); GAPB(o[0]=__builtin_amdgcn_mfma_f32_32x32x16_bf16(PAF(1),VFR(1),o[0],0,0,0), C0,8); \
    KRD(GL,1); GAPB(o[1]=__builtin_amdgcn_mfma_f32_32x32x16_bf16(PAF(1),VFR(5),o[1],0,0,0), C0,12); \
    KRD(GL,2); GAPB(o[0]=__builtin_amdgcn_mfma_f32_32x32x16_bf16(PAF(2),VFR(2),o[0],0,0,0), C1,0); \
    KRD(GL,3); GAPB(o[1]=__builtin_amdgcn_mfma_f32_32x32x16_bf16(PAF(2),VFR(6),o[1],0,0,0), C1,4); \
    GAPB(o[0]=__builtin_amdgcn_mfma_f32_32x32x16_bf16(PAF(3),VFR(3),o[0],0,0,0), C1,8); \
    GAPB(o[1]=__builtin_amdgcn_mfma_f32_32x32x16_bf16(PAF(3),VFR(7),o[1],0,0,0), C1,12); \
    }while(0)
  int t=1;
  #undef CMASK
  #define CMASK(P0,P1,t) do{}while(0)
  for(;t+5<NT;t+=2){
    STEP(pB0,pB1,pA0,pA1,t,true,true,true);     WAIT_BAR(2); RESC(); ROT();
    STEP(pA0,pA1,pB0,pB1,t+1,true,true,true);   WAIT_BAR(2); RESC(); ROT();
  }
  #undef CMASK
  #define CMASK(P0,P1,t) do{}while(0)
  #define ENDW(tt) do{ if((tt)+3<NT){WAIT_BAR(2);} else if((tt)+2<NT){WAIT_BAR(1);} else {WAIT_BAR(0);} }while(0)
  for(;t+1<NT;t+=2){
    STEP(pB0,pB1,pA0,pA1,t,(t+3<NT),(t+1<NT),(t+1<NT));       ENDW(t);   RESC(); ROT();
    STEP(pA0,pA1,pB0,pB1,t+1,(t+4<NT),(t+2<NT),(t+2<NT));     ENDW(t+1); RESC(); ROT();
  }
  STEP(pB0,pB1,pA0,pA1,NT-1,false,false,false); RESC();
  { float sacc=pB0[0]+pB0[1]; _Pragma("unroll") for(int r=2;r<16;++r)sacc+=pB0[r]; _Pragma("unroll") for(int r=0;r<16;++r)sacc+=pB1[r]; l_reg+=sacc;
    pw0=(u32x4){PKW(pB0,0),PKW(pB0,2),PKW(pB0,4),PKW(pB0,6)};pw1=(u32x4){PKW(pB0,8),PKW(pB0,10),PKW(pB0,12),PKW(pB0,14)};pw2=(u32x4){PKW(pB1,0),PKW(pB1,2),PKW(pB1,4),PKW(pB1,6)};pw3=(u32x4){PKW(pB1,8),PKW(pB1,10),PKW(pB1,12),PKW(pB1,14)};
    SBAR(); pv(o,vb0+sl_cur,PAF(0),PAF(1),PAF(2),PAF(3)); }
  #undef PKW
  #undef PAF
  #undef VFR
  #undef PIN
  #undef MX3
  #undef GAPA
  #undef GAPB
  #undef EX
  #undef VRD
  #undef KRD
  #undef STEP
  #undef ENDW
  {auto rr=__builtin_amdgcn_permlane32_swap(__float_as_uint(l_reg),__float_as_uint(l_reg),false,false);l_reg=__uint_as_float(rr[0])+__uint_as_float(rr[1]);}
  if(hi==0)wsf[32+r32]=l_reg;asm volatile("s_waitcnt lgkmcnt(0)":::"memory");
  float rli[16];
  #pragma unroll
  for(int r=0;r<16;++r)rli[r]=__builtin_amdgcn_rcpf(wsf[32+crow(r,hi)]);
  abf16*Ow=Ob+(long)(wid*QBLK)*DM;
  { abf16*stg=(abf16*)(shm+LDS_OST)+wid*2048;
    #pragma unroll
    for(int r=0;r<16;++r){const int orow=crow(r,hi);
      #pragma unroll
      for(int d0=0;d0<2;++d0)stg[orow*64+d0*32+r32]=__float2bfloat16(o[d0][r]*rli[r]);}
    asm volatile("s_waitcnt lgkmcnt(0)":::"memory");
    #pragma unroll
    for(int i=0;i<4;++i){const int row=i*8+(lane>>3),ch=lane&7; const u32x4 v=*(const u32x4*)(stg+row*64+ch*8); ATTN_STORE16(Ow+(long)row*DM+ch*8,v);} }
  asm volatile("s_waitcnt lgkmcnt(0)\n\ts_barrier":::"memory");
  #undef DMA_K
  #undef DMA_V
  #undef CMASK
  #undef START
  #undef RESC
  #undef ROT
}
constexpr int ATTN_LDS_BYTES=LDS_BYTES;
#undef SBAR
#undef WAIT_BAR
}

__device__ __forceinline__ void phase_attn_fast(const Ctx& C, int l, bool dummy_out = false) {
    using attn_body::abf16;
    abf16* MIX = (abf16*)(C.ws + WS_MIX); const abf16* KB = (const abf16*)(C.ws + WS_KB); const abf16* VB = (const abf16*)(C.ws + WS_VB);
    const int nctx = (l == 0) ? 64 : 0;
    float mq = fabsf(C.g_q[l * 64 + C.lane]), mk = fabsf(C.g_k[l * 64 + C.lane]);
#pragma unroll
    for (int o = 1; o < 64; o <<= 1) { mq = fmaxf(mq, shx(mq, o, C.lane)); mk = fmaxf(mk, shx(mk, o, C.lane)); }
    const float mref = fminf(64.0f * C2 * mq * mk * 1.02f + 0.5f, 96.0f);
    for (int i = 0;; ++i) {
        int U;
        if (C.G == 256) {
            if (i < 4) U = (C.vcu >> 5) * 128 + i * 32 + (C.vcu & 31);
            else if (i == 4 && nctx && (C.vcu & 3) == 0) U = 1024 + (C.vcu >> 2);
            else break;
        } else { U = i * C.G + C.vcu; if (U >= 1024 + nctx) break; }
        int b, h, qrow, key0, NT;
        if (U < 1024) { const int g = U >> 6, r = U & 63; b = g >> 1; h = (g & 1) * 4 + (r >> 4); qrow = b * SEQ + (r & 15) * 256; key0 = 0; NT = KVROWS / 64; }
        else { const int id = U - 1024; b = id >> 3; h = id & 7; qrow = M_LAT + b * CTXL; key0 = SEQ; NT = CTXL / 64; }
        const size_t kvoff = ((size_t)b * KVROWS + key0) * KVP + (h >> 2) * 64;
        abf16* Obase = dummy_out ? (abf16*)(C.ws + WS_AP) : MIX;
        attn_body::attn_unit<8>(MIX + (size_t)qrow * DM + h * 64, Obase + (size_t)qrow * DM + h * 64, KB + kvoff, VB + kvoff, NT, C.lds_gen, C.tid, mref);
    }
}

__device__ __forceinline__ void ffn_fix_panel(const Ctx& C, int l, int pm) {
    const bf16* EDGE = WSP(bf16, WS_EDGE); bf16* ACT = WSP(bf16, WS_ACT);
    for (int idx = C.tid; idx < 2 * 352; idx += NTHREADS) {
        const int side = idx >= 352 ? 1 : 0, j0 = (idx - side * 352) * 8, R = pm * 256;
        bool first, last; if (pm < 128) { first = (R & 4095) == 0; last = ((R + 255) & 4095) == 4095; } else { first = true; last = true; }
        const bf16 *pu, *px, *pd; bool hu, hd; int row;
        if (side == 0) { row = R; hu = !first; hd = true; pu = EDGE + (size_t)((pm - 1) * 4 + 3) * NUP; px = EDGE + (size_t)(pm * 4 + 0) * NUP; pd = EDGE + (size_t)(pm * 4 + 1) * NUP; }
        else { row = R + 255; hu = true; hd = !last; pu = EDGE + (size_t)(pm * 4 + 2) * NUP; px = EDGE + (size_t)(pm * 4 + 3) * NUP; pd = EDGE + (size_t)((pm + 1) * 4 + 0) * NUP; }
        float au[8], ag[8];
#pragma unroll
        for (int e = 0; e < 8; ++e) { au[e] = 0.f; ag[e] = 0.f; }
#pragma unroll
        for (int k = 0; k < 3; ++k) { const bool has = (k == 0) ? hu : (k == 2) ? hd : true; const bf16* rp = ((k == 0) ? pu : (k == 2) ? pd : px) + j0;
            if (has) { float u[8], g[8]; unpack8(*(const v4u*)rp, u); unpack8(*(const v4u*)(rp + DFF), g);
                const float* wu = C.ffn_conv_w + (size_t)(l * 3 + k) * NUP + j0; const f32x4 wu0 = *(const f32x4*)wu, wu1 = *(const f32x4*)(wu + 4), wg0 = *(const f32x4*)(wu + DFF), wg1 = *(const f32x4*)(wu + DFF + 4);
#pragma unroll
                for (int e = 0; e < 4; ++e) { au[e] += wu0[e] * u[e]; au[4 + e] += wu1[e] * u[4 + e]; ag[e] += wg0[e] * g[e]; ag[4 + e] += wg1[e] * g[4 + e]; } } }
        float o[8];
#pragma unroll
        for (int e = 0; e < 8; ++e) o[e] = silu_(ag[e]) * au[e];
        *(v4u*)(ACT + (size_t)row * DFF + j0) = pack8(o);
    }
}
__device__ __forceinline__ void phase_final(const Ctx& C) {
    const float* __restrict__ STA = WSP(float, WS_STA); const bf16* __restrict__ XR = WSP(bf16, WS_XR);
    f32x4 g[2][2];
#pragma unroll
    for (int j = 0; j < 2; ++j) { g[j][0] = *(const f32x4*)(C.g_final + C.lane * 8 + 512 * j); g[j][1] = *(const f32x4*)(C.g_final + C.lane * 8 + 512 * j + 4); }
    for (int m = C.gw; m < M_LAT; m += C.NGW) {
        float s = STA[(size_t)m * 16 + (C.lane & 15)];
        v4u w[2];
#pragma unroll
        for (int j = 0; j < 2; ++j) w[j] = *(const v4u*)(XR + (size_t)m * DM + C.lane * 8 + 512 * j);
        s += shx(s, 1, C.lane); s += shx(s, 2, C.lane); s += shx(s, 4, C.lane); s += shx(s, 8, C.lane);
        const float r = rsqrtf(s * (1.0f / DM) + EPS);
#pragma unroll
        for (int j = 0; j < 2; ++j) { float x[8]; unpack8(w[j], x); float* o = C.out + (size_t)m * DM + C.lane * 8 + 512 * j;
            *(f32x4*)o = (f32x4){x[0], x[1], x[2], x[3]} * r * g[j][0]; *(f32x4*)(o + 4) = (f32x4){x[4], x[5], x[6], x[7]} * r * g[j][1]; }
    }
}

namespace pg8 {
#define PG8_LAS __attribute__((address_space(3)))
typedef unsigned short bf16_t;
typedef short bf16x8 __attribute__((ext_vector_type(8)));
typedef float f32x4 __attribute__((ext_vector_type(4)));
typedef unsigned u32x4 __attribute__((ext_vector_type(4)));
constexpr int BM = 256, BK = 64, HALF = 128, HTB = HALF * BK * 2  , STAGE_BYTES = 8 * HTB, NXCD = 8, WGM = 8;

__host__ __device__ __forceinline__ int lds_byte(int r, int c) { const int st = (r >> 4) * 2 + (c >> 5), rr = r & 15, cc = c & 31, ob = rr * 64 + cc * 2; return st * 1024 + (ob ^ (((ob >> 9) & 1) << 5)); }
__host__ __device__ __forceinline__ void stage_rc(int b, int& R, int& C) { const int st = b / 1024, sb = b % 1024, swz = sb ^ (((sb >> 9) & 1) << 5); R = (st >> 1) * 16 + swz / 64; C = (st & 1) * 32 + (swz % 64) / 2; }
__host__ __device__ __forceinline__ int perm32(int rho) { const int n = rho >> 4, i = rho & 15; return 8 * (i >> 2) + 4 * n + (i & 3); }

struct Unit { int pm, pn; };
struct Gemm { const bf16_t* A; const bf16_t* Bt; int M, N, K; int ksub = 0; };

struct StaticOrder {
    int nM, nN, nwg, G, c;
    __host__ __device__ void init(int M, int N, int G_, int c_) { nM = M / BM; nN = N / BM; nwg = nM * nN; G = G_; c = c_; }
    __host__ __device__ bool next(int i, Unit& u) const {
        const long L = (long)i * G + c; if (L >= nwg) return false;
        int wgid = (int)L; { const int q = nwg / NXCD, r = nwg % NXCD, xcd = wgid % NXCD, off = wgid / NXCD; wgid = (xcd < r ? xcd * (q + 1) : r * (q + 1) + (xcd - r) * q) + off; }
        const int nig = WGM * nN, gid = wgid / nig, fm = gid * WGM, gsz = (nM - fm) < WGM ? (nM - fm) : WGM;
        u.pm = fm + ((wgid % nig) % gsz); u.pn = (wgid % nig) / gsz; return true;
    }
    __device__ __forceinline__ void a_ready(const Unit&) const {}
    __device__ __forceinline__ void done(const Unit&) const {}
};


template <class Epi, class Sched, bool ALIGN_EPI = false, bool SP2 = false>
__device__ __forceinline__ void gemm_phase(PG8_LAS unsigned char* lds, const Gemm g, const Sched& S, const Epi& E, const int tid) {
    const int wid = __builtin_amdgcn_readfirstlane(tid >> 6), lane = tid & 63, wr = wid >> 2, wc = wid & 3, fr = lane & 15, fq = lane >> 4;
    const int K = g.K, nt = (g.ksub ? g.ksub : K) / BK;
#define PG8_KOF(u) (g.ksub ? (size_t)((u).pn & 1) * (size_t)g.ksub * 2 : (size_t)0)
    unsigned voffA[2], voffB[2];
#pragma unroll
    for (int i = 0; i < 2; ++i) { int R, C; stage_rc(tid * 16 + i * 8192, R, C); const int Rb = Epi::PERM ? ((R & ~31) + perm32(R & 31)) : R;
        voffA[i] = (unsigned)(R * K + C) * 2u; voffB[i] = (unsigned)(Rb * K + C) * 2u; }
    const size_t kstep = (size_t)(BK * 2);
    const size_t hstep = (size_t)HALF * K * 2;
    const size_t tstep = 2 * hstep;
    const unsigned ldsw = (unsigned)wid * 1024u;
    const int aoff = lds_byte(wr * 64 + fr, fq * 8), boff = lds_byte(wc * 32 + fr, fq * 8);
#define PG8_SA(b, h) (((b) * 2 + (h)) * HTB)
#define PG8_SB(b, h) ((4 + (b) * 2 + (h)) * HTB)
#define PG8_STAGE(bufoff, gbase, voff) do { _Pragma("unroll") for (int _i = 0; _i < 2; ++_i) \
        __builtin_amdgcn_global_load_lds((const unsigned*)((const char*)(gbase) + (voff)[_i]), (PG8_LAS unsigned*)(lds + (bufoff) + ldsw + _i * 8192), 16, 0, 0); } while (0)
#define PG8_LDA(dst, b, h) do { _Pragma("unroll") for (int m = 0; m < 4; ++m) _Pragma("unroll") for (int k = 0; k < 2; ++k) dst[m][k] = *(const PG8_LAS bf16x8*)(lds + PG8_SA(b, h) + aoff + m * 2048 + k * 1024); } while (0)
#define PG8_LDB(dst, b, h) do { _Pragma("unroll") for (int n = 0; n < 2; ++n) _Pragma("unroll") for (int k = 0; k < 2; ++k) dst[n][k] = *(const PG8_LAS bf16x8*)(lds + PG8_SB(b, h) + boff + n * 2048 + k * 1024); } while (0)
#define PG8_MMA(ai, bj, At, Bt) do { __builtin_amdgcn_s_setprio(1); _Pragma("unroll") for (int m = 0; m < 4; ++m) _Pragma("unroll") for (int n = 0; n < 2; ++n) _Pragma("unroll") for (int k = 0; k < 2; ++k) \
        acc[ai][bj][m][n] = __builtin_amdgcn_mfma_f32_16x16x32_bf16(Bt[n][k], At[m][k], acc[ai][bj][m][n], 0, 0, 0); __builtin_amdgcn_s_setprio(0); } while (0)
#define PG8_WAIT_V(n) asm volatile("s_waitcnt vmcnt(" #n ")" ::: "memory")
#define PG8_WAIT_L(n) asm volatile("s_waitcnt lgkmcnt(" #n ")" ::: "memory")
#define PG8_BAR __builtin_amdgcn_s_barrier()
#define PG8_SCHED __builtin_amdgcn_sched_barrier(0)
    Unit cur, nxt; int ui = 0;
    if (!S.next(0, cur)) return;
    f32x4 acc[2][2][4][2];
#pragma unroll
    for (int a = 0; a < 2; ++a)
#pragma unroll
        for (int b = 0; b < 2; ++b)
#pragma unroll
            for (int m = 0; m < 4; ++m)
#pragma unroll
                for (int n = 0; n < 2; ++n) acc[a][b][m][n] = (f32x4){0.f, 0.f, 0.f, 0.f};
    bf16x8 At[4][2], B0[2][2], B1[2][2];
    const char* cA = (const char*)g.A + (size_t)cur.pm * tstep + PG8_KOF(cur); const char* cB = (const char*)g.Bt + (size_t)cur.pn * tstep + PG8_KOF(cur);
    S.a_ready(cur);
    if constexpr (SP2) {
        PG8_STAGE(PG8_SB(0, 0), cB, voffB); PG8_STAGE(PG8_SB(0, 1), cB + hstep, voffB); PG8_STAGE(PG8_SA(0, 0), cA, voffA); PG8_STAGE(PG8_SA(0, 1), cA + hstep, voffA);
        if (wr == 1) PG8_BAR;
        PG8_WAIT_V(2); PG8_BAR;
        PG8_STAGE(PG8_SB(1, 0), cB + kstep, voffB); PG8_STAGE(PG8_SA(1, 0), cA + kstep, voffA); PG8_STAGE(PG8_SB(1, 1), cB + hstep + kstep, voffB);
        PG8_WAIT_V(6); PG8_BAR;
    } else {
        PG8_STAGE(PG8_SB(0, 0), cB, voffB); PG8_STAGE(PG8_SA(0, 0), cA, voffA); PG8_STAGE(PG8_SB(0, 1), cB + hstep, voffB); PG8_STAGE(PG8_SA(0, 1), cA + hstep, voffA);
        if (wr == 1) PG8_BAR;
        PG8_WAIT_V(4); PG8_BAR;
        PG8_STAGE(PG8_SB(1, 0), cB + kstep, voffB); PG8_STAGE(PG8_SA(1, 0), cA + kstep, voffA); PG8_STAGE(PG8_SB(1, 1), cB + hstep + kstep, voffB);
        PG8_WAIT_V(6); PG8_BAR;
    }
    for (;;) {
        const bool has_next = S.next(ui + 1, nxt);
        const char* nA = has_next ? (const char*)g.A + (size_t)nxt.pm * tstep + PG8_KOF(nxt) : cA; const char* nB = has_next ? (const char*)g.Bt + (size_t)nxt.pn * tstep + PG8_KOF(nxt) : cB;
        for (int t = 0; t < nt; t += 2) {
            const bool last = (t == nt - 2);
            const char* a1 = cA + (size_t)(t + 1) * kstep;
            const char* a2 = last ? nA : cA + (size_t)(t + 2) * kstep; const char* b2 = last ? nB : cB + (size_t)(t + 2) * kstep;
            const char* a3 = a2 + kstep; const char* b3 = b2 + kstep;
            if (last && has_next) S.a_ready(nxt);
            if constexpr (SP2) {
            PG8_LDB(B0, 0, 0); PG8_LDB(B1, 0, 1); PG8_SCHED; PG8_LDA(At, 0, 0); PG8_STAGE(PG8_SA(1, 1), a1 + hstep, voffA);
            PG8_WAIT_V(8); PG8_WAIT_L(0); PG8_BAR; PG8_MMA(0, 0, At, B0); PG8_MMA(0, 1, At, B1); PG8_BAR; PG8_SCHED;
            PG8_LDA(At, 0, 1); PG8_STAGE(PG8_SB(0, 0), b2, voffB); PG8_STAGE(PG8_SB(0, 1), b2 + hstep, voffB); PG8_STAGE(PG8_SA(0, 0), a2, voffA);
            PG8_WAIT_V(8); PG8_WAIT_L(0); PG8_BAR; PG8_MMA(1, 0, At, B0); PG8_MMA(1, 1, At, B1); PG8_BAR; PG8_SCHED;
            PG8_LDB(B0, 1, 0); PG8_LDB(B1, 1, 1); PG8_SCHED; PG8_LDA(At, 1, 0); PG8_STAGE(PG8_SA(0, 1), a2 + hstep, voffA);
            PG8_WAIT_V(8); PG8_WAIT_L(0); PG8_BAR; PG8_MMA(0, 0, At, B0); PG8_MMA(0, 1, At, B1); PG8_BAR; PG8_SCHED;
            PG8_LDA(At, 1, 1); PG8_STAGE(PG8_SB(1, 0), b3, voffB); PG8_STAGE(PG8_SB(1, 1), b3 + hstep, voffB); PG8_STAGE(PG8_SA(1, 0), a3, voffA);
            PG8_WAIT_V(8); PG8_WAIT_L(0); PG8_BAR; PG8_MMA(1, 0, At, B0); PG8_MMA(1, 1, At, B1); PG8_BAR; PG8_SCHED;
            } else {
            PG8_LDB(B0, 0, 0); PG8_SCHED; PG8_LDA(At, 0, 0); PG8_STAGE(PG8_SA(1, 1), a1 + hstep, voffA);
            PG8_WAIT_L(8); PG8_BAR; PG8_WAIT_L(0); PG8_MMA(0, 0, At, B0); PG8_BAR; PG8_SCHED;
            PG8_LDB(B1, 0, 1); PG8_STAGE(PG8_SB(0, 0), b2, voffB);
            PG8_BAR; PG8_WAIT_L(0); PG8_MMA(0, 1, At, B1); PG8_BAR;
            PG8_LDA(At, 0, 1); PG8_STAGE(PG8_SA(0, 0), a2, voffA);
            PG8_BAR; PG8_WAIT_L(0); PG8_MMA(1, 0, At, B0); PG8_BAR; PG8_SCHED;
            PG8_STAGE(PG8_SB(0, 1), b2 + hstep, voffB);
            PG8_WAIT_V(6); PG8_BAR; PG8_MMA(1, 1, At, B1); PG8_BAR;
            PG8_LDB(B0, 1, 0); PG8_SCHED; PG8_LDA(At, 1, 0); PG8_STAGE(PG8_SA(0, 1), a2 + hstep, voffA);
            PG8_WAIT_L(8); PG8_BAR; PG8_WAIT_L(0); PG8_MMA(0, 0, At, B0); PG8_BAR; PG8_SCHED;
            PG8_LDB(B1, 1, 1); PG8_STAGE(PG8_SB(1, 0), b3, voffB);
            PG8_BAR; PG8_WAIT_L(0); PG8_MMA(0, 1, At, B1); PG8_BAR;
            PG8_LDA(At, 1, 1); PG8_STAGE(PG8_SA(1, 0), a3, voffA);
            PG8_BAR; PG8_WAIT_L(0); PG8_MMA(1, 0, At, B0); PG8_BAR; PG8_SCHED;
            PG8_STAGE(PG8_SB(1, 1), b3 + hstep, voffB);
            PG8_WAIT_V(6); PG8_BAR; PG8_MMA(1, 1, At, B1); PG8_BAR;
            }
        }
        if constexpr (ALIGN_EPI) { if (wr == 0) PG8_BAR; }
        if constexpr (!Epi::AFTER_DRAIN) { E(acc, cur, wr, wc, fr, fq); S.done(cur); }
        if (!has_next) break;
#pragma unroll
        for (int a = 0; a < 2; ++a)
#pragma unroll
            for (int b = 0; b < 2; ++b)
#pragma unroll
                for (int m = 0; m < 4; ++m)
#pragma unroll
                    for (int n = 0; n < 2; ++n) acc[a][b][m][n] = (f32x4){0.f, 0.f, 0.f, 0.f};
        cur = nxt; cA = nA; cB = nB; ++ui;
        if constexpr (ALIGN_EPI) { if (wr == 1) PG8_BAR; }
    }
    PG8_WAIT_V(0);
    if constexpr (!ALIGN_EPI) { if (wr == 0) PG8_BAR; }
    PG8_BAR;
    if constexpr (Epi::AFTER_DRAIN) { E.fused(acc, cur, wr, wc, fr, fq, lds, wid, lane); S.done(cur); }
#undef PG8_KOF
#undef PG8_SA
#undef PG8_SB
#undef PG8_STAGE
#undef PG8_LDA
#undef PG8_LDB
#undef PG8_MMA
#undef PG8_WAIT_V
#undef PG8_WAIT_L
#undef PG8_BAR
#undef PG8_SCHED
}
}


struct FastProj {
    static constexpr bool PERM = true, AFTER_DRAIN = false; ProjEpi e; LAS unsigned char* xl;
    __device__ __forceinline__ void operator()(const f32x4 (&acc)[2][2][4][2], const pg8::Unit& u, int wr, int wc, int fr, int fq) const {
        asm volatile("" : "+v"(fr), "+v"(fq));
        LAS float* HS = (LAS float*)xl;
        LAS float* GL = (LAS float*)(xl + 8192);
        const int lrow0 = u.pm * 256 + wr * 64 + fr, grow0 = e.row_off + lrow0, bi = row_bi(e.row_off + u.pm * 256), col0 = u.pn * 256 + wc * 32 + 8 * fq, lane = fq * 16 + fr;
        const int gtile = e.tile0 + u.pn, hsub = wc >> 1, half = wc & 1, tid = (wr * 4 + wc) * 64 + lane;
        const bool qkv = gtile < 3, isq = gtile < 2;
        float rsv[2][4];
        { f32x4 sv[2][4];
#pragma unroll
          for (int ai = 0; ai < 2; ++ai)
#pragma unroll
              for (int m = 0; m < 4; ++m) sv[ai][m] = *(const f32x4*)(e.stats + (size_t)(grow0 + ai * 128 + m * 16) * 16 + fq * 4);
          if (tid < 128) GL[tid] = tid < 64 ? e.gq[tid] : e.gk[tid - 64];
#pragma unroll
          for (int ai = 0; ai < 2; ++ai)
#pragma unroll
              for (int m = 0; m < 4; ++m) { float s = (sv[ai][m].x + sv[ai][m].y) + (sv[ai][m].z + sv[ai][m].w); s += shx(s, 16, lane); s += shx(s, 32, lane); rsv[ai][m] = rsqrtf(s * (1.0f / DM) + EPS); } }
        f32x4 bv[2][2];
#pragma unroll
        for (int bj = 0; bj < 2; ++bj)
#pragma unroll
            for (int n = 0; n < 2; ++n) bv[bj][n] = *(const f32x4*)(e.bias + (size_t)bi * e.ldb + col0 + bj * 128 + 4 * n);
        if (qkv) {
#pragma unroll
            for (int ai = 0; ai < 2; ++ai)
#pragma unroll
                for (int m = 0; m < 4; ++m)
#pragma unroll
                    for (int bj = 0; bj < 2; ++bj) { const f32x4 v0 = acc[ai][bj][m][0] * rsv[ai][m] + bv[bj][0], v1 = acc[ai][bj][m][1] * rsv[ai][m] + bv[bj][1];
                        float q = ((v0.x * v0.x + v0.y * v0.y) + (v0.z * v0.z + v0.w * v0.w)) + ((v1.x * v1.x + v1.y * v1.y) + (v1.z * v1.z + v1.w * v1.w));
                        q += shx(q, 16, lane); q += shx(q, 32, lane);
                        if (fq == 0) HS[((ai * 128 + wr * 64 + m * 16 + fr) * 4 + 2 * bj + hsub) * 2 + half] = q; }
        }
        asm volatile("s_waitcnt lgkmcnt(0)" ::: "memory"); __builtin_amdgcn_s_barrier(); asm volatile("" ::: "memory");
        const int ib = 16 * half + 4 * fq;
#pragma unroll
        for (int ai = 0; ai < 2; ++ai)
#pragma unroll
            for (int m = 0; m < 4; ++m) { int grow = grow0 + ai * 128 + m * 16, hrow = ai * 128 + wr * 64 + m * 16 + fr, lrow = lrow0 + ai * 128 + m * 16;
                asm volatile("" : "+v"(grow), "+v"(hrow), "+v"(lrow));
                const float rs = rsv[ai][m];
                if (!qkv) {
                    bf16* rowp = e.Cout + (size_t)lrow * e.ldc + col0;
#pragma unroll
                    for (int bj = 0; bj < 2; ++bj) { const f32x4 v0 = acc[ai][bj][m][0] * rs + bv[bj][0], v1 = acc[ai][bj][m][1] * rs + bv[bj][1];
                        v4u w; w.x = pk2(v0.x, v0.y); w.y = pk2(v0.z, v0.w); w.z = pk2(v1.x, v1.y); w.w = pk2(v1.z, v1.w); *(v4u*)(rowp + bj * 128) = w; }
                } else {
                    const bool lat = grow < M_LAT; const int t = grow & 4095, pos = half ? (t & 63) : (t >> 6);
                    const f32x4 cs = *(const f32x4*)(e.ropeT + pos * 16 + 4 * fq), sn = *(const f32x4*)(e.ropeT + 1024 + pos * 16 + 4 * fq);
                    int b, kpos; if (lat) { b = grow >> 12; kpos = t; } else { const int mc = grow - M_LAT; b = mc >> 8; kpos = SEQ + (mc & 255); }
#pragma unroll
                    for (int bj = 0; bj < 2; ++bj) { const bool isv = (!isq) && (bj == 1);
                        const f32x2 hp = *(const LAS f32x2*)(HS + (hrow * 4 + 2 * bj + hsub) * 2); const float rinv = rsqrtf((hp.x + hp.y) * (1.0f / 64.0f) + EPS);
                        const int gsel = (isq ? 0 : 64);
                        const f32x4 ga = *(const LAS f32x4*)(GL + gsel + ib), gb = *(const LAS f32x4*)(GL + gsel + 32 + ib);
                        float o[8];
#pragma unroll
                        for (int n = 0; n < 2; ++n) { const f32x4 v = acc[ai][bj][m][n] * rs + bv[bj][n];
                            float a1 = v.x * rinv * ga[2 * n], a2 = v.y * rinv * gb[2 * n], b1 = v.z * rinv * ga[2 * n + 1], b2 = v.w * rinv * gb[2 * n + 1];
                            if (lat) { const float c0 = cs[2 * n], s0 = sn[2 * n], c1 = cs[2 * n + 1], s1 = sn[2 * n + 1];
                                const float ta = a1 * c0 - a2 * s0, tb = a1 * s0 + a2 * c0, tc = b1 * c1 - b2 * s1, td = b1 * s1 + b2 * c1; a1 = ta; a2 = tb; b1 = tc; b2 = td; }
                            const float sc = isq ? C2 : 1.0f;
                            o[4 * n] = isv ? v.x : a1 * sc; o[4 * n + 1] = isv ? v.y : a2 * sc; o[4 * n + 2] = isv ? v.z : b1 * sc; o[4 * n + 3] = isv ? v.w : b2 * sc; }
                        v4u w; w.x = pk2(o[0], o[1]); w.y = pk2(o[2], o[3]); w.z = pk2(o[4], o[5]); w.w = pk2(o[6], o[7]);
                        bf16* dq = e.MIX + (size_t)grow * DM + (gtile * 4 + 2 * bj + hsub) * 64 + 32 * half + 8 * fq;
                        bf16* dkv = (isv ? e.VB : e.KB) + ((size_t)b * KVROWS + kpos) * KVP + hsub * 64 + 32 * half + 8 * fq;
                        *(v4u*)(isq ? dq : dkv) = w; }
                }
                asm volatile("" ::: "memory"); __builtin_amdgcn_sched_barrier(0);
            }
    }
};
template <bool XIN_F32> struct FastRes {
    static constexpr bool PERM = true, AFTER_DRAIN = false; ResEpi e;
    __device__ __forceinline__ void operator()(const f32x4 (&acc)[2][2][4][2], const pg8::Unit& u, int wr, int wc, int fr, int fq) const {
        asm volatile("" : "+v"(fr), "+v"(fq));
        const int pmg = e.pm_off + u.pm, grow0 = pmg * 256 + wr * 64 + fr, bi = row_bi(pmg * 256), col8 = u.pn * 256 + wc * 32 + 8 * fq, lane = fq * 16 + fr;
        f32x4 gt[2][2], gg[2][2], gc[2][2], xf[2][2][2]; v4u xb[2][2];
#pragma unroll
        for (int bj = 0; bj < 2; ++bj) {
#pragma unroll
            for (int n = 0; n < 2; ++n) { const int c = col8 + bj * 128 + 4 * n; gt[bj][n] = *(const f32x4*)(e.gate + (size_t)bi * 6144 + c);
                gg[bj][n] = *(const f32x4*)(e.gn + c); gc[bj][n] = *(const f32x4*)(e.cn + (size_t)bi * 6144 + c);
                if (XIN_F32) xf[0][bj][n] = *(const f32x4*)(e.xi_row(grow0) + c); }
            if (!XIN_F32) xb[0][bj] = *(const v4u*)(e.XR + (size_t)grow0 * DM + col8 + bj * 128); }
#pragma unroll
        for (int bj = 0; bj < 2; ++bj)
#pragma unroll
            for (int n = 0; n < 2; ++n) gg[bj][n] = gg[bj][n] * (gc[bj][n] + 1.0f);
#pragma unroll
        for (int g = 0; g < 8; ++g) { const int ai = g >> 2, m = g & 3, grow = grow0 + ai * 128 + m * 16; float ss = 0.f;
            const int aprow = e.ap_perm ? (grow & ~63) + 16 * (grow & 3) + ((grow & 63) >> 2) : grow;
            if (g < 7) { const int grow1 = grow0 + ((g + 1) >> 2) * 128 + ((g + 1) & 3) * 16;
#pragma unroll
                for (int bj = 0; bj < 2; ++bj) {
                    if (XIN_F32) {
#pragma unroll
                        for (int n = 0; n < 2; ++n) xf[(g + 1) & 1][bj][n] = *(const f32x4*)(e.xi_row(grow1) + col8 + bj * 128 + 4 * n); }
                    else xb[(g + 1) & 1][bj] = *(const v4u*)(e.XR + (size_t)grow1 * DM + col8 + bj * 128); } }
#pragma unroll
            for (int bj = 0; bj < 2; ++bj) { f32x4 x0, x1;
                if (XIN_F32) { x0 = xf[g & 1][bj][0]; x1 = xf[g & 1][bj][1]; }
                else { const v4u w = xb[g & 1][bj]; x0 = (f32x4){bflo(w.x), bfhi(w.x), bflo(w.y), bfhi(w.y)}; x1 = (f32x4){bflo(w.z), bfhi(w.z), bflo(w.w), bfhi(w.w)}; }
                const f32x4 v0 = x0 + gt[bj][0] * acc[ai][bj][m][0], v1 = x1 + gt[bj][1] * acc[ai][bj][m][1];
                ss += ((v0.x * v0.x + v0.y * v0.y) + (v0.z * v0.z + v0.w * v0.w)) + ((v1.x * v1.x + v1.y * v1.y) + (v1.z * v1.z + v1.w * v1.w));
                v4u xo; xo.x = pk2(v0.x, v0.y); xo.y = pk2(v0.z, v0.w); xo.z = pk2(v1.x, v1.y); xo.w = pk2(v1.z, v1.w);
                *(v4u*)(e.XR + (size_t)grow * DM + col8 + bj * 128) = xo;
                if (e.has_ap) { const f32x4 a0 = v0 * gg[bj][0], a1 = v1 * gg[bj][1]; v4u w; w.x = pk2(a0.x, a0.y); w.y = pk2(a0.z, a0.w); w.z = pk2(a1.x, a1.y); w.w = pk2(a1.z, a1.w);
                    *(v4u*)(e.AP + (size_t)aprow * DM + col8 + bj * 128) = w; } }
            ss += shx(ss, 16, lane); ss += shx(ss, 32, lane);
            if (fq == 0) e.stats[(size_t)grow * 16 + u.pn * 4 + wc] = ss;
            asm volatile("" ::: "memory");
        }
    }
};

constexpr int CW_FIN = 8192;
struct FastResFinal {
    static constexpr bool PERM = true, AFTER_DRAIN = false; ResEpi e; const float* gfin; float* outp; float* XB; unsigned* ctl; LAS unsigned char* xl;
    __device__ __forceinline__ void operator()(f32x4 (&acc)[2][2][4][2], const pg8::Unit& u, int wr, int wc, int fr, int fq) const {
        asm volatile("" : "+v"(fr), "+v"(fq));
        LAS float* PL = (LAS float*)xl; LAS float* RS = (LAS float*)(xl + 4096);
        const int grow0 = u.pm * 256 + wr * 64 + fr, bi = row_bi(u.pm * 256), col8 = u.pn * 256 + wc * 32 + 8 * fq, tid = (wr * 4 + wc) * 64 + fq * 16 + fr, lane = fq * 16 + fr;
        f32x4 gt[2][2]; v4u xb[2][2];
#pragma unroll
        for (int bj = 0; bj < 2; ++bj) {
#pragma unroll
            for (int n = 0; n < 2; ++n) gt[bj][n] = *(const f32x4*)(e.gate + (size_t)bi * 6144 + col8 + bj * 128 + 4 * n);
            xb[0][bj] = *(const v4u*)(e.XR + (size_t)grow0 * DM + col8 + bj * 128); }
#pragma unroll
        for (int g = 0; g < 8; ++g) { const int ai = g >> 2, m = g & 3; float ss = 0.f;
            if (g < 7) { const int grow1 = grow0 + ((g + 1) >> 2) * 128 + ((g + 1) & 3) * 16;
#pragma unroll
                for (int bj = 0; bj < 2; ++bj) xb[(g + 1) & 1][bj] = *(const v4u*)(e.XR + (size_t)grow1 * DM + col8 + bj * 128); }
#pragma unroll
            for (int bj = 0; bj < 2; ++bj) { const v4u w = xb[g & 1][bj];
                const f32x4 x0 = (f32x4){bflo(w.x), bfhi(w.x), bflo(w.y), bfhi(w.y)}, x1 = (f32x4){bflo(w.z), bfhi(w.z), bflo(w.w), bfhi(w.w)};
                const f32x4 v0 = x0 + gt[bj][0] * acc[ai][bj][m][0], v1 = x1 + gt[bj][1] * acc[ai][bj][m][1]; acc[ai][bj][m][0] = v0; acc[ai][bj][m][1] = v1;
                ss += ((v0.x * v0.x + v0.y * v0.y) + (v0.z * v0.z + v0.w * v0.w)) + ((v1.x * v1.x + v1.y * v1.y) + (v1.z * v1.z + v1.w * v1.w)); }
            ss += shx(ss, 16, lane); ss += shx(ss, 32, lane);
            if (fq == 0) PL[(ai * 128 + wr * 64 + m * 16 + fr) * 4 + wc] = ss;
            asm volatile("" ::: "memory"); }
        asm volatile("s_waitcnt lgkmcnt(0)" ::: "memory"); __builtin_amdgcn_s_barrier(); asm volatile("" ::: "memory");
        if (tid < 256) { const f32x4 p = *(const LAS f32x4*)(PL + tid * 4); const float s = (p.x + p.y) + (p.z + p.w);
            __hip_atomic_store(XB + (size_t)(u.pm * 256 + tid) * 4 + u.pn, s, __ATOMIC_RELAXED, __HIP_MEMORY_SCOPE_AGENT); }
        asm volatile("s_waitcnt vmcnt(0)" ::: "memory"); __builtin_amdgcn_s_barrier(); asm volatile("" ::: "memory");
        if (tid == 0) __hip_atomic_fetch_add(ctl + CW_FIN + 64 * u.pm, 1u, __ATOMIC_RELAXED, __HIP_MEMORY_SCOPE_AGENT);
        if (tid < 64) { unsigned sp = 0;
            while ((unsigned)__builtin_amdgcn_readfirstlane((int)__hip_atomic_load(ctl + CW_FIN + 64 * u.pm, __ATOMIC_RELAXED, __HIP_MEMORY_SCOPE_AGENT)) < 4u) { __builtin_amdgcn_s_sleep(2); if (++sp > (1u << 22)) break; }
            __builtin_amdgcn_fence(__ATOMIC_ACQUIRE, "agent"); asm volatile("s_waitcnt vmcnt(0)" ::: "memory"); }
        asm volatile("" ::: "memory"); __builtin_amdgcn_s_barrier(); asm volatile("" ::: "memory");
        if (tid < 256) { const float* xbp = XB + (size_t)(u.pm * 256 + tid) * 4; float t = 0.f;
#pragma unroll
            for (int p = 0; p < 4; ++p) t += __hip_atomic_load(xbp + p, __ATOMIC_RELAXED, __HIP_MEMORY_SCOPE_AGENT);
            RS[tid] = rsqrtf(t * (1.0f / DM) + EPS); }
        asm volatile("s_waitcnt lgkmcnt(0)" ::: "memory"); __builtin_amdgcn_s_barrier(); asm volatile("" ::: "memory");
        f32x4 gf[2][2];
#pragma unroll
        for (int bj = 0; bj < 2; ++bj)
#pragma unroll
            for (int n = 0; n < 2; ++n) gf[bj][n] = *(const f32x4*)(gfin + col8 + bj * 128 + 4 * n);
#pragma unroll
        for (int g = 0; g < 8; ++g) { const int ai = g >> 2, m = g & 3, grow = grow0 + ai * 128 + m * 16; const float rs = RS[ai * 128 + wr * 64 + m * 16 + fr]; float* xn = outp + (size_t)grow * DM + col8;
#pragma unroll
            for (int bj = 0; bj < 2; ++bj)
#pragma unroll
                for (int n = 0; n < 2; ++n) *(f32x4*)(xn + bj * 128 + 4 * n) = acc[ai][bj][m][n] * rs * gf[bj][n]; }
    }
};

__device__ __forceinline__ unsigned dpp_ror1(unsigned v) { return (unsigned)__builtin_amdgcn_update_dpp(0, (int)v, 0x121, 0xf, 0xf, false); }
__device__ __forceinline__ unsigned dpp_ror15(unsigned v) { return (unsigned)__builtin_amdgcn_update_dpp(0, (int)v, 0x12F, 0xf, 0xf, false); }
struct FastUpConv {
    static constexpr bool PERM = true, AFTER_DRAIN = false;
    bf16* ACT; bf16* EDGE; const float* stats; const float* bias; const float* cw; LAS unsigned char* xl;
    static __device__ __forceinline__ float ror1f(float v) { return __int_as_float(__builtin_amdgcn_mov_dpp(__float_as_int(v), 0x121, 0xf, 0xf, false)); }
    static __device__ __forceinline__ float shr1_old(float old, float v) { return __int_as_float(__builtin_amdgcn_update_dpp(__float_as_int(old), __float_as_int(v), 0x111, 0xf, 0xf, false)); }
    static __device__ __forceinline__ float shl1_old(float old, float v) { return __int_as_float(__builtin_amdgcn_update_dpp(__float_as_int(old), __float_as_int(v), 0x101, 0xf, 0xf, false)); }
    static __device__ __forceinline__ float sg_(float g2, float u2) { return g2 * u2 * __builtin_amdgcn_rcpf(1.0f + __builtin_amdgcn_exp2f(g2)); }
    static __device__ __forceinline__ float ror15f(float v) { return __int_as_float(__builtin_amdgcn_mov_dpp(__float_as_int(v), 0x12F, 0xf, 0xf, false)); }
    __device__ __forceinline__ void operator()(f32x4 (&acc)[2][2][4][2], const pg8::Unit& u, int wr, int wc, int fr, int fq) const {
        asm volatile("" : "+v"(fr), "+v"(fq));
        LAS float* EX = (LAS float*)xl; LAS float* RS = (LAS float*)(xl + 8192); LAS float* CT = (LAS float*)(xl + 9216);
        const int trow0 = wr * 64 + 4 * fr;
        const int bi = row_bi(u.pm * 256), j0 = u.pn * 128 + wc * 32 + 8 * fq, tid = (wr * 4 + wc) * 64 + fq * 16 + fr;
        const int ct0 = wc * 32 + 8 * fq;
        { const int which = (wr * 4 + wc) >> 1  , c = (tid * 2) & 255, col = (c >> 7) * DFF + u.pn * 128 + (c & 127);
          const f32x2 vb = *(const f32x2*)(bias + (size_t)bi * NUP + col), vw = *(const f32x2*)(cw + (size_t)(which > 0 ? which - 1 : 0) * NUP + col);
          const float csc = (c >> 7) ? -1.4426950408889634f : -0.6931471805599453f;
          const f32x2 v = which == 0 ? vb : vw * csc;
          if (tid < 256) { const f32x4* sp = (const f32x4*)(stats + (size_t)(u.pm * 256 + tid) * 16); const f32x4 a = sp[0], b = sp[1], c4 = sp[2], d = sp[3];
              const float s = ((a.x + a.y) + (a.z + a.w)) + ((b.x + b.y) + (b.z + b.w)) + ((c4.x + c4.y) + (c4.z + c4.w)) + ((d.x + d.y) + (d.z + d.w));
              RS[tid] = rsqrtf(s * (1.0f / DM) + EPS); }
          *(LAS f32x2*)(CT + which * 256 + c) = v; }
        asm volatile("s_waitcnt lgkmcnt(0)" ::: "memory"); __builtin_amdgcn_s_barrier(); asm volatile("" ::: "memory");
        { f32x4 bv[2][2];
#pragma unroll
          for (int bj = 0; bj < 2; ++bj)
#pragma unroll
              for (int n = 0; n < 2; ++n) bv[bj][n] = *(const LAS f32x4*)(CT + bj * 128 + ct0 + 4 * n);
#pragma unroll
          for (int ai = 0; ai < 2; ++ai) { const f32x4 rs4 = *(const LAS f32x4*)(RS + ai * 128 + trow0);
#pragma unroll
              for (int m = 0; m < 4; ++m)
#pragma unroll
                  for (int bj = 0; bj < 2; ++bj)
#pragma unroll
                      for (int n = 0; n < 2; ++n) acc[ai][bj][m][n] = acc[ai][bj][m][n] * rs4[m] + bv[bj][n]; } }
#pragma unroll
        for (int ai = 0; ai < 2; ++ai) { const int s = 2 * ai + wr;
#pragma unroll
            for (int bj = 0; bj < 2; ++bj)
#pragma unroll
                for (int n = 0; n < 2; ++n) {
                    if (fr == 0) *(LAS f32x4*)(EX + ((s * 2 + 0) * 4 + wc) * 64 + (bj * 2 + n) * 16 + fq * 4) = acc[ai][bj][0][n];
                    if (fr == 15) *(LAS f32x4*)(EX + ((s * 2 + 1) * 4 + wc) * 64 + (bj * 2 + n) * 16 + fq * 4) = acc[ai][bj][3][n]; } }
        if (wr == 0 && fr == 0) {
#pragma unroll
            for (int m = 0; m < 2; ++m)
#pragma unroll
                for (int bj = 0; bj < 2; ++bj)
#pragma unroll
                    for (int n = 0; n < 2; ++n) { const f32x4 v = acc[0][bj][m][n]; v2u w; w.x = pk2(v.x, v.y); w.y = pk2(v.z, v.w); *(v2u*)(EDGE + (size_t)(u.pm * 4 + m) * NUP + bj * DFF + j0 + 4 * n) = w; } }
        if (wr == 1 && fr == 15) {
#pragma unroll
            for (int m = 2; m < 4; ++m)
#pragma unroll
                for (int bj = 0; bj < 2; ++bj)
#pragma unroll
                    for (int n = 0; n < 2; ++n) { const f32x4 v = acc[1][bj][m][n]; v2u w; w.x = pk2(v.x, v.y); w.y = pk2(v.z, v.w); *(v2u*)(EDGE + (size_t)(u.pm * 4 + m) * NUP + bj * DFF + j0 + 4 * n) = w; } }
        asm volatile("s_waitcnt lgkmcnt(0)" ::: "memory"); __builtin_amdgcn_s_barrier(); asm volatile("" ::: "memory");
#pragma unroll
        for (int ai = 0; ai < 2; ++ai) { const int s = 2 * ai + wr; v2u keep[4];
#pragma unroll
            for (int n = 0; n < 2; ++n) { f32x4 cv[2][4];
#pragma unroll
                for (int bj = 0; bj < 2; ++bj) {
                    const f32x4 top = *(const LAS f32x4*)(EX + (((ai == 0 ? 0 : s - 1) * 2 + 1) * 4 + wc) * 64 + (bj * 2 + n) * 16 + fq * 4);
                    const f32x4 bot = *(const LAS f32x4*)(EX + (((ai == 1 ? 3 : s + 1) * 2 + 0) * 4 + wc) * 64 + (bj * 2 + n) * 16 + fq * 4);
                    const f32x4 w0 = *(const LAS f32x4*)(CT + 1 * 256 + bj * 128 + ct0 + 4 * n), w1 = *(const LAS f32x4*)(CT + 2 * 256 + bj * 128 + ct0 + 4 * n), w2 = *(const LAS f32x4*)(CT + 3 * 256 + bj * 128 + ct0 + 4 * n);
                    f32x4 up0, dn3;
#pragma unroll
                    for (int k = 0; k < 4; ++k) { up0[k] = shr1_old(top[k], acc[ai][bj][3][n][k]); dn3[k] = shl1_old(bot[k], acc[ai][bj][0][n][k]); }
#pragma unroll
                    for (int m = 0; m < 4; ++m) { const f32x4 up = (m > 0) ? acc[ai][bj][m - 1][n] : up0, dn = (m < 3) ? acc[ai][bj][m + 1][n] : dn3;
                        cv[bj][m] = w0 * up + w1 * acc[ai][bj][m][n] + w2 * dn; } }
#pragma unroll
                for (int m = 0; m < 4; ++m) { v2u o; o.x = pk2(sg_(cv[1][m].x, cv[0][m].x), sg_(cv[1][m].y, cv[0][m].y)); o.y = pk2(sg_(cv[1][m].z, cv[0][m].z), sg_(cv[1][m].w, cv[0][m].w));
                    if (n == 0) keep[m] = o;
                    else { v4u w4; w4.x = keep[m].x; w4.y = keep[m].y; w4.z = o.x; w4.w = o.y; *(v4u*)(ACT + (size_t)(u.pm * 256 + ai * 128 + trow0 + m) * DFF + j0) = w4; } }
            } }
    }
};

template <int DSH> __device__ __forceinline__ float dpp_up(float v) { return __int_as_float(__builtin_amdgcn_mov_dpp(__float_as_int(v), 0x120 + (16 - DSH), 0xf, 0xf, false)); }
template <int DIR> __device__ __forceinline__ void aff_step(float& P, float& B, const float Ps, const float Bs) {
    if (DIR == 0) { B = Ps * B + Bs; P = P * Ps; } else { B = P * Bs + B; P = P * Ps; }
}
struct FastGates {
    static constexpr bool PERM = false, AFTER_DRAIN = false; GatesEpi e; LAS unsigned char* xl;
    __device__ __forceinline__ void operator()(const f32x4 (&acc)[2][2][4][2], const pg8::Unit& u, int wr, int wc, int fr, int fq) const {
        asm volatile("" : "+v"(fr), "+v"(fq));
        LAS float* PR = (LAS float*)xl;
        const int srow0 = u.pm * 256 + wr * 64 + fr;
        const int trow0 = u.pm * 256 + wr * 64 + 4 * fr;
        const int dir = u.pn >> 1, chb = (u.pn & 1) * 128, cl0 = wc * 32 + 4 * fq, ch0 = chb + cl0, tid = (wr * 4 + wc) * 64 + fq * 16 + fr;
        { const int which = (wr * 4 + wc) >> 1  , c = tid & 127;
          if (which < 3) { const int i = dir * 256 + chb + c; const float v0 = e.ba[i], v1 = e.bi_[i], v2 = e.spl[i] * (-8.0f * 1.4426950408889634f);
              PR[which * 128 + c] = which == 0 ? v0 * -1.4426950408889634f : which == 1 ? v1 * -1.4426950408889634f : v2; } }
        asm volatile("s_waitcnt lgkmcnt(0)" ::: "memory"); __builtin_amdgcn_s_barrier(); asm volatile("" ::: "memory");
#pragma unroll
        for (int ai = 0; ai < 2; ++ai) {
            v2u xr[4][2];
#pragma unroll
            for (int m = 0; m < 4; ++m)
#pragma unroll
                for (int n = 0; n < 2; ++n) xr[m][n] = *(const v2u*)(e.RC + (size_t)(srow0 + ai * 128 + m * 16) * 256 + ch0 + 16 * n);
#pragma unroll
            for (int n = 0; n < 2; ++n) {
                const f32x4 vba = *(const LAS f32x4*)(PR + cl0 + 16 * n), vbi = *(const LAS f32x4*)(PR + 128 + cl0 + 16 * n), vsp = *(const LAS f32x4*)(PR + 256 + cl0 + 16 * n);
                float Pa[4], Ba[4];
#pragma unroll
                for (int m = 0; m < 4; ++m) {
                    const v2u xw = xr[m][n]; const float xf[4] = {bflo(xw.x), bfhi(xw.x), bflo(xw.y), bfhi(xw.y)};
                    const f32x4 ya = acc[ai][0][m][n], yi = acc[ai][1][m][n];
                    v4u pw;
#pragma unroll
                    for (int k = 0; k < 4; ++k) { const float rg = __builtin_amdgcn_rcpf(1.0f + __builtin_amdgcn_exp2f(__builtin_fmaf(ya[k], -1.4426950408889634f, vba[k]))), ig = __builtin_amdgcn_rcpf(1.0f + __builtin_amdgcn_exp2f(__builtin_fmaf(yi[k], -1.4426950408889634f, vbi[k])));
                        const float la2 = bflo(pk2(rg * vsp[k], 0.f));
                        const float P = __builtin_amdgcn_exp2f(la2);
                        const float bb = __builtin_amdgcn_sqrtf(__builtin_fminf(__builtin_fmaxf(1.0f - P * P, 0.f), 1.0f)) * (ig * xf[k]);
                        const unsigned w = pk2(la2, bb); pw[k] = w; const float B = bfhi(w);
                        if (m == 0) { Pa[k] = P; Ba[k] = B; } else if (dir == 0) aff_step<0>(Pa[k], Ba[k], P, B); else aff_step<1>(Pa[k], Ba[k], P, B); }
                    *(v4u*)(e.LAB + ((size_t)dir * M_ALL + trow0 + ai * 128 + m) * 256 + ch0 + 16 * n) = pw;
                }
                if (dir == 0) {
#pragma unroll
                    for (int k = 0; k < 4; ++k) { aff_step<0>(Pa[k], Ba[k], dpp_up<1>(Pa[k]), dpp_up<1>(Ba[k])); aff_step<0>(Pa[k], Ba[k], dpp_up<2>(Pa[k]), dpp_up<2>(Ba[k]));
                        aff_step<0>(Pa[k], Ba[k], dpp_up<4>(Pa[k]), dpp_up<4>(Ba[k])); aff_step<0>(Pa[k], Ba[k], dpp_up<8>(Pa[k]), dpp_up<8>(Ba[k])); }
                } else {
#pragma unroll
                    for (int k = 0; k < 4; ++k) { aff_step<1>(Pa[k], Ba[k], dpp_up<1>(Pa[k]), dpp_up<1>(Ba[k])); aff_step<1>(Pa[k], Ba[k], dpp_up<2>(Pa[k]), dpp_up<2>(Ba[k]));
                        aff_step<1>(Pa[k], Ba[k], dpp_up<4>(Pa[k]), dpp_up<4>(Ba[k])); aff_step<1>(Pa[k], Ba[k], dpp_up<8>(Pa[k]), dpp_up<8>(Ba[k])); }
                }
                if (fr == 0) { const int s = 2 * ai + wr; int b, c; if (u.pm < 128) { b = u.pm >> 4; c = 4 + (u.pm & 15) * 4 + s; } else { b = u.pm - 128; c = s; }
                    const size_t o = ((size_t)(dir * NB + b) * NCHUNK + c) * 256 + ch0 + 16 * n;
                    *(f32x4*)(e.AGP + o) = (f32x4){Pa[0], Pa[1], Pa[2], Pa[3]}; *(f32x4*)(e.AGB + o) = (f32x4){Ba[0], Ba[1], Ba[2], Ba[3]}; }
                asm volatile("" ::: "memory"); __builtin_amdgcn_sched_barrier(0);
            }
        }
    }
};

struct GenOrder {
    pg8::StaticOrder map; int b1, s1, n1, b2, s2, n2;
    __device__ __forceinline__ void strided(int M, int N, int first, int stride) { map.init(M, N, 1, 0); b1 = first; s1 = stride; n1 = 1 << 20; b2 = 0; s2 = 0; n2 = 0; }
    __device__ __forceinline__ bool next(int i, pg8::Unit& u) const { int L; if (i < n1) L = b1 + i * s1; else if (i < n1 + n2) L = b2 + (i - n1) * s2; else return false; return map.next(L, u); }
    __device__ __forceinline__ void a_ready(const pg8::Unit&) const {}
    __device__ __forceinline__ void done(const pg8::Unit&) const {}
};
__device__ __forceinline__ void gemm_proj(const Ctx& C, const bf16* A, const bf16* Bt, int Mrows, int N, int K, const GenOrder& S, const ProjEpi& E) {
    pg8::Gemm g{A, Bt, Mrows, N, K}; FastProj F{E, C.lds + EXCH_OFF};
    pg8::gemm_phase<FastProj, GenOrder, true, true>(C.lds, g, S, F, C.tid);
}
template <bool XIN_F32> __device__ __forceinline__ void gemm_res(const Ctx& C, const bf16* A, const bf16* Bt, int Mrows, int K, const GenOrder& S, const ResEpi& E) {
    pg8::Gemm g{A, Bt, Mrows, DM, K}; FastRes<XIN_F32> F{E};
    pg8::gemm_phase<FastRes<XIN_F32>, GenOrder, true, true>(C.lds, g, S, F, C.tid);
}
__device__ __forceinline__ void gemm_res_final(const Ctx& C, const bf16* A, const bf16* Bt, int Mrows, int K, const GenOrder& S, const ResEpi& E) {
    pg8::Gemm g{A, Bt, Mrows, DM, K}; FastResFinal F{E, C.g_final, C.out, (float*)(C.ws + WS_AGP), (unsigned*)(C.ws + WS_CTL), C.lds + EXCH_OFF};
    pg8::gemm_phase<FastResFinal, GenOrder, true, true>(C.lds, g, S, F, C.tid);
}
__device__ __forceinline__ void gemm_gates(const Ctx& C, const bf16* A, const bf16* Bt, const GatesEpi& E) {
    pg8::Gemm g{A, Bt, M_ALL, 1024, 256, 128}; GenOrder S; S.strided(M_ALL, 1024, (int)blockIdx.x, C.G); FastGates F{E, C.lds + EXCH_OFF};
    pg8::gemm_phase<FastGates, GenOrder, true, true>(C.lds, g, S, F, C.tid);
}
__device__ __forceinline__ void gemm_upconv(const Ctx& C, int l, int Mrows) {
    pg8::Gemm g{(const bf16*)(C.ws + WS_AP), (const bf16*)(C.ws + WS_WUP + l * SZ_WUP), Mrows, NUP, DM}; GenOrder S; S.strided(Mrows, NUP, (int)blockIdx.x, C.G);
    FastUpConv F{(bf16*)(C.ws + WS_ACT), (bf16*)(C.ws + WS_EDGE), (const float*)(C.ws + WS_STB), (const float*)(C.ws + WS_BUP) + (size_t)l * 9 * NUP, C.ffn_conv_w + (size_t)l * 3 * NUP, C.lds + EXCH_OFF};
    pg8::gemm_phase<FastUpConv, GenOrder, true, true>(C.lds, g, S, F, C.tid);
}


typedef GAS unsigned gu32;
#define RLX_AGENT __ATOMIC_RELAXED, __HIP_MEMORY_SCOPE_AGENT
#define XB_TMO      128
#define XB_XCNT(j)  (256  + 64 * (j))
#define XB_XSUB(j)  (1280 + 64 * (j))
#define XB_XGEN(j)  (2304 + 64 * (j))
#define XB_TOP      3328
#define XB_TOPGEN   3392
#define XCD_BAR_WORDS 3456
#define XB_SPIN_CAP (1u << 18)

__device__ __forceinline__ unsigned xb_ld(unsigned* p)              { return __hip_atomic_load(p, __ATOMIC_RELAXED, __HIP_MEMORY_SCOPE_AGENT); }
__device__ __forceinline__ unsigned xb_add(unsigned* p, unsigned v) { return __hip_atomic_fetch_add(p, v, __ATOMIC_RELAXED, __HIP_MEMORY_SCOPE_AGENT); }
__device__ __forceinline__ unsigned xb_xcc_id() { return (unsigned)__builtin_amdgcn_s_getreg((3 << 11) | 20) & 0xFu; }
#define XB_SPIN(cond, bar) do { unsigned _sp = 0; while (cond) { __builtin_amdgcn_s_sleep(1); \
    if ((++_sp & 255u) == 0u) { if (xb_ld(&(bar)[XB_TMO])) break; if (_sp > XB_SPIN_CAP) { atomicAdd(&(bar)[XB_TMO], 1u); break; } } } } while (0)

struct XcdBarrier {
    int wave;
    unsigned* bar; unsigned x;
    volatile LAS unsigned* st;
};

__device__ __forceinline__ bool xb_leader(int wave) { return wave == 0 && __builtin_amdgcn_mbcnt_hi(~0u, __builtin_amdgcn_mbcnt_lo(~0u, 0u)) == 0u; }
__device__ __forceinline__ XcdBarrier xcd_barrier_post(unsigned* bar, volatile LAS unsigned* st, int wave) {
    XcdBarrier b; b.wave = wave; b.bar = bar; b.x = xb_xcc_id(); b.st = st;
    if (xb_leader(wave)) (void)xb_add(&bar[XB_XCNT(b.x)], 1u);
    return b;
}
__device__ __forceinline__ void xcd_barrier_complete(unsigned* bar, unsigned x, unsigned& nloc, unsigned& nx) {
    const unsigned G = gridDim.x * gridDim.y * gridDim.z;
    unsigned sum, cnt, mine, sp = 0u;
    for (;;) {
        sum = 0u; cnt = 0u; mine = 0u;
#pragma unroll
        for (unsigned j = 0; j < 16; ++j) { const unsigned c = xb_ld(&bar[XB_XCNT(j)]); sum += c; cnt += (c > 0u) ? 1u : 0u; mine = (j == x) ? c : mine; }
        if (sum == G) break;
        __builtin_amdgcn_s_sleep(1);
        if ((++sp & 255u) == 0u) { if (xb_ld(&bar[XB_TMO])) break; if (sp > XB_SPIN_CAP) { atomicAdd(&bar[XB_TMO], 1u); break; } }
    }
    nloc = mine > 0u ? mine : 1u; nx = cnt > 0u ? cnt : 1u;
}

__device__ __forceinline__ void xcd_barrier(const XcdBarrier& b) {
    asm volatile("s_waitcnt vmcnt(0)" ::: "memory");
    __syncthreads();
    if (xb_leader(b.wave)) {
        unsigned* bar = b.bar;
        __builtin_amdgcn_s_waitcnt(0);
        unsigned nloc = b.st[0], nx = b.st[1];
        if (nloc == 0u) { xcd_barrier_complete(bar, b.x, nloc, nx); b.st[0] = nloc; b.st[1] = nx; }
        const unsigned old = xb_add(&bar[XB_XSUB(b.x)], 1u);
        const unsigned gen = old / nloc;
        if (old + 1u == (gen + 1u) * nloc) {
            __builtin_amdgcn_fence(__ATOMIC_RELEASE, "agent");
            asm volatile("s_waitcnt vmcnt(0)" ::: "memory");
            const unsigned og = xb_add(&bar[XB_TOP], 1u);
            const unsigned tg = og / nx;
            if (og + 1u == (tg + 1u) * nx) xb_add(&bar[XB_TOPGEN], 1u);
            else XB_SPIN(xb_ld(&bar[XB_TOPGEN]) == tg, bar);
            __builtin_amdgcn_fence(__ATOMIC_ACQUIRE, "agent");
            xb_add(&bar[XB_XGEN(b.x)], 1u);
            asm volatile("s_waitcnt vmcnt(0)" ::: "memory");
        } else {
            XB_SPIN(xb_ld(&bar[XB_XGEN(b.x)]) == gen, bar);
            __builtin_amdgcn_fence(__ATOMIC_ACQUIRE, "agent");
            asm volatile("s_waitcnt vmcnt(0)" ::: "memory");
        }
    }
    __syncthreads();
}

constexpr int CW_GSYNC = 3840;
__device__ __forceinline__ void grid_arrive(unsigned* word, int wave) {
    asm volatile("s_waitcnt vmcnt(0)" ::: "memory"); __syncthreads();
    if (xb_leader(wave)) { __builtin_amdgcn_fence(__ATOMIC_RELEASE, "agent"); asm volatile("s_waitcnt vmcnt(0)" ::: "memory"); (void)xb_add(word, 1u); }
}
__device__ __forceinline__ void grid_wait(unsigned* word, unsigned target, int wave) {
    if (xb_leader(wave)) { unsigned sp = 0; while (xb_ld(word) < target) { __builtin_amdgcn_s_sleep(2); if (++sp > (1u << 22)) break; }
        __builtin_amdgcn_fence(__ATOMIC_ACQUIRE, "agent"); asm volatile("s_waitcnt vmcnt(0)" ::: "memory"); }
    __syncthreads();
}

constexpr int PH_PER_LAYER = 7, PH_FINAL = 2 + DEPTH * PH_PER_LAYER, N_PHASES = PH_FINAL + 1;
__global__ void __launch_bounds__(NTHREADS, 2) fwd_kernel(Args args) {
    extern __shared__ __attribute__((aligned(16))) unsigned char lds_raw[];
    Ctx C;
    C.lds = (LAS unsigned char*)lds_raw; C.lds_gen = (char*)lds_raw; C.wave = __builtin_amdgcn_readfirstlane((int)threadIdx.x >> 6); C.lane = (int)__builtin_amdgcn_mbcnt_hi(~0u, __builtin_amdgcn_mbcnt_lo(~0u, 0u)); C.tid = C.wave * 64 + C.lane;
    C.G = gridDim.x; { const int bx = blockIdx.x; C.vcu = (C.G % 8 == 0) ? (bx % 8) * (C.G / 8) + bx / 8 : bx; }
    C.gw = C.vcu * NWAVES + C.wave; C.NGW = C.G * NWAVES;
    const int lo = args.ph_lo, hi = args.ph_hi;
    for (int u = C.tid; u < (LDS_BYTES - LDSCTL_OFF) / 4; u += NTHREADS) ((LAS unsigned*)(C.lds + LDSCTL_OFF))[u] = 0u;
    __syncthreads();
    XcdBarrier bar; bar.wave = C.wave; bar.bar = (unsigned*)(args.ws + WS_CTL) + CW_BAR; bar.x = 0; bar.st = nullptr;
    if (hi - lo > 1) bar = xcd_barrier_post((unsigned*)(args.ws + WS_CTL) + CW_BAR, (volatile LAS unsigned*)(C.lds + MISC_OFF) + 8, C.wave);
#define IN(k) (lo <= (k) && (k) < hi)
#define PCTX Ctx L = C; asm volatile("v_mbcnt_lo_u32_b32 %0, -1, 0\n\tv_mbcnt_hi_u32_b32 %0, -1, %0" : "=v"(L.lane)); L.tid = L.wave * 64 + L.lane; asm volatile("" : "+s"(L.vcu), "+s"(L.gw)); { const __attribute__((address_space(4))) Args* ka_ = (const __attribute__((address_space(4))) Args*)__builtin_amdgcn_kernarg_segment_ptr(); asm volatile("" : "+s"(ka_)); L.x = (const float*)ka_->in[0]; L.c = (const float*)ka_->in[1]; L.ctx = (const float*)ka_->in[2]; L.c_ctx = (const float*)ka_->in[3]; L.w_mod = (const float*)ka_->in[4]; L.b_mod = (const float*)ka_->in[5]; L.g_mix = (const float*)ka_->in[6]; L.g_ffn = (const float*)ka_->in[7]; L.w_in = (const float*)ka_->in[8]; L.g_q = (const float*)ka_->in[9]; L.g_k = (const float*)ka_->in[10]; L.lru_conv_w = (const float*)ka_->in[11]; L.lru_conv_b = (const float*)ka_->in[12]; L.lru_wa = (const float*)ka_->in[13]; L.lru_ba = (const float*)ka_->in[14]; L.lru_wi = (const float*)ka_->in[15]; L.lru_bi = (const float*)ka_->in[16]; L.lru_lam = (const float*)ka_->in[17]; L.sc_conv_w = (const float*)ka_->in[18]; L.w_out = (const float*)ka_->in[19]; L.w_up = (const float*)ka_->in[20]; L.ffn_conv_w = (const float*)ka_->in[21]; L.w_down = (const float*)ka_->in[22]; L.g_final = (const float*)ka_->in[23]; L.out = ka_->out; { GAS unsigned char* wsg_ = (GAS unsigned char*)ka_->ws; asm volatile("" : "+s"(wsg_)); L.ws = (unsigned char*)wsg_; } }
#define SEAM(k) do { if (IN(k) && IN((k) + 1)) { xcd_barrier(bar); } } while (0)
    if (IN(0)) REP(0) { PCTX; phase_p0a(L); } SEAM(0);
    if (IN(1)) REP(1) { PCTX; phase_p0b(L); } SEAM(1);
    for (int l = 0; l < DEPTH; ++l) {
        const int P = 2 + l * PH_PER_LAYER;
        const int Mff = (l == 0) ? M_ALL : M_LAT;
        if (IN(P + 0)) REP(2) {
            PCTX; int bx = (int)blockIdx.x; asm volatile("" : "+s"(bx));
            if (l == 0) {
                ProjEpi E{(bf16*)(L.ws + WS_PROJ), NPROJ, (const float*)(L.ws + WS_STA), (const float*)(L.ws + WS_BIN), NPROJ, 0, 0, (bf16*)(L.ws + WS_MIX), (bf16*)(L.ws + WS_KB), (bf16*)(L.ws + WS_VB), (const float*)(L.ws + WS_ROPE), L.g_q + (0) * 64, L.g_k + (0) * 64};
                GenOrder S; S.strided(M_ALL, NPROJ, bx, L.G);
                gemm_proj(L, (const bf16*)(L.ws + WS_AP), (const bf16*)(L.ws + WS_WIN), M_ALL, NPROJ, DM, S, E);
                { const int rem = (L.G == 256) ? ((M_ALL / 256) * (NPROJ / 256)) & 255 : 0; if (bx >= rem) { __syncthreads(); deferred_work(L, 0, bx - rem, L.G - rem); } }
            } else {
                { const float* mod = (const float*)(L.ws + WS_MOD) + (size_t)(l - 1) * 9 * 6144;
                  ResEpi E{L.x, L.ctx, (bf16*)(L.ws + WS_XR), mod + 5 * 1024, L.g_mix + l * DM, mod + 9 * 6144 + 1 * 1024, (bf16*)(L.ws + WS_AP), (float*)(L.ws + WS_STA), true, M_LAT / 256, false};
                  GenOrder S; S.strided(M_CTX, DM, bx, L.G);
                  { pg8::Unit fu; int prev = -1; for (int i = 0; S.next(i, fu); ++i) { if (fu.pm != prev) ffn_fix_panel(L, l - 1, M_LAT / 256 + fu.pm); prev = fu.pm; } asm volatile("s_waitcnt vmcnt(0)" ::: "memory"); __syncthreads(); }
                  gemm_res<false>(L, (const bf16*)(L.ws + WS_ACT) + (size_t)M_LAT * DFF, (const bf16*)(L.ws + WS_WDN + (l - 1) * SZ_WDN), M_CTX, DFF, S, E); }
                { ProjEpi E{(bf16*)(L.ws + WS_PROJ), NPROJ, (const float*)(L.ws + WS_STA), (const float*)(L.ws + WS_BIN) + (size_t)l * 9 * NPROJ, NPROJ, 0, 0, (bf16*)(L.ws + WS_MIX), (bf16*)(L.ws + WS_KB), (bf16*)(L.ws + WS_VB), (const float*)(L.ws + WS_ROPE), L.g_q + (l) * 64, L.g_k + (l) * 64};
                  GenOrder S; S.strided(M_LAT, NPROJ, bx, L.G);
                  if (L.G == 256) {
                      if (bx < 32) { S.b1 = 896 + bx; S.s1 = 32; S.n1 = 2; }
                      else { const int j = bx - 32; S.b1 = j; S.s1 = 224; S.n1 = 4; S.b2 = 960 + j; S.s2 = 0; S.n2 = j < 64 ? 1 : 0; } }
                  gemm_proj(L, (const bf16*)(L.ws + WS_AP), (const bf16*)(L.ws + WS_WIN + l * SZ_WIN), M_LAT, NPROJ, DM, S, E); }
            }
        } SEAM(P + 0);
        if (IN(P + 1)) {
            if ((PROBE_REP_MASK >> 3) & 1) { PCTX; if (l == 0) phase_post(L, l, 0, M_ALL, 12, L.gw, L.NGW); }
            PCTX;
            if (l == 0) phase_post(L, l, 0, M_ALL, 12, L.gw, L.NGW);
            else {
                const int gs = L.G >> 3; const bool split = gs >= 2; int q = 0, below = 0, role = 0;
#pragma unroll
                for (int p = 0; p < 8; ++p) { if (L.vcu == p * gs) { role = 1; q = p; } if (split && L.vcu == p * gs + 1) { role = 2; q = p; } if (p * gs < L.vcu) ++below; if (split && p * gs + 1 < L.vcu) ++below; }
                if (role != 0) {
                    const int r0 = M_LAT + 256 * q, c0 = (role == 2 || !split) ? 512 : 768, ncol = split ? 256 : 512;
                    ProjEpi E{(bf16*)(L.ws + WS_PROJ) + (size_t)r0 * NPROJ + c0, NPROJ, (const float*)(L.ws + WS_STA), (const float*)(L.ws + WS_BIN) + (size_t)l * 9 * NPROJ + c0, NPROJ, r0, c0 >> 8, (bf16*)(L.ws + WS_MIX), (bf16*)(L.ws + WS_KB), (bf16*)(L.ws + WS_VB), (const float*)(L.ws + WS_ROPE), L.g_q + l * 64, L.g_k + l * 64};
                    GenOrder S; S.strided(256, ncol, 0, 1);
                    gemm_proj(L, (const bf16*)(L.ws + WS_AP) + (size_t)r0 * DM, (const bf16*)(L.ws + WS_WIN + l * SZ_WIN) + (size_t)c0 * DM, 256, ncol, DM, S, E);
                    if (role == 1) { asm volatile("s_waitcnt vmcnt(0)" ::: "memory"); __syncthreads(); phase_post(L, l, r0, r0 + 256, 4, L.wave, NWAVES); }
                } else {
                    const int j = L.vcu - below, nl = L.G - (split ? 16 : 8);
                    phase_post(L, l, 0, M_LAT, 12, j * NWAVES + L.wave, nl * NWAVES);
                }
            }
        } SEAM(P + 1);
        const bool fuse23 = IN(P + 2) && IN(P + 3);
        if (IN(P + 2)) REP(4) {
            PCTX;
            GatesEpi E{(const bf16*)(L.ws + WS_RC), L.lru_ba + l * 512, L.lru_bi + l * 512, (const float*)(L.ws + WS_SPL) + l * 512, (unsigned*)(L.ws + WS_LA), (float*)(L.ws + WS_AGP), (float*)(L.ws + WS_AGB)};
            gemm_gates(L, (const bf16*)(L.ws + WS_RC), (const bf16*)(L.ws + WS_GW + l * SZ_GW), E);
            if (l == 0) { const int bx = (int)blockIdx.x, rem = (L.G == 256) ? ((M_ALL / 256) * 4) & 255 : 0; if (bx >= rem) { __syncthreads(); deferred_work(L, 1, bx - rem, L.G - rem); } }
            if (fuse23) grid_arrive((unsigned*)(L.ws + WS_CTL) + CW_GSYNC + 64 * l, L.wave);
        } if (!fuse23) SEAM(P + 2);
        if (IN(P + 3)) { { PCTX;
            REP(6) phase_attn_fast(L, l, rep_ == 0 && ((PROBE_REP_MASK >> 6) & 1));
            } REP(7) { PCTX; if (fuse23) grid_wait((unsigned*)(L.ws + WS_CTL) + CW_GSYNC + 64 * l, (unsigned)L.G, L.wave); phase_scan2(L, l); } } SEAM(P + 3);
        if (IN(P + 4)) for (int rep_ = 0; rep_ < ((((PROBE_REP_MASK) >> 8) & 1) && l == 0 ? 2 : 1); ++rep_) {
            PCTX; const float* mod = (const float*)(L.ws + WS_MOD) + (size_t)l * 9 * 6144;
            ResEpi E{L.x, L.ctx, (bf16*)(L.ws + WS_XR), mod + 2 * 1024, L.g_ffn + l * DM, mod + 4 * 1024, (bf16*)(L.ws + WS_AP), (float*)(L.ws + WS_STB), true, 0, true};
            GenOrder S; S.strided(Mff, DM, (int)blockIdx.x, L.G);
            if (l == 0) gemm_res<true>(L, (const bf16*)(L.ws + WS_MIX), (const bf16*)(L.ws + WS_WOUT + l * SZ_WOUT), Mff, DM, S, E);
            else gemm_res<false>(L, (const bf16*)(L.ws + WS_MIX), (const bf16*)(L.ws + WS_WOUT + l * SZ_WOUT), Mff, DM, S, E);
            if (l == 0) { const int bx = (int)blockIdx.x, rem = (L.G == 256) ? ((M_ALL / 256) * 4) & 255 : 0; if (bx >= rem) { __syncthreads(); deferred_work(L, 2, bx - rem, L.G - rem); } }
        } SEAM(P + 4);
        if (IN(P + 5)) REP(9) { PCTX; gemm_upconv(L, l, Mff); } SEAM(P + 5);
        if (IN(P + 6)) {
            PCTX; const float* mod = (const float*)(L.ws + WS_MOD) + (size_t)l * 9 * 6144;
            const bool last = (l == DEPTH - 1);
            ResEpi E{L.x, L.ctx, (bf16*)(L.ws + WS_XR), mod + 5 * 1024, last ? L.g_final : L.g_mix + (l + 1) * DM, last ? mod : mod + 9 * 6144 + 1 * 1024, (bf16*)(L.ws + WS_AP), (float*)(L.ws + WS_STA), !last, 0, false};
            GenOrder S; S.strided(M_LAT, DM, (int)blockIdx.x, L.G);
            { pg8::Unit fu; int prev = -1; for (int i = 0; S.next(i, fu); ++i) { if (fu.pm != prev) ffn_fix_panel(L, l, fu.pm); prev = fu.pm; } asm volatile("s_waitcnt vmcnt(0)" ::: "memory"); __syncthreads(); }
            if (last && L.G == 256) gemm_res_final(L, (const bf16*)(L.ws + WS_ACT), (const bf16*)(L.ws + WS_WDN + l * SZ_WDN), M_LAT, DFF, S, E);
            else gemm_res<false>(L, (const bf16*)(L.ws + WS_ACT), (const bf16*)(L.ws + WS_WDN + l * SZ_WDN), M_LAT, DFF, S, E);
        } if (!(l == DEPTH - 1 && C.G == 256)) SEAM(P + 6);
    }
    if (IN(PH_FINAL) && C.G != 256) { PCTX; phase_final(L); }
#undef IN
#undef SEAM
}

extern "C" void kernel_launch(void* const* d_in, const int* in_sizes, int n_in, void* d_out, int out_size, void* d_ws, size_t ws_size, hipStream_t stream) {
    static int grid = 0;
    if (grid == 0) {
        if (n_in != 24 || out_size != M_LAT * DM || ws_size < WS_END) { fprintf(stderr, "kernel_launch: unexpected problem (n_in %d, out %d, ws %zu)\n", n_in, out_size, ws_size); grid = -1; return; }
        int dev = 0, cus = 0, per_cu = 0;
        if (hipGetDevice(&dev) != hipSuccess || hipDeviceGetAttribute(&cus, hipDeviceAttributeMultiprocessorCount, dev) != hipSuccess) { grid = -1; return; }
        if (hipFuncSetAttribute((const void*)fwd_kernel, hipFuncAttributeMaxDynamicSharedMemorySize, LDS_BYTES) != hipSuccess) { fprintf(stderr, "kernel_launch: hipFuncSetAttribute failed\n"); grid = -1; return; }
        if (hipOccupancyMaxActiveBlocksPerMultiprocessor(&per_cu, (const void*)fwd_kernel, NTHREADS, LDS_BYTES) != hipSuccess || per_cu < 1) { fprintf(stderr, "kernel_launch: occupancy query says %d blocks per CU\n", per_cu); }
        (void)hipGetLastError();
        grid = cus;
    }
    if (grid < 0) return;
    (void)hipMemsetAsync((char*)d_ws + WS_CTL, 0, CTL_ZERO_BYTES, stream);
    Args a{};
    for (int i = 0; i < 24; ++i) a.in[i] = d_in[i];
    a.out = (float*)d_out; a.ws = (unsigned char*)d_ws;
#if MK_N_LAUNCHES == 1
    a.ph_lo = 0; a.ph_hi = N_PHASES;
    void* kargs[] = {&a};
    hipError_t e = hipLaunchCooperativeKernel((const void*)fwd_kernel, dim3(grid), dim3(NTHREADS), kargs, LDS_BYTES, stream);
    if (e != hipSuccess) fprintf(stderr, "kernel_launch: cooperative launch failed: %s (grid %d)\n", hipGetErrorString(e), grid);
#else
    for (int p = 0; p < N_PHASES; ++p) {
        a.ph_lo = p; a.ph_hi = p + 1;
        hipLaunchKernelGGL(fwd_kernel, dim3(grid), dim3(NTHREADS), LDS_BYTES, stream, a);
    }
#endif
}
```
